# Optimizing an MI355X kernel written in HIP

```python
import math
import jax, jax.numpy as jnp
from jax import lax
import numpy as np

D_MODEL = 2048
BATCH = 1
SEQ = 8192
DEPTH = 4

GRID_W = 64
CTX_LEN = 256
MIX_W = D_MODEL
S5_W = D_MODEL // 4
S5_CH = 16
S5_G = S5_W // S5_CH
S5_P = 64
CONV_W = D_MODEL // 4
CONV_K = 31
ML_W = D_MODEL // 2
ML_H = 4
ML_DH = ML_W // ML_H
ML_CHUNK = 128
D_FF = ((8 * D_MODEL + 3 * 256 - 1) // (3 * 256)) * 256
EPS = 1e-6
LN_EPS = 1e-5

OFF_S5 = 0
OFF_CONV = OFF_S5 + S5_W
OFF_Q = OFF_CONV + 2 * CONV_W
OFF_K = OFF_Q + ML_W
OFF_V = OFF_K + ML_W
OFF_O = OFF_V + ML_W
OFF_G = OFF_O + ML_W
IN_W = OFF_G + 4 * ML_H

kernel_name = 'hymba_s5_conformer_mlstm_dit'


def _rmsnorm(x, g):
    xf = x.astype(jnp.float32)
    xf = xf * lax.rsqrt(jnp.mean(xf * xf, axis=-1, keepdims=True) + EPS)
    return (xf * g.astype(jnp.float32)).astype(x.dtype)


def _layernorm(x, g, b):
    xf = x.astype(jnp.float32)
    xc = xf - jnp.mean(xf, axis=-1, keepdims=True)
    var = jnp.mean(xc * xc, axis=-1, keepdims=True)
    return (xc * lax.rsqrt(var + LN_EPS) * g.astype(jnp.float32) + b.astype(jnp.float32)).astype(x.dtype)


def _adaln(c_vec, w_mod, b_mod):
    m = jax.nn.silu(c_vec) @ w_mod + b_mod
    return jnp.split(m[..., None, :], 6, axis=-1)


def _swiglu(h, w_in, w_out):
    g, u = jnp.split(h @ w_in, 2, axis=-1)
    return (jax.nn.silu(g) * u) @ w_out


def _lin_rec(e1, e2):
    a1, b1 = e1
    a2, b2 = e2
    return a1 * a2, a2 * b1 + b2


def _s5_discretize(lam_re, lam_im, log_step, b_re, b_im):
    f32 = jnp.float32
    lam = lax.complex(lam_re.astype(f32), lam_im.astype(f32))
    lam_bar = jnp.exp(lam * jnp.exp(log_step.astype(f32)))
    b = lax.complex(b_re.astype(f32), b_im.astype(f32))
    b_bar = ((lam_bar - 1.0) / lam)[..., None] * b
    return lam_bar, b_bar


def _s5_scan(bu, lam_bar, h0, reverse):
    first, last = (-1, 0) if reverse else (0, -1)
    bu = bu.at[:, first].add(lam_bar * h0)
    a = jnp.broadcast_to(lam_bar, bu.shape)
    _, h = lax.associative_scan(_lin_rec, (a, bu), reverse=reverse, axis=1)
    return h, h[:, last]


def s5_mixer(u_c, u_x, lam_re, lam_im, log_step, b_re, b_im, c_re, c_im, d_skip, w_glu, b_glu, need_ctx):
    f32 = jnp.float32
    uc = u_c.astype(f32).reshape(u_c.shape[:2] + (S5_G, S5_CH))
    ux = u_x.astype(f32).reshape(u_x.shape[:2] + (S5_G, S5_CH))
    d = d_skip.astype(f32).reshape(S5_G, S5_CH)
    y_c = d * uc
    y_x = d * ux
    h0 = jnp.zeros((ux.shape[0], S5_G, S5_P), jnp.complex64)
    for di, reverse in enumerate((False, True)):
        lam_bar, b_bar = _s5_discretize(lam_re[di], lam_im[di], log_step[di], b_re[di], b_im[di])
        c_mat = lax.complex(c_re[di].astype(f32), c_im[di].astype(f32))
        h_c, h_fin = _s5_scan(jnp.einsum('blgc,gpc->blgp', uc, b_bar), lam_bar, h0, reverse)
        h_x, _ = _s5_scan(jnp.einsum('blgc,gpc->blgp', ux, b_bar), lam_bar, h_fin, reverse)
        y_x = y_x + jnp.einsum('blgp,gcp->blgc', h_x, c_mat).real
        if need_ctx:
            y_c = y_c + jnp.einsum('blgp,gcp->blgc', h_c, c_mat).real

    def glu(y, like):
        g = jax.nn.gelu(y.reshape(y.shape[:2] + (S5_W,))).astype(like.dtype)
        return g * jax.nn.sigmoid(g @ w_glu + b_glu)

    out_x = glu(y_x, u_x)
    out_c = glu(y_c, u_c) if need_ctx else None
    return out_c, out_x


def conv_module(pw, dw_w, dw_b, ln_g, ln_b, rows):
    a, b = jnp.split(pw, 2, axis=-1)
    g = a * jax.nn.sigmoid(b)
    bsz, length, ch = g.shape
    seqs = g.reshape(bsz * rows, length // rows, ch)
    y = lax.conv_general_dilated(seqs, dw_w[:, None, :], window_strides=(1,),
                                 padding=[(CONV_K // 2, CONV_K // 2)],
                                 dimension_numbers=('NWC', 'WIO', 'NWC'),
                                 feature_group_count=ch)
    y = y.reshape(bsz, length, ch) + dw_b
    return jax.nn.silu(_layernorm(y, ln_g, ln_b))


def _chunks(t):
    bsz, length = t.shape[:2]
    t = t.reshape((bsz, length // ML_CHUNK, ML_CHUNK) + t.shape[2:])
    return jnp.swapaxes(jnp.moveaxis(t, 1, 0), 2, 3)


def _unchunk(t):
    t = jnp.moveaxis(jnp.swapaxes(t, 2, 3), 0, 1)
    return t.reshape((t.shape[0], -1) + t.shape[3:])


def _mlstm_chunkwise(q, k, v, log_i, log_f, state):
    tril = jnp.tril(jnp.ones((ML_CHUNK, ML_CHUNK), bool))

    def step(carry, xs):
        cm, n, m = carry
        qc, kc, vc, li, lf = xs
        b = jnp.cumsum(lf, axis=-1)
        d_log = jnp.where(tril, b[..., :, None] - b[..., None, :] + li[..., None, :], -jnp.inf)
        inter = b + m[..., None]
        m_row = jnp.maximum(inter, jnp.max(d_log, axis=-1))
        s = jnp.einsum('bhjd,bhsd->bhjs', qc, kc) * jnp.exp(d_log - m_row[..., None])
        w_inter = jnp.exp(inter - m_row)
        num = jnp.einsum('bhjs,bhsv->bhjv', s, vc) + w_inter[..., None] * jnp.einsum('bhjd,bhdv->bhjv', qc, cm)
        den = jnp.sum(s, axis=-1) + w_inter * jnp.einsum('bhjd,bhd->bhj', qc, n)
        h = num / jnp.maximum(jnp.abs(den), jnp.exp(-m_row))[..., None]
        g = b[..., -1:] - b + li
        m_new = jnp.maximum(b[..., -1] + m, jnp.max(g, axis=-1))
        kw = kc * jnp.exp(g - m_new[..., None])[..., None]
        decay = jnp.exp(b[..., -1] + m - m_new)
        cm = decay[..., None, None] * cm + jnp.einsum('bhsd,bhsv->bhdv', kw, vc)
        n = decay[..., None] * n + jnp.sum(kw, axis=-2)
        return (cm, n, m_new), h

    xs = (_chunks(q), _chunks(k), _chunks(v), _chunks(log_i), _chunks(log_f))
    state, h = lax.scan(step, state, xs)
    return _unchunk(h), state


def _mlstm_dir(q, k, v, li, lf, state, reverse):
    if reverse:
        q, k, v, li, lf = (jnp.flip(t, axis=1) for t in (q, k, v, li, lf))
    h, state = _mlstm_chunkwise(q, k, v, li, lf, state)
    return (jnp.flip(h, axis=1) if reverse else h), state


def _mlstm_inputs(z):
    bsz, length = z.shape[:2]
    f32 = jnp.float32
    q = z[..., OFF_Q:OFF_K].astype(f32).reshape(bsz, length, ML_H, ML_DH)
    k = z[..., OFF_K:OFF_V].astype(f32).reshape(bsz, length, ML_H, ML_DH) * (ML_DH ** -0.5)
    v = z[..., OFF_V:OFF_O].astype(f32).reshape(bsz, length, ML_H, ML_DH)
    gates = z[..., OFF_G:IN_W].astype(f32).reshape(bsz, length, 4, ML_H)
    log_i = (gates[:, :, 0], gates[:, :, 2])
    log_f = (jax.nn.log_sigmoid(gates[:, :, 1]), jax.nn.log_sigmoid(gates[:, :, 3]))
    return q, k, v, log_i, log_f


def _mlstm_readout(h, z, norm_g):
    bsz, length = h.shape[:2]
    hc = h - jnp.mean(h, axis=-1, keepdims=True)
    var = jnp.mean(hc * hc, axis=-1, keepdims=True)
    h = (hc * lax.rsqrt(var + LN_EPS)).reshape(bsz, length, ML_W) * norm_g.astype(jnp.float32)
    o = jax.nn.sigmoid(z[..., OFF_O:OFF_G].astype(jnp.float32))
    return (o * h).astype(z.dtype)


def mlstm_mixer(zc, zx, norm_g, need_ctx):
    qc, kc, vc, lic, lfc = _mlstm_inputs(zc)
    qx, kx, vx, lix, lfx = _mlstm_inputs(zx)
    bsz = zx.shape[0]
    f32 = jnp.float32
    zero = (jnp.zeros((bsz, ML_H, ML_DH, ML_DH), f32), jnp.zeros((bsz, ML_H, ML_DH), f32),
            jnp.zeros((bsz, ML_H), f32))
    h_c_sum = 0.0
    h_x_sum = 0.0
    for di, reverse in enumerate((False, True)):
        h_c, st = _mlstm_dir(qc, kc, vc, lic[di], lfc[di], zero, reverse)
        h_x, _ = _mlstm_dir(qx, kx, vx, lix[di], lfx[di], st, reverse)
        h_c_sum = h_c_sum + h_c
        h_x_sum = h_x_sum + h_x
    out_x = _mlstm_readout(h_x_sum, zx, norm_g)
    out_c = _mlstm_readout(h_c_sum, zc, norm_g) if need_ctx else None
    return out_c, out_x


def setup_inputs(seed: int = 0) -> dict:
    key = jax.random.key(seed)
    ks = jax.random.split(key, 32)
    f32 = jnp.float32
    L = DEPTH

    def nrm(k, shape, s):
        return s * jax.random.normal(k, shape, f32)

    f_bias = jnp.linspace(3.0, 6.0, ML_H, dtype=f32)
    b_in = nrm(ks[8], (L, IN_W), 0.02)
    b_in = b_in.at[:, OFF_G + ML_H:OFF_G + 2 * ML_H].add(f_bias).at[:, OFF_G + 3 * ML_H:].add(f_bias)
    return {
        'x': nrm(ks[0], (BATCH, SEQ, D_MODEL), 1.0),
        'c': nrm(ks[1], (BATCH, D_MODEL), 1.0),
        'ctx': nrm(ks[2], (BATCH, CTX_LEN, D_MODEL), 1.0),
        'c_ctx': nrm(ks[3], (D_MODEL,), 1.0),
        'w_mod': nrm(ks[4], (L, D_MODEL, 6 * D_MODEL), 0.5 * D_MODEL ** -0.5),
        'b_mod': nrm(ks[5], (L, 6 * D_MODEL), 0.02),
        'norm1_g': 1.0 + nrm(ks[6], (L, D_MODEL), 0.02),
        'w_in': nrm(ks[7], (L, D_MODEL, IN_W), D_MODEL ** -0.5),
        'b_in': b_in,
        's5_lam_re': -0.5 + nrm(ks[9], (L, 2, S5_G, S5_P), 0.01),
        's5_lam_im': math.pi * jnp.arange(S5_P, dtype=f32) + nrm(ks[10], (L, 2, S5_G, S5_P), 0.01),
        's5_log_step': jax.random.uniform(ks[11], (L, 2, S5_G, S5_P), f32, math.log(1e-3), math.log(1e-1)),
        's5_b_re': nrm(ks[12], (L, 2, S5_G, S5_P, S5_CH), (2 * S5_CH) ** -0.5),
        's5_b_im': nrm(ks[13], (L, 2, S5_G, S5_P, S5_CH), (2 * S5_CH) ** -0.5),
        's5_c_re': nrm(ks[14], (L, 2, S5_G, S5_CH, S5_P), S5_P ** -0.5),
        's5_c_im': nrm(ks[15], (L, 2, S5_G, S5_CH, S5_P), S5_P ** -0.5),
        's5_d': nrm(ks[16], (L, S5_W), 1.0),
        's5_w_glu': nrm(ks[17], (L, S5_W, S5_W), S5_W ** -0.5),
        's5_b_glu': nrm(ks[18], (L, S5_W), 0.02),
        'conv_dw_w': nrm(ks[19], (L, CONV_K, CONV_W), CONV_K ** -0.5),
        'conv_dw_b': nrm(ks[20], (L, CONV_W), 0.02),
        'conv_ln_g': 1.0 + nrm(ks[21], (L, CONV_W), 0.02),
        'conv_ln_b': nrm(ks[22], (L, CONV_W), 0.02),
        'ml_norm_g': 1.0 + nrm(ks[23], (L, ML_W), 0.02),
        'w_out': nrm(ks[24], (L, MIX_W, D_MODEL), MIX_W ** -0.5),
        'norm2_g': 1.0 + nrm(ks[25], (L, D_MODEL), 0.02),
        'w_ffn_in': nrm(ks[26], (L, D_MODEL, 2 * D_FF), D_MODEL ** -0.5),
        'w_ffn_out': nrm(ks[27], (L, D_FF, D_MODEL), D_FF ** -0.5),
        'norm_f_g': 1.0 + nrm(ks[28], (D_MODEL,), 0.02),
    }


def reference(x, c, ctx, c_ctx, w_mod, b_mod, norm1_g, w_in, b_in, s5_lam_re, s5_lam_im,
              s5_log_step, s5_b_re, s5_b_im, s5_c_re, s5_c_im, s5_d, s5_w_glu, s5_b_glu,
              conv_dw_w, conv_dw_b, conv_ln_g, conv_ln_b, ml_norm_g, w_out, norm2_g,
              w_ffn_in, w_ffn_out, norm_f_g):
    rows = x.shape[1] // GRID_W
    for l in range(DEPTH):
        need_ctx = l < DEPTH - 1
        sh1_x, sc1_x, g1_x, sh2_x, sc2_x, g2_x = _adaln(c, w_mod[l], b_mod[l])
        sh1_c, sc1_c, g1_c, sh2_c, sc2_c, g2_c = _adaln(c_ctx, w_mod[l], b_mod[l])

        hx = _rmsnorm(x, norm1_g[l]) * (1.0 + sc1_x) + sh1_x
        hc = _rmsnorm(ctx, norm1_g[l]) * (1.0 + sc1_c) + sh1_c
        zx = hx @ w_in[l] + b_in[l]
        zc = hc @ w_in[l] + b_in[l]
        s5_c, s5_x = s5_mixer(zc[..., OFF_S5:OFF_CONV], zx[..., OFF_S5:OFF_CONV],
                              s5_lam_re[l], s5_lam_im[l], s5_log_step[l], s5_b_re[l], s5_b_im[l],
                              s5_c_re[l], s5_c_im[l], s5_d[l], s5_w_glu[l], s5_b_glu[l], need_ctx)
        ml_c, ml_x = mlstm_mixer(zc, zx, ml_norm_g[l], need_ctx)
        cv_x = conv_module(zx[..., OFF_CONV:OFF_Q], conv_dw_w[l], conv_dw_b[l],
                           conv_ln_g[l], conv_ln_b[l], rows)
        x = x + g1_x * (jnp.concatenate([s5_x, cv_x, ml_x], axis=-1) @ w_out[l])

        hx2 = _rmsnorm(x, norm2_g[l]) * (1.0 + sc2_x) + sh2_x
        x = x + g2_x * _swiglu(hx2, w_ffn_in[l], w_ffn_out[l])

        if need_ctx:
            cv_c = conv_module(zc[..., OFF_CONV:OFF_Q], conv_dw_w[l], conv_dw_b[l],
                               conv_ln_g[l], conv_ln_b[l], 1)
            ctx = ctx + g1_c * (jnp.concatenate([s5_c, cv_c, ml_c], axis=-1) @ w_out[l])
            hc2 = _rmsnorm(ctx, norm2_g[l]) * (1.0 + sc2_c) + sh2_c
            ctx = ctx + g2_c * _swiglu(hc2, w_ffn_in[l], w_ffn_out[l])
    return _rmsnorm(x, norm_f_g)
```

```cpp
#include <hip/hip_runtime.h>
#include <cstdio>
#include <cstdint>

#ifndef PHMASK
#define PHMASK 0x1ff
#endif
#ifndef PROMASK
#define PROMASK 1
#endif
#ifndef MK_SINGLE
#define MK_SINGLE 1
#endif

namespace pg8 {
#define PG8_LAS __attribute__((address_space(3)))
typedef unsigned short bf16_t;
typedef short bf16x8 __attribute__((ext_vector_type(8)));
typedef float f32x4 __attribute__((ext_vector_type(4)));
typedef float f32x2 __attribute__((ext_vector_type(2)));
typedef unsigned u32x4 __attribute__((ext_vector_type(4)));
constexpr int BM = 256, BK = 64, HALF = 128, HTB = HALF * BK * 2, STAGE_BYTES = 8 * HTB, NXCD = 8, WGM = 8;

__host__ __device__ __forceinline__ int lds_byte(int r, int c) { const int st = (r >> 4) * 2 + (c >> 5), rr = r & 15, cc = c & 31, ob = rr * 64 + cc * 2; return st * 1024 + (ob ^ (((ob >> 9) & 1) << 5)); }
__host__ __device__ __forceinline__ void stage_rc(int b, int& R, int& C) { const int st = b / 1024, sb = b % 1024, swz = sb ^ (((sb >> 9) & 1) << 5); R = (st >> 1) * 16 + swz / 64; C = (st & 1) * 32 + (swz % 64) / 2; }
__host__ __device__ __forceinline__ int perm32(int rho) { const int n = rho >> 4, i = rho & 15; return 8 * (i >> 2) + 4 * n + (i & 3); }

struct Unit { int pm, pn; };
struct Gemm { const bf16_t* A; const bf16_t* Bt; int lda, ldb, K; };

struct StaticOrder {
    int nM, nN, nwg, G, c;
    __host__ __device__ void init(int nM_, int nN_, int G_, int c_) { nM = nM_; nN = nN_; nwg = nM * nN; G = G_; c = c_; }
    __host__ __device__ bool next(int i, Unit& u) const {
        const long L = (long)i * G + c; if (L >= nwg) return false;
        int wgid = (int)L; { const int q = nwg / NXCD, r = nwg % NXCD, xcd = wgid % NXCD, off = wgid / NXCD; wgid = (xcd < r ? xcd * (q + 1) : r * (q + 1) + (xcd - r) * q) + off; }
        const int nig = WGM * nN, gid = wgid / nig, fm = gid * WGM, gsz = (nM - fm) < WGM ? (nM - fm) : WGM;
        u.pm = fm + ((wgid % nig) % gsz); u.pn = (wgid % nig) / gsz; return true;
    }
};

__device__ __forceinline__ unsigned cvt_pk_bf16(float lo, float hi) { unsigned r; asm volatile("v_cvt_pk_bf16_f32 %0, %1, %2" : "=v"(r) : "v"(lo), "v"(hi)); return r; }

template <class Epi, class Sched, bool ALIGN_EPI = false, bool SP2 = false>
__device__ __forceinline__ void gemm_phase(PG8_LAS unsigned char* lds, const Gemm g, const Sched& S, const Epi& E) {
    int tid_o = threadIdx.x; asm volatile("" : "+v"(tid_o));
    const int tid = tid_o, wid = __builtin_amdgcn_readfirstlane(tid >> 6), lane = tid & 63, wr = wid >> 2, wc = wid & 3, fr = lane & 15, fq = lane >> 4;
    const int K = g.K, nt = K / BK;
    unsigned voffA[2], voffB[2];
#pragma unroll
    for (int i = 0; i < 2; ++i) { int R, C; stage_rc(tid * 16 + i * 8192, R, C); const int Rb = Epi::PERM ? ((R & ~31) + perm32(R & 31)) : R;
        voffA[i] = (unsigned)(R * g.lda + C) * 2u; voffB[i] = (unsigned)(Rb * g.ldb + C) * 2u; }
    const size_t kstep = (size_t)(BK * 2);
    const size_t hstepA = (size_t)HALF * g.lda * 2, hstepB = (size_t)HALF * g.ldb * 2;
    const size_t tstepA = 2 * hstepA, tstepB = 2 * hstepB;
    const unsigned ldsw = (unsigned)wid * 1024u;
    const int aoff = lds_byte(wr * 64 + fr, fq * 8), boff = lds_byte(wc * 32 + fr, fq * 8);
#define PG8_SA(b, h) (((b) * 2 + (h)) * HTB)
#define PG8_SB(b, h) ((4 + (b) * 2 + (h)) * HTB)
#define PG8_STAGE(bufoff, gbase, voff) do { _Pragma("unroll") for (int _i = 0; _i < 2; ++_i) \
        __builtin_amdgcn_global_load_lds((const unsigned*)((const char*)(gbase) + (voff)[_i]), (PG8_LAS unsigned*)(lds + (bufoff) + ldsw + _i * 8192), 16, 0, 0); } while (0)
#define PG8_LDA(dst, b, h) do { _Pragma("unroll") for (int m = 0; m < 4; ++m) _Pragma("unroll") for (int k = 0; k < 2; ++k) dst[m][k] = *(const PG8_LAS bf16x8*)(lds + PG8_SA(b, h) + aoff + m * 2048 + k * 1024); } while (0)
#define PG8_LDB(dst, b, h) do { _Pragma("unroll") for (int n = 0; n < 2; ++n) _Pragma("unroll") for (int k = 0; k < 2; ++k) dst[n][k] = *(const PG8_LAS bf16x8*)(lds + PG8_SB(b, h) + boff + n * 2048 + k * 1024); } while (0)
#define PG8_MMA(ai, bj, At, Bt) do { __builtin_amdgcn_s_setprio(1); _Pragma("unroll") for (int m = 0; m < 4; ++m) _Pragma("unroll") for (int n = 0; n < 2; ++n) _Pragma("unroll") for (int k = 0; k < 2; ++k) \
        acc[ai][bj][m][n] = __builtin_amdgcn_mfma_f32_16x16x32_bf16(Bt[n][k], At[m][k], acc[ai][bj][m][n], 0, 0, 0); __builtin_amdgcn_s_setprio(0); } while (0)
#define PG8_WAIT_V(n) asm volatile("s_waitcnt vmcnt(" #n ")" ::: "memory")
#define PG8_WAIT_L(n) asm volatile("s_waitcnt lgkmcnt(" #n ")" ::: "memory")
#define PG8_BAR __builtin_amdgcn_s_barrier()
#define PG8_SCHED __builtin_amdgcn_sched_barrier(0)
    Unit cur, nxt; int ui = 0;
    if (!S.next(0, cur)) return;
    f32x4 acc[2][2][4][2];
#pragma unroll
    for (int a = 0; a < 2; ++a)
#pragma unroll
        for (int b = 0; b < 2; ++b)
#pragma unroll
            for (int m = 0; m < 4; ++m)
#pragma unroll
                for (int n = 0; n < 2; ++n) acc[a][b][m][n] = (f32x4){0.f, 0.f, 0.f, 0.f};
    bf16x8 At[4][2], B0[2][2], B1[2][2];
    const char* cA = (const char*)g.A + (size_t)cur.pm * tstepA; const char* cB = (const char*)g.Bt + (size_t)cur.pn * tstepB;
    if constexpr (SP2) {
        PG8_STAGE(PG8_SB(0, 0), cB, voffB); PG8_STAGE(PG8_SB(0, 1), cB + hstepB, voffB); PG8_STAGE(PG8_SA(0, 0), cA, voffA); PG8_STAGE(PG8_SA(0, 1), cA + hstepA, voffA);
        if (wr == 1) PG8_BAR;
        PG8_WAIT_V(2); PG8_BAR;
        PG8_STAGE(PG8_SB(1, 0), cB + kstep, voffB); PG8_STAGE(PG8_SA(1, 0), cA + kstep, voffA); PG8_STAGE(PG8_SB(1, 1), cB + hstepB + kstep, voffB);
        PG8_WAIT_V(6); PG8_BAR;
    } else {
        PG8_STAGE(PG8_SB(0, 0), cB, voffB); PG8_STAGE(PG8_SA(0, 0), cA, voffA); PG8_STAGE(PG8_SB(0, 1), cB + hstepB, voffB); PG8_STAGE(PG8_SA(0, 1), cA + hstepA, voffA);
        if (wr == 1) PG8_BAR;
        PG8_WAIT_V(4); PG8_BAR;
        PG8_STAGE(PG8_SB(1, 0), cB + kstep, voffB); PG8_STAGE(PG8_SA(1, 0), cA + kstep, voffA); PG8_STAGE(PG8_SB(1, 1), cB + hstepB + kstep, voffB);
        PG8_WAIT_V(6); PG8_BAR;
    }
    for (;;) {
        const bool has_next = S.next(ui + 1, nxt);
        const char* nA = has_next ? (const char*)g.A + (size_t)nxt.pm * tstepA : cA; const char* nB = has_next ? (const char*)g.Bt + (size_t)nxt.pn * tstepB : cB;
        for (int t = 0; t < nt; t += 2) {
            const bool last = (t == nt - 2);
            const char* a1 = cA + (size_t)(t + 1) * kstep;
            const char* a2 = last ? nA : cA + (size_t)(t + 2) * kstep; const char* b2 = last ? nB : cB + (size_t)(t + 2) * kstep;
            const char* a3 = a2 + kstep; const char* b3 = b2 + kstep;
            if constexpr (SP2) {
            PG8_LDB(B0, 0, 0); PG8_LDB(B1, 0, 1); PG8_SCHED; PG8_LDA(At, 0, 0); PG8_STAGE(PG8_SA(1, 1), a1 + hstepA, voffA);
            PG8_WAIT_V(8); PG8_WAIT_L(0); PG8_BAR; PG8_MMA(0, 0, At, B0); PG8_MMA(0, 1, At, B1); PG8_BAR; PG8_SCHED;
            PG8_LDA(At, 0, 1); PG8_STAGE(PG8_SB(0, 0), b2, voffB); PG8_STAGE(PG8_SB(0, 1), b2 + hstepB, voffB); PG8_STAGE(PG8_SA(0, 0), a2, voffA);
            PG8_WAIT_V(8); PG8_WAIT_L(0); PG8_BAR; PG8_MMA(1, 0, At, B0); PG8_MMA(1, 1, At, B1); PG8_BAR; PG8_SCHED;
            PG8_LDB(B0, 1, 0); PG8_LDB(B1, 1, 1); PG8_SCHED; PG8_LDA(At, 1, 0); PG8_STAGE(PG8_SA(0, 1), a2 + hstepA, voffA);
            PG8_WAIT_V(8); PG8_WAIT_L(0); PG8_BAR; PG8_MMA(0, 0, At, B0); PG8_MMA(0, 1, At, B1); PG8_BAR; PG8_SCHED;
            PG8_LDA(At, 1, 1); PG8_STAGE(PG8_SB(1, 0), b3, voffB); PG8_STAGE(PG8_SB(1, 1), b3 + hstepB, voffB); PG8_STAGE(PG8_SA(1, 0), a3, voffA);
            PG8_WAIT_V(8); PG8_WAIT_L(0); PG8_BAR; PG8_MMA(1, 0, At, B0); PG8_MMA(1, 1, At, B1); PG8_BAR; PG8_SCHED;
            } else {
            PG8_LDB(B0, 0, 0); PG8_SCHED; PG8_LDA(At, 0, 0); PG8_STAGE(PG8_SA(1, 1), a1 + hstepA, voffA);
            PG8_WAIT_L(8); PG8_BAR; PG8_WAIT_L(0); PG8_MMA(0, 0, At, B0); PG8_BAR; PG8_SCHED;
            PG8_LDB(B1, 0, 1); PG8_STAGE(PG8_SB(0, 0), b2, voffB);
            PG8_BAR; PG8_WAIT_L(0); PG8_MMA(0, 1, At, B1); PG8_BAR;
            PG8_LDA(At, 0, 1); PG8_STAGE(PG8_SA(0, 0), a2, voffA);
            PG8_BAR; PG8_WAIT_L(0); PG8_MMA(1, 0, At, B0); PG8_BAR; PG8_SCHED;
            PG8_STAGE(PG8_SB(0, 1), b2 + hstepB, voffB);
            PG8_WAIT_V(6); PG8_BAR; PG8_MMA(1, 1, At, B1); PG8_BAR;
            PG8_LDB(B0, 1, 0); PG8_SCHED; PG8_LDA(At, 1, 0); PG8_STAGE(PG8_SA(0, 1), a2 + hstepA, voffA);
            PG8_WAIT_L(8); PG8_BAR; PG8_WAIT_L(0); PG8_MMA(0, 0, At, B0); PG8_BAR; PG8_SCHED;
            PG8_LDB(B1, 1, 1); PG8_STAGE(PG8_SB(1, 0), b3, voffB);
            PG8_BAR; PG8_WAIT_L(0); PG8_MMA(0, 1, At, B1); PG8_BAR;
            PG8_LDA(At, 1, 1); PG8_STAGE(PG8_SA(1, 0), a3, voffA);
            PG8_BAR; PG8_WAIT_L(0); PG8_MMA(1, 0, At, B0); PG8_BAR; PG8_SCHED;
            PG8_STAGE(PG8_SB(1, 1), b3 + hstepB, voffB);
            PG8_WAIT_V(6); PG8_BAR; PG8_MMA(1, 1, At, B1); PG8_BAR;
            }
        }
        if constexpr (ALIGN_EPI) { if (wr == 0) PG8_BAR; }
        E(acc, cur, wr, wc, fr, fq);
        if (!has_next) break;
#pragma unroll
        for (int a = 0; a < 2; ++a)
#pragma unroll
            for (int b = 0; b < 2; ++b)
#pragma unroll
                for (int m = 0; m < 4; ++m)
#pragma unroll
                    for (int n = 0; n < 2; ++n) acc[a][b][m][n] = (f32x4){0.f, 0.f, 0.f, 0.f};
        cur = nxt; cA = nA; cB = nB; ++ui;
        if constexpr (ALIGN_EPI) { if (wr == 1) PG8_BAR; }
    }
    PG8_WAIT_V(0);
    if constexpr (!ALIGN_EPI) { if (wr == 0) PG8_BAR; }
    PG8_BAR;
#undef PG8_SA
#undef PG8_SB
#undef PG8_STAGE
#undef PG8_LDA
#undef PG8_LDB
#undef PG8_MMA
#undef PG8_WAIT_V
#undef PG8_WAIT_L
#undef PG8_BAR
#undef PG8_SCHED
}
}

constexpr int D = 2048, SEQ = 8192, CTXL = 256, R = SEQ + CTXL, DEPTH = 4, NPAN = R / 256;
constexpr int S5W = 512, S5G = 32, S5CH = 16, S5P = 64, CONVW = 512, CONVK = 31, MLW = 1024, MLH = 4, DH = 256, DFF = 5632;
constexpr int INW = 5648, NIN = 5888;
constexpr int OFF_CONV = 512, OFF_Q = 1536, OFF_K = 2560, OFF_V = 3584, OFF_O = 4608, OFF_G = 5632;
constexpr float EPS = 1e-6f, LN_EPS = 1e-5f;
constexpr int UROWS = 768, UPITCH = 512;

constexpr size_t MiB = 1u << 20;
constexpr size_t WS_CTL = 0, CTL_ZERO_BYTES = 1 * MiB;
constexpr size_t WS_MOD = 1 * MiB;
constexpr size_t WS_XR = 2 * MiB;
constexpr size_t WS_HN = 68 * MiB;
constexpr size_t WS_U = 101 * MiB;
constexpr size_t WS_CG = 125 * MiB;
constexpr size_t WS_Q = 134 * MiB, WS_K = 151 * MiB, WS_V = 168 * MiB;
constexpr size_t WS_O = 185 * MiB;
constexpr size_t WS_GATES = 202 * MiB;
constexpr size_t WS_MIX = 203 * MiB;
constexpr size_t WS_HFF = 236 * MiB;
constexpr size_t WS_YS = 327 * MiB;
constexpr size_t WS_S5G = 360 * MiB;
constexpr size_t WS_HML = 369 * MiB;
constexpr size_t WS_W = 436 * MiB;
constexpr size_t WL_IN = 0, WL_OUT = 23 * MiB, WL_FI = 31 * MiB, WL_FO = 75 * MiB, WL_GLU = 97 * MiB, WL_STRIDE = 98 * MiB;
constexpr size_t WS_END = WS_W + DEPTH * WL_STRIDE;
constexpr int CW_BAR = 4096;

constexpr int RING_BYTES = 131072, LDSCTL_OFF = RING_BYTES, MISC_OFF = LDSCTL_OFF + 320, LDS_BYTES = 147456;
constexpr int NWAVES = 8, NTHR = 512;

#define GAS __attribute__((address_space(1)))
#define LAS __attribute__((address_space(3)))
typedef unsigned short bf16;
typedef unsigned v4u __attribute__((ext_vector_type(4)));
typedef unsigned v2u __attribute__((ext_vector_type(2)));
typedef float f32x4 __attribute__((ext_vector_type(4)));
typedef GAS unsigned gu32;
#define RLX_AGENT __ATOMIC_RELAXED, __HIP_MEMORY_SCOPE_AGENT
#define LDS_WAIT() asm volatile("s_waitcnt lgkmcnt(0)" ::: "memory")
__device__ __forceinline__ unsigned f2bf(float f) { unsigned u = __builtin_bit_cast(unsigned, f); return (u + 0x7fffu + ((u >> 16) & 1u)) >> 16; }
__device__ __forceinline__ unsigned pk2(float lo, float hi) { return f2bf(lo) | (f2bf(hi) << 16); }
__device__ __forceinline__ float bf2f(unsigned short b) { return __builtin_bit_cast(float, ((unsigned)b) << 16); }
__device__ __forceinline__ float bflo(unsigned w) { return __builtin_bit_cast(float, w << 16); }
__device__ __forceinline__ float bfhi(unsigned w) { return __builtin_bit_cast(float, w & 0xffff0000u); }
__device__ __forceinline__ float sigmoidf_(float x) { return 1.f / (1.f + __expf(-x)); }
__device__ __forceinline__ float siluf_(float x) { return x / (1.f + __expf(-x)); }
__device__ __forceinline__ float gelu_tanh_(float x) { const float u = 0.7978845608028654f * (x + 0.044715f * x * x * x); return x * (1.f / (1.f + __expf(-2.f * u))); }
__device__ __forceinline__ float wave_sum(float v) {
#pragma unroll
    for (int o = 1; o < 64; o <<= 1) v += __shfl_xor(v, o);
    return v;
}
__device__ __forceinline__ int tau_row(int d, int tau) { return d == 0 ? tau : (tau < CTXL ? CTXL - 1 - tau : (R - 1 + CTXL) - tau); }

#define XB_TMO      128
#define XB_XCNT(j)  (256  + 64 * (j))
#define XB_XSUB(j)  (1280 + 64 * (j))
#define XB_XGEN(j)  (2304 + 64 * (j))
#define XB_TOP      3328
#define XB_TOPGEN   3392
#define XCD_BAR_WORDS 3456
#define XB_SPIN_CAP (1u << 22)
__device__ __forceinline__ unsigned xb_ld(unsigned* p)              { return __hip_atomic_load(p, __ATOMIC_RELAXED, __HIP_MEMORY_SCOPE_AGENT); }
__device__ __forceinline__ unsigned xb_add(unsigned* p, unsigned v) { return __hip_atomic_fetch_add(p, v, __ATOMIC_RELAXED, __HIP_MEMORY_SCOPE_AGENT); }
__device__ __forceinline__ unsigned xb_xcc_id() { return (unsigned)__builtin_amdgcn_s_getreg((3 << 11) | 20) & 0xFu; }
#define XB_SPIN(cond, bar) do { unsigned _sp = 0; while (cond) { __builtin_amdgcn_s_sleep(1); \
    if ((++_sp & 255u) == 0u) { if (xb_ld(&(bar)[XB_TMO])) break; if (_sp > XB_SPIN_CAP) { atomicAdd(&(bar)[XB_TMO], 1u); break; } } } } while (0)
struct XcdBarrier { unsigned* bar; unsigned x; volatile LAS unsigned* st; };
__device__ __forceinline__ XcdBarrier xcd_barrier_post(unsigned* bar, volatile LAS unsigned* st) {
    XcdBarrier b; b.bar = bar; b.x = xb_xcc_id(); b.st = st;
    if (threadIdx.x == 0) (void)xb_add(&bar[XB_XCNT(b.x)], 1u);
    return b;
}
__device__ __forceinline__ void xcd_barrier_complete(unsigned* bar, unsigned x, unsigned& nloc, unsigned& nx) {
    const unsigned G = gridDim.x * gridDim.y * gridDim.z;
    unsigned sum, cnt, mine, sp = 0u;
    for (;;) {
        sum = 0u; cnt = 0u; mine = 0u;
#pragma unroll
        for (unsigned j = 0; j < 16; ++j) { const unsigned c = xb_ld(&bar[XB_XCNT(j)]); sum += c; cnt += (c > 0u) ? 1u : 0u; mine = (j == x) ? c : mine; }
        if (sum == G) break;
        __builtin_amdgcn_s_sleep(1);
        if ((++sp & 255u) == 0u) { if (xb_ld(&bar[XB_TMO])) break; if (sp > XB_SPIN_CAP) { atomicAdd(&bar[XB_TMO], 1u); break; } }
    }
    nloc = mine > 0u ? mine : 1u; nx = cnt > 0u ? cnt : 1u;
}
__device__ __forceinline__ void xcd_barrier(const XcdBarrier& b) {
    asm volatile("s_waitcnt vmcnt(0)" ::: "memory");
    __syncthreads();
    if (threadIdx.x == 0) {
        unsigned* bar = b.bar;
        __builtin_amdgcn_s_waitcnt(0);
        unsigned nloc = b.st[0], nx = b.st[1];
        if (nloc == 0u) { xcd_barrier_complete(bar, b.x, nloc, nx); b.st[0] = nloc; b.st[1] = nx; }
        const unsigned old = xb_add(&bar[XB_XSUB(b.x)], 1u);
        const unsigned gen = old / nloc;
        if (old + 1u == (gen + 1u) * nloc) {
            __builtin_amdgcn_fence(__ATOMIC_RELEASE, "agent");
            asm volatile("s_waitcnt vmcnt(0)" ::: "memory");
            const unsigned og = xb_add(&bar[XB_TOP], 1u);
            const unsigned tg = og / nx;
            if (og + 1u == (tg + 1u) * nx) xb_add(&bar[XB_TOPGEN], 1u);
            else XB_SPIN(xb_ld(&bar[XB_TOPGEN]) == tg, bar);
            __builtin_amdgcn_fence(__ATOMIC_ACQUIRE, "agent");
            xb_add(&bar[XB_XGEN(b.x)], 1u);
            asm volatile("s_waitcnt vmcnt(0)" ::: "memory");
        } else {
            XB_SPIN(xb_ld(&bar[XB_XGEN(b.x)]) == gen, bar);
            __builtin_amdgcn_fence(__ATOMIC_ACQUIRE, "agent");
            asm volatile("s_waitcnt vmcnt(0)" ::: "memory");
        }
    }
    __syncthreads();
}

struct Args {
    const float *x, *c, *ctx, *c_ctx, *w_mod, *b_mod, *norm1_g, *w_in, *b_in, *s5_lam_re, *s5_lam_im, *s5_log_step, *s5_b_re, *s5_b_im, *s5_c_re, *s5_c_im,
                *s5_d, *s5_w_glu, *s5_b_glu, *conv_dw_w, *conv_dw_b, *conv_ln_g, *conv_ln_b, *ml_norm_g, *w_out, *norm2_g, *w_ffn_in, *w_ffn_out, *norm_f_g;
    float* out; unsigned char* ws;
    int l_lo, l_hi, ph_lo, ph_hi, do_pro, do_fin, use_bar, pad;
};

__device__ __forceinline__ void transpose_item(const float* W, int Nsrc, bf16* WT, int ldt, int k0, int n0d, int n0s, int nvalid, LAS float* scr, int lane) {
#pragma unroll 8
    for (int i = 0; i < 32; ++i) { const int kk = 2 * i + (lane >> 5), nn = lane & 31; scr[kk * 33 + nn] = nn < nvalid ? W[(size_t)(k0 + kk) * Nsrc + n0s + nn] : 0.f; }
    LDS_WAIT(); asm volatile("" ::: "memory");
    const int c = lane & 7;
#pragma unroll
    for (int j = 0; j < 4; ++j) { const int n = (lane >> 3) + 8 * j; const LAS float* s = scr + (8 * c) * 33 + n;
        v4u o; o.x = pk2(s[0 * 33], s[1 * 33]); o.y = pk2(s[2 * 33], s[3 * 33]); o.z = pk2(s[4 * 33], s[5 * 33]); o.w = pk2(s[6 * 33], s[7 * 33]);
        *(GAS v4u*)(WT + (size_t)(n0d + n) * ldt + k0 + 8 * c) = o; }
    LDS_WAIT(); asm volatile("" ::: "memory");
}
__device__ __forceinline__ int win_src(int nd) {
    if (nd >= OFF_CONV && nd < OFF_Q) { const int t = (nd - OFF_CONV) >> 8, w = (nd - OFF_CONV) & 255; return w < 128 ? OFF_CONV + t * 128 + w : OFF_CONV + CONVW + t * 128 + (w - 128); }
    return nd;
}
__device__ __forceinline__ int wfi_src(int nd) { const int t = nd >> 8, w = nd & 255; return w < 128 ? t * 128 + w : DFF + t * 128 + (w - 128); }

using pg8::f32x2;
struct EpiWin {
    static constexpr bool PERM = true;
    const float* bias; bf16 *U, *CG, *Q, *Kb, *V, *O; float* GATES;
    __device__ __forceinline__ void operator()(const f32x4 (&acc)[2][2][4][2], const pg8::Unit& u, int wr, int wc, int fr, int fq) const {
        const int row0 = u.pm * 256 + wr * 64 + fr, pn = u.pn, cw0 = wc * 32 + 8 * fq;
        if (pn < 2) {
#pragma unroll
            for (int bj = 0; bj < 2; ++bj) { const int col = pn * 256 + bj * 128 + cw0, g = col >> 4, ch0 = col & 15;
                const f32x4 b0 = *(const f32x4*)(bias + col), b1 = *(const f32x4*)(bias + col + 4);
#pragma unroll
                for (int ai = 0; ai < 2; ++ai)
#pragma unroll
                    for (int m = 0; m < 4; ++m) { const int r = row0 + ai * 128 + m * 16; const f32x4 v0 = acc[ai][bj][m][0] + b0, v1 = acc[ai][bj][m][1] + b1;
                        v4u w; w.x = pk2(v0[0], v0[1]); w.y = pk2(v0[2], v0[3]); w.z = pk2(v1[0], v1[1]); w.w = pk2(v1[2], v1[3]);
                        *(v4u*)(U + ((size_t)g * UROWS + (r >> 4)) * UPITCH + (r & 15) * 16 + ch0) = w; } }
        } else if (pn < 6) {
            const int ch = (pn - 2) * 128 + cw0;
            const f32x4 a0 = *(const f32x4*)(bias + OFF_CONV + ch), a1 = *(const f32x4*)(bias + OFF_CONV + ch + 4), b0 = *(const f32x4*)(bias + OFF_CONV + CONVW + ch), b1 = *(const f32x4*)(bias + OFF_CONV + CONVW + ch + 4);
#pragma unroll
            for (int ai = 0; ai < 2; ++ai)
#pragma unroll
                for (int m = 0; m < 4; ++m) { const int r = row0 + ai * 128 + m * 16;
                    const f32x4 x0 = acc[ai][0][m][0] + a0, x1 = acc[ai][0][m][1] + a1, y0 = acc[ai][1][m][0] + b0, y1 = acc[ai][1][m][1] + b1; float o[8];
#pragma unroll
                    for (int j = 0; j < 4; ++j) { o[j] = x0[j] * sigmoidf_(y0[j]); o[4 + j] = x1[j] * sigmoidf_(y1[j]); }
                    v4u w; w.x = pk2(o[0], o[1]); w.y = pk2(o[2], o[3]); w.z = pk2(o[4], o[5]); w.w = pk2(o[6], o[7]);
                    *(v4u*)(CG + (size_t)r * CONVW + ch) = w; }
        } else if (pn < 22) {
            const int which = (pn - 6) >> 2, h = (pn - 6) & 3; const float sc = which == 1 ? 0.0625f : 1.f;
            bf16* base; size_t pitch;
            if (which == 0) { base = Q + (size_t)h * R * 256; pitch = 256; } else if (which == 1) { base = Kb + (size_t)h * R * 256; pitch = 256; }
            else if (which == 2) { base = V + (size_t)h * R * 256; pitch = 256; } else { base = O + h * 256; pitch = 1024; }
#pragma unroll
            for (int bj = 0; bj < 2; ++bj) { const int cw = bj * 128 + cw0; const f32x4 b0 = *(const f32x4*)(bias + pn * 256 + cw), b1 = *(const f32x4*)(bias + pn * 256 + cw + 4);
#pragma unroll
                for (int ai = 0; ai < 2; ++ai)
#pragma unroll
                    for (int m = 0; m < 4; ++m) { const int r = row0 + ai * 128 + m * 16; const f32x4 v0 = (acc[ai][bj][m][0] + b0) * sc, v1 = (acc[ai][bj][m][1] + b1) * sc;
                        v4u w; w.x = pk2(v0[0], v0[1]); w.y = pk2(v0[2], v0[3]); w.z = pk2(v1[0], v1[1]); w.w = pk2(v1[2], v1[3]);
                        *(v4u*)(base + (size_t)r * pitch + cw) = w; } }
        } else {
            if (wc == 0 && fq < 2) { const f32x4 b0 = *(const f32x4*)(bias + OFF_G + 8 * fq), b1 = *(const f32x4*)(bias + OFF_G + 8 * fq + 4);
#pragma unroll
                for (int ai = 0; ai < 2; ++ai)
#pragma unroll
                    for (int m = 0; m < 4; ++m) { const int r = row0 + ai * 128 + m * 16;
                        *(f32x4*)(GATES + (size_t)r * 16 + 8 * fq) = acc[ai][0][m][0] + b0; *(f32x4*)(GATES + (size_t)r * 16 + 8 * fq + 4) = acc[ai][0][m][1] + b1; } }
        }
    }
};
struct EpiRes {
    static constexpr bool PERM = false;
    float* XR; const float* gate_c; const float* gate_x;
    __device__ __forceinline__ void operator()(const f32x4 (&acc)[2][2][4][2], const pg8::Unit& u, int wr, int wc, int fr, int fq) const {
        const int row0 = u.pm * 256 + wr * 64 + fr, col0 = u.pn * 256 + wc * 32 + 4 * fq; const float* gate = u.pm == 0 ? gate_c : gate_x;
        f32x4 gv[2][2];
#pragma unroll
        for (int bj = 0; bj < 2; ++bj)
#pragma unroll
            for (int n = 0; n < 2; ++n) gv[bj][n] = *(const f32x4*)(gate + col0 + bj * 128 + n * 16);
#pragma unroll
        for (int ai = 0; ai < 2; ++ai)
#pragma unroll
            for (int m = 0; m < 4; ++m) { float* rowp = XR + (size_t)(row0 + ai * 128 + m * 16) * D + col0;
#pragma unroll
                for (int bj = 0; bj < 2; ++bj)
#pragma unroll
                    for (int n = 0; n < 2; ++n) { f32x4* p = (f32x4*)(rowp + bj * 128 + n * 16); *p = *p + gv[bj][n] * acc[ai][bj][m][n]; } }
    }
};
struct EpiSwiglu {
    static constexpr bool PERM = true;
    bf16* HFF;
    __device__ __forceinline__ void operator()(const f32x4 (&acc)[2][2][4][2], const pg8::Unit& u, int wr, int wc, int fr, int fq) const {
        const int row0 = u.pm * 256 + wr * 64 + fr, hc = u.pn * 128 + wc * 32 + 8 * fq;
#pragma unroll
        for (int ai = 0; ai < 2; ++ai)
#pragma unroll
            for (int m = 0; m < 4; ++m) { const int r = row0 + ai * 128 + m * 16; float o[8];
#pragma unroll
                for (int j = 0; j < 4; ++j) { o[j] = siluf_(acc[ai][0][m][0][j]) * acc[ai][1][m][0][j]; o[4 + j] = siluf_(acc[ai][0][m][1][j]) * acc[ai][1][m][1][j]; }
                v4u w; w.x = pk2(o[0], o[1]); w.y = pk2(o[2], o[3]); w.z = pk2(o[4], o[5]); w.w = pk2(o[6], o[7]);
                *(v4u*)(HFF + (size_t)r * DFF + hc) = w; }
    }
};
struct EpiGlu {
    static constexpr bool PERM = true;
    const bf16* S5Gb; const float* bias; bf16* MIX;
    __device__ __forceinline__ void operator()(const f32x4 (&acc)[2][2][4][2], const pg8::Unit& u, int wr, int wc, int fr, int fq) const {
        const int row0 = u.pm * 256 + wr * 64 + fr;
#pragma unroll
        for (int bj = 0; bj < 2; ++bj) { const int col = u.pn * 256 + bj * 128 + wc * 32 + 8 * fq; const f32x4 b0 = *(const f32x4*)(bias + col), b1 = *(const f32x4*)(bias + col + 4);
#pragma unroll
            for (int ai = 0; ai < 2; ++ai)
#pragma unroll
                for (int m = 0; m < 4; ++m) { const int r = row0 + ai * 128 + m * 16; const v4u gw = *(const v4u*)(S5Gb + (size_t)r * S5W + col);
                    const f32x4 v0 = acc[ai][bj][m][0] + b0, v1 = acc[ai][bj][m][1] + b1; float o[8];
                    o[0] = bflo(gw.x) * sigmoidf_(v0[0]); o[1] = bfhi(gw.x) * sigmoidf_(v0[1]); o[2] = bflo(gw.y) * sigmoidf_(v0[2]); o[3] = bfhi(gw.y) * sigmoidf_(v0[3]);
                    o[4] = bflo(gw.z) * sigmoidf_(v1[0]); o[5] = bfhi(gw.z) * sigmoidf_(v1[1]); o[6] = bflo(gw.w) * sigmoidf_(v1[2]); o[7] = bfhi(gw.w) * sigmoidf_(v1[3]);
                    v4u w; w.x = pk2(o[0], o[1]); w.y = pk2(o[2], o[3]); w.z = pk2(o[4], o[5]); w.w = pk2(o[6], o[7]);
                    *(v4u*)(MIX + (size_t)r * D + col) = w; } }
    }
};

constexpr int NPH = 9;
__global__ void __launch_bounds__(NTHR, 2) fwd(Args a) {
    extern __shared__ __attribute__((aligned(16))) unsigned char lds_raw[];
    LAS unsigned char* lds = (LAS unsigned char*)lds_raw;
    volatile LAS unsigned* MISC = (volatile LAS unsigned*)(lds + MISC_OFF);
    const int tid = threadIdx.x, lane = tid & 63, wave = __builtin_amdgcn_readfirstlane(tid >> 6);
    const int G = gridDim.x, bid = blockIdx.x, NGW = G * NWAVES;
    unsigned char* ws = a.ws;
    gu32* ctl = (gu32*)(ws + WS_CTL);
    float* MOD = (float*)(ws + WS_MOD); float* XR = (float*)(ws + WS_XR); bf16* HN = (bf16*)(ws + WS_HN); bf16* U = (bf16*)(ws + WS_U); bf16* CG = (bf16*)(ws + WS_CG);
    bf16* Qb = (bf16*)(ws + WS_Q); bf16* Kb = (bf16*)(ws + WS_K); bf16* Vb = (bf16*)(ws + WS_V); bf16* Ob = (bf16*)(ws + WS_O); float* GATES = (float*)(ws + WS_GATES);
    bf16* MIX = (bf16*)(ws + WS_MIX); bf16* HFF = (bf16*)(ws + WS_HFF); float* YS = (float*)(ws + WS_YS); bf16* S5Gb = (bf16*)(ws + WS_S5G); float* HML = (float*)(ws + WS_HML);
    for (int u = tid; u < (LDS_BYTES - LDSCTL_OFF) / 4; u += NTHR) ((LAS unsigned*)(lds + LDSCTL_OFF))[u] = 0u;
    __syncthreads();
    XcdBarrier bar; bar.bar = (unsigned*)(ctl + CW_BAR); bar.x = 0; bar.st = nullptr;
    if (a.use_bar) bar = xcd_barrier_post((unsigned*)(ctl + CW_BAR), MISC + 8);
#define GRID_BAR() do { if (a.use_bar) xcd_barrier(bar); } while (0)
#define PH_IDS int tid = threadIdx.x; asm volatile("" : "+v"(tid)); const int lane = tid & 63, wave = __builtin_amdgcn_readfirstlane(tid >> 6), gw = bid * NWAVES + wave; (void)lane; (void)gw;

    if (PROMASK && a.do_pro) { PH_IDS
        {
            const size_t n4 = (size_t)R * D / 4, nc4 = (size_t)CTXL * D / 4;
            for (size_t i = (size_t)bid * NTHR + tid; i < n4; i += (size_t)G * NTHR) ((f32x4*)XR)[i] = i < nc4 ? ((const f32x4*)a.ctx)[i] : ((const f32x4*)a.x)[i - nc4];
        }
        {
            LAS float* scr = (LAS float*)(lds + wave * 16384);
            constexpr int I_IN = (D / 64) * (NIN / 32), I_OUT = (D / 64) * (D / 32), I_FI = (D / 64) * (2 * DFF / 32), I_FO = (DFF / 64) * (D / 32), I_GLU = (S5W / 64) * (S5W / 32);
            constexpr int I_L = I_IN + I_OUT + I_FI + I_FO + I_GLU;
            for (int it = gw; it < DEPTH * I_L; it += NGW) {
                const int l = it / I_L; int r = it % I_L; unsigned char* wl = ws + WS_W + (size_t)l * WL_STRIDE;
                if (r < I_IN) { const int nb = r % (NIN / 32), kb = r / (NIN / 32), nd = nb * 32, nsrc = win_src(nd); const int nv = nd + 32 <= INW ? 32 : (nd < INW ? INW - nd : 0);
                    transpose_item(a.w_in + (size_t)l * D * INW, INW, (bf16*)(wl + WL_IN), D, kb * 64, nd, nv ? nsrc : 0, nv, scr, lane); continue; } r -= I_IN;
                if (r < I_OUT) { const int nb = r % (D / 32), kb = r / (D / 32); transpose_item(a.w_out + (size_t)l * D * D, D, (bf16*)(wl + WL_OUT), D, kb * 64, nb * 32, nb * 32, 32, scr, lane); continue; } r -= I_OUT;
                if (r < I_FI) { const int nb = r % (2 * DFF / 32), kb = r / (2 * DFF / 32); transpose_item(a.w_ffn_in + (size_t)l * D * 2 * DFF, 2 * DFF, (bf16*)(wl + WL_FI), D, kb * 64, nb * 32, wfi_src(nb * 32), 32, scr, lane); continue; } r -= I_FI;
                if (r < I_FO) { const int nb = r % (D / 32), kb = r / (D / 32); transpose_item(a.w_ffn_out + (size_t)l * DFF * D, D, (bf16*)(wl + WL_FO), DFF, kb * 64, nb * 32, nb * 32, 32, scr, lane); continue; } r -= I_FO;
                { const int nb = r % (S5W / 32), kb = r / (S5W / 32); transpose_item(a.s5_w_glu + (size_t)l * S5W * S5W, S5W, (bf16*)(wl + WL_GLU), S5W, kb * 64, nb * 32, nb * 32, 32, scr, lane); }
            }
        }
        __syncthreads();
        {
            LAS float* red = (LAS float*)lds;
            for (int it = bid; it < DEPTH * 48; it += G) {
                const int l = it / 48, cg = it % 48, col = cg * 256 + lane * 4;
                const float* W = a.w_mod + (size_t)l * D * 6 * D + col; f32x4 s0 = {0.f, 0.f, 0.f, 0.f}, s1 = {0.f, 0.f, 0.f, 0.f};
#pragma unroll 8
                for (int k = wave * 256; k < wave * 256 + 256; ++k) { const f32x4 w = *(const f32x4*)(W + (size_t)k * 6 * D); const float cc = a.c_ctx[k], cx = a.c[k]; s0 += w * siluf_(cc); s1 += w * siluf_(cx); }
                *(LAS f32x4*)(red + (wave * 2 + 0) * 256 + lane * 4) = s0; *(LAS f32x4*)(red + (wave * 2 + 1) * 256 + lane * 4) = s1;
                __syncthreads();
                { const int ty = tid >> 8, cc = tid & 255; float s = a.b_mod[(size_t)l * 6 * D + cg * 256 + cc];
#pragma unroll
                  for (int w = 0; w < 8; ++w) s += red[(w * 2 + ty) * 256 + cc];
                  MOD[((size_t)l * 2 + ty) * 6 * D + cg * 256 + cc] = s; }
                __syncthreads();
            }
        }
        GRID_BAR();
    }

    const int plo = a.ph_lo, phi = a.ph_hi;
#define IN(k) (((PHMASK >> (k)) & 1) && plo <= (k) && (k) < phi)
    for (int l = a.l_lo; l < a.l_hi; ++l) {
        const unsigned char* wl = ws + WS_W + (size_t)l * WL_STRIDE;
        const float* modc = MOD + ((size_t)l * 2 + 0) * 6 * D; const float* modx = MOD + ((size_t)l * 2 + 1) * 6 * D;
#define NORM_PHASE(gvec, SH, SC) do { \
            for (int r = gw; r < R; r += NGW) { const float* md = r < CTXL ? modc : modx; const f32x4* xr = (const f32x4*)(XR + (size_t)r * D) + lane; f32x4 v[8]; float ss = 0.f; \
                _Pragma("unroll") for (int j = 0; j < 8; ++j) { v[j] = xr[64 * j]; ss += (v[j].x * v[j].x + v[j].y * v[j].y) + (v[j].z * v[j].z + v[j].w * v[j].w); } \
                const float rstd = 1.f / sqrtf(wave_sum(ss) * (1.f / D) + EPS); \
                _Pragma("unroll") for (int j = 0; j < 8; ++j) { const int c0 = lane * 4 + 256 * j; const f32x4 gg = *(const f32x4*)((gvec) + c0), sc = *(const f32x4*)(md + (SC) * D + c0), sh = *(const f32x4*)(md + (SH) * D + c0); \
                    const f32x4 o = v[j] * rstd * gg * (sc + 1.f) + sh; v2u w; w.x = pk2(o.x, o.y); w.y = pk2(o.z, o.w); *(v2u*)(HN + (size_t)r * D + c0) = w; } } } while (0)
        if (IN(0)) { PH_IDS const float* g1n = a.norm1_g + (size_t)l * D; NORM_PHASE(g1n, 0, 1); GRID_BAR(); }

        if (IN(1)) {
            pg8::Gemm g{HN, (const bf16*)(wl + WL_IN), D, D, D}; pg8::StaticOrder S; S.init(NPAN, NIN / 256, G, bid);
            EpiWin E{a.b_in + (size_t)l * INW, U, CG, Qb, Kb, Vb, Ob, GATES};
            pg8::gemm_phase<EpiWin, pg8::StaticOrder, true, true>(lds, g, S, E);
            GRID_BAR();
        }

        if (IN(2)) { PH_IDS
            for (int un = gw; un < S5G * 2; un += NGW) {
                const int g = un >> 1, d = un & 1, p = lane; const size_t pb = (((size_t)l * 2 + d) * S5G + g) * S5P + p;
                const float lre = a.s5_lam_re[pb], lim = a.s5_lam_im[pb], st = __expf(a.s5_log_step[pb]);
                const float ea = __expf(lre * st), th = lim * st, cs = cosf(th), sn = sinf(th), lr = ea * cs, li = ea * sn;
                const float sh = sinf(0.5f * th), m1r = expm1f(lre * st) * cs - 2.f * sh * sh, m1i = li;
                const float dn = 1.f / (lre * lre + lim * lim), cr = (m1r * lre + m1i * lim) * dn, ci = (m1i * lre - m1r * lim) * dn;
                float Br[16], Bi[16], Cr[16], Ci[16];
#pragma unroll
                for (int c = 0; c < 16; ++c) { const float br = a.s5_b_re[pb * 16 + c], bi = a.s5_b_im[pb * 16 + c]; Br[c] = cr * br - ci * bi; Bi[c] = cr * bi + ci * br;
                    const size_t cb = ((((size_t)l * 2 + d) * S5G + g) * S5CH + c) * S5P + p; Cr[c] = a.s5_c_re[cb]; Ci[c] = a.s5_c_im[cb]; }
                float hr = 0.f, hi = 0.f;
                for (int tau = 0; tau < R; ++tau) { const int r = tau_row(d, tau);
                    const float uv = lane < 16 ? bf2f(U[((size_t)g * UROWS + (r >> 4)) * UPITCH + (r & 15) * 16 + lane]) : 0.f; float br = 0.f, bi = 0.f;
#pragma unroll
                    for (int c = 0; c < 16; ++c) { const float uc = __shfl(uv, c); br += Br[c] * uc; bi += Bi[c] * uc; }
                    const float nr = lr * hr - li * hi + br, ni = lr * hi + li * hr + bi; hr = nr; hi = ni; float yv = 0.f;
#pragma unroll
                    for (int c = 0; c < 16; ++c) { const float s = wave_sum(Cr[c] * hr - Ci[c] * hi); yv = lane == c ? s : yv; }
                    if (lane < 16) YS[((size_t)d * R + r) * S5W + g * 16 + lane] = yv; }
            }
            {
                LAS float* red = (LAS float*)(lds + 65536);
                for (int un = bid; un < 256; un += G) {
                    const int h = un >> 6, d = (un >> 5) & 1, sl = un & 31, dk = tid & 255, hf = tid >> 8, dv0 = sl * 8 + hf * 4;
                    const bf16* Qh = Qb + (size_t)h * R * 256; const bf16* Kh = Kb + (size_t)h * R * 256; const bf16* Vh = Vb + (size_t)h * R * 256;
                    float C0 = 0.f, C1 = 0.f, C2 = 0.f, C3 = 0.f, nn = 0.f;
                    int r = tau_row(d, 0); float nq = bf2f(Qh[(size_t)r * 256 + dk]), nk = bf2f(Kh[(size_t)r * 256 + dk]); v2u nv = *(const v2u*)(Vh + (size_t)r * 256 + dv0);
                    float ngi = GATES[(size_t)r * 16 + d * 8 + h], ngf = GATES[(size_t)r * 16 + d * 8 + 4 + h];
                    for (int tau = 0; tau < R; ++tau) {
                        const int rc = r; const float q = nq, k = nk, gi = ngi, gf = ngf; const v2u vv = nv;
                        if (tau + 1 < R) { r = tau_row(d, tau + 1); nq = bf2f(Qh[(size_t)r * 256 + dk]); nk = bf2f(Kh[(size_t)r * 256 + dk]); nv = *(const v2u*)(Vh + (size_t)r * 256 + dv0);
                            ngi = GATES[(size_t)r * 16 + d * 8 + h]; ngf = GATES[(size_t)r * 16 + d * 8 + 4 + h]; }
                        const float f = sigmoidf_(gf), ik = __expf(gi) * k;
                        C0 = f * C0 + ik * bflo(vv.x); C1 = f * C1 + ik * bfhi(vv.x); C2 = f * C2 + ik * bflo(vv.y); C3 = f * C3 + ik * bfhi(vv.y); nn = f * nn + ik;
                        const float s0 = wave_sum(q * C0), s1 = wave_sum(q * C1), s2 = wave_sum(q * C2), s3 = wave_sum(q * C3), s4 = wave_sum(q * nn);
                        LAS float* rb = red + (tau & 1) * 40 + wave * 5;
                        if (lane == 0) { rb[0] = s0; rb[1] = s1; rb[2] = s2; rb[3] = s3; rb[4] = s4; }
                        __syncthreads();
                        if (tid < 8) { const int h2 = tid >> 2, j = tid & 3; const LAS float* rr = red + (tau & 1) * 40 + h2 * 20; const float num = rr[j] + rr[5 + j] + rr[10 + j] + rr[15 + j], den = rr[4] + rr[9] + rr[14] + rr[19];
                            HML[((size_t)d * R + rc) * MLW + h * 256 + sl * 8 + h2 * 4 + j] = num / fmaxf(fabsf(den), 1.f); }
                    }
                    __syncthreads();
                }
            }
            {
                LAS float* red = (LAS float*)(lds + 98304);
                const int ch = tid; float wv[CONVK];
#pragma unroll
                for (int j = 0; j < CONVK; ++j) wv[j] = a.conv_dw_w[((size_t)l * CONVK + j) * CONVW + ch];
                const float dwb = a.conv_dw_b[(size_t)l * CONVW + ch], lg = a.conv_ln_g[(size_t)l * CONVW + ch], lb = a.conv_ln_b[(size_t)l * CONVW + ch];
                for (int un = bid; un < 129; un += G) {
                    const int row0 = un == 0 ? 0 : CTXL + (un - 1) * 64, len = un == 0 ? CTXL : 64;
                    for (int t = 0; t < len; ++t) { float y = dwb;
#pragma unroll
                        for (int j = 0; j < CONVK; ++j) { const int tt = t + j - CONVK / 2; if (tt >= 0 && tt < len) y += wv[j] * bf2f(CG[(size_t)(row0 + tt) * CONVW + ch]); }
                        float s = wave_sum(y); if (lane == 0) red[wave] = s; __syncthreads();
                        float mean = 0.f;
#pragma unroll
                        for (int w = 0; w < 8; ++w) mean += red[w];
                        mean *= (1.f / CONVW); const float dy = y - mean; float q = wave_sum(dy * dy); if (lane == 0) red[8 + wave] = q; __syncthreads();
                        float var = 0.f;
#pragma unroll
                        for (int w = 0; w < 8; ++w) var += red[8 + w];
                        var *= (1.f / CONVW); const float o = dy / sqrtf(var + LN_EPS) * lg + lb;
                        ((unsigned short*)MIX)[(size_t)(row0 + t) * D + S5W + ch] = (unsigned short)f2bf(siluf_(o));
                        __syncthreads(); }
                }
            }
            GRID_BAR();
        }

        if (IN(3)) { PH_IDS
            const float* dsk = a.s5_d + (size_t)l * S5W;
            for (size_t i = (size_t)bid * NTHR + tid; i < (size_t)R * S5W; i += (size_t)G * NTHR) { const int r = (int)(i / S5W), c = (int)(i % S5W);
                const float uv = bf2f(U[((size_t)(c >> 4) * UROWS + (r >> 4)) * UPITCH + (r & 15) * 16 + (c & 15)]); const float y = dsk[c] * uv + YS[i] + YS[(size_t)R * S5W + i];
                ((unsigned short*)S5Gb)[i] = (unsigned short)f2bf(gelu_tanh_(y)); }
            const float* ng = a.ml_norm_g + (size_t)l * MLW;
            for (int it = gw; it < R * MLH; it += NGW) { const int r = it >> 2, h = it & 3; const size_t o0 = (size_t)r * MLW + h * 256 + lane * 4;
                const f32x4 v = *(const f32x4*)(HML + o0) + *(const f32x4*)(HML + (size_t)R * MLW + o0);
                const float mean = wave_sum((v.x + v.y) + (v.z + v.w)) * (1.f / 256.f); const f32x4 dv = v - mean;
                const float var = wave_sum((dv.x * dv.x + dv.y * dv.y) + (dv.z * dv.z + dv.w * dv.w)) * (1.f / 256.f), rstd = 1.f / sqrtf(var + LN_EPS);
                const f32x4 gg = *(const f32x4*)(ng + h * 256 + lane * 4); const v2u ow = *(const v2u*)(Ob + o0);
                const f32x4 o = {sigmoidf_(bflo(ow.x)) * dv.x * rstd * gg.x, sigmoidf_(bfhi(ow.x)) * dv.y * rstd * gg.y, sigmoidf_(bflo(ow.y)) * dv.z * rstd * gg.z, sigmoidf_(bfhi(ow.y)) * dv.w * rstd * gg.w};
                v2u w; w.x = pk2(o.x, o.y); w.y = pk2(o.z, o.w); *(v2u*)(MIX + (size_t)r * D + 1024 + h * 256 + lane * 4) = w; }
            GRID_BAR();
        }

        if (IN(4)) {
            pg8::Gemm g{S5Gb, (const bf16*)(wl + WL_GLU), S5W, S5W, S5W}; pg8::StaticOrder S; S.init(NPAN, S5W / 256, G, bid);
            EpiGlu E{S5Gb, a.s5_b_glu + (size_t)l * S5W, MIX};
            pg8::gemm_phase<EpiGlu, pg8::StaticOrder, true, true>(lds, g, S, E);
            GRID_BAR();
        }

        if (IN(5)) {
            pg8::Gemm g{MIX, (const bf16*)(wl + WL_OUT), D, D, D}; pg8::StaticOrder S; S.init(NPAN, D / 256, G, bid);
            EpiRes E{XR, modc + 2 * D, modx + 2 * D};
            pg8::gemm_phase<EpiRes, pg8::StaticOrder, true, true>(lds, g, S, E);
            GRID_BAR();
        }

        if (IN(6)) { PH_IDS const float* g2n = a.norm2_g + (size_t)l * D; NORM_PHASE(g2n, 3, 4); GRID_BAR(); }

        if (IN(7)) {
            pg8::Gemm g{HN, (const bf16*)(wl + WL_FI), D, D, D}; pg8::StaticOrder S; S.init(NPAN, 2 * DFF / 256, G, bid);
            EpiSwiglu E{HFF};
            pg8::gemm_phase<EpiSwiglu, pg8::StaticOrder, true, true>(lds, g, S, E);
            GRID_BAR();
        }

        if (IN(8)) {
            pg8::Gemm g{HFF, (const bf16*)(wl + WL_FO), DFF, DFF, DFF}; pg8::StaticOrder S; S.init(NPAN, D / 256, G, bid);
            EpiRes E{XR, modc + 5 * D, modx + 5 * D};
            pg8::gemm_phase<EpiRes, pg8::StaticOrder, true, true>(lds, g, S, E);
            GRID_BAR();
        }
    }

    if (a.do_fin) { PH_IDS
        for (int r = CTXL + gw; r < R; r += NGW) { const f32x4* xr = (const f32x4*)(XR + (size_t)r * D) + lane; f32x4 v[8]; float ss = 0.f;
#pragma unroll
            for (int j = 0; j < 8; ++j) { v[j] = xr[64 * j]; ss += (v[j].x * v[j].x + v[j].y * v[j].y) + (v[j].z * v[j].z + v[j].w * v[j].w); }
            const float rstd = 1.f / sqrtf(wave_sum(ss) * (1.f / D) + EPS);
#pragma unroll
            for (int j = 0; j < 8; ++j) { const int c0 = lane * 4 + 256 * j; *(f32x4*)(a.out + (size_t)(r - CTXL) * D + c0) = v[j] * rstd * *(const f32x4*)(a.norm_f_g + c0); } }
    }
#undef IN
#undef NORM_PHASE
#undef GRID_BAR
}

extern "C" void kernel_launch(void* const* d_in, const int* in_sizes, int n_in, void* d_out, int out_size, void* d_ws, size_t ws_size, hipStream_t stream) {
    static int grid = 0;
    if (grid == 0) {
        if (n_in != 29 || in_sizes[0] != SEQ * D || out_size != SEQ * D || ws_size < WS_END) { fprintf(stderr, "kernel_launch: unexpected problem (n_in %d, in0 %d, out %d, ws %zu < %zu)\n", n_in, n_in > 0 ? in_sizes[0] : -1, out_size, ws_size, (size_t)WS_END); grid = -1; return; }
        int dev = 0, cus = 0, per_cu = 0;
        if (hipGetDevice(&dev) != hipSuccess || hipDeviceGetAttribute(&cus, hipDeviceAttributeMultiprocessorCount, dev) != hipSuccess) { grid = -1; return; }
        if (hipFuncSetAttribute((const void*)fwd, hipFuncAttributeMaxDynamicSharedMemorySize, LDS_BYTES) != hipSuccess) { fprintf(stderr, "kernel_launch: hipFuncSetAttribute failed\n"); grid = -1; return; }
        if (hipOccupancyMaxActiveBlocksPerMultiprocessor(&per_cu, (const void*)fwd, NTHR, LDS_BYTES) != hipSuccess || per_cu < 1) fprintf(stderr, "kernel_launch: occupancy query says %d\n", per_cu);
        (void)hipGetLastError();
        grid = cus;
    }
    if (grid < 0) return;
    (void)hipMemsetAsync((char*)d_ws + WS_CTL, 0, CTL_ZERO_BYTES, stream);
    Args a{};
    const float** pp = (const float**)&a;
    for (int i = 0; i < 29; ++i) pp[i] = (const float*)d_in[i];
    a.out = (float*)d_out; a.ws = (unsigned char*)d_ws;
#if MK_SINGLE
    a.l_lo = 0; a.l_hi = DEPTH; a.ph_lo = 0; a.ph_hi = NPH; a.do_pro = 1; a.do_fin = 1; a.use_bar = 1;
    hipLaunchKernelGGL(fwd, dim3(grid), dim3(NTHR), LDS_BYTES, stream, a);
#else
    a.use_bar = 0;
    a.l_lo = 0; a.l_hi = 0; a.ph_lo = 0; a.ph_hi = 0; a.do_pro = 1; a.do_fin = 0;
    hipLaunchKernelGGL(fwd, dim3(grid), dim3(NTHR), LDS_BYTES, stream, a);
    a.do_pro = 0;
    for (int l = 0; l < DEPTH; ++l) for (int p = 0; p < NPH; ++p) { a.l_lo = l; a.l_hi = l + 1; a.ph_lo = p; a.ph_hi = p + 1; hipLaunchKernelGGL(fwd, dim3(grid), dim3(NTHR), LDS_BYTES, stream, a); }
    a.l_lo = 0; a.l_hi = 0; a.ph_lo = 0; a.ph_hi = 0; a.do_fin = 1;
    hipLaunchKernelGGL(fwd, dim3(grid), dim3(NTHR), LDS_BYTES, stream, a);
#endif
}
```

```cpp
#include <hip/hip_runtime.h>
#include <cstdio>
#include <cstdint>

#ifndef PHMASK
#define PHMASK 0xfff
#endif
#ifndef PROMASK
#define PROMASK 1
#endif
#ifndef MLDBG
#define MLDBG 0
#endif
#ifndef MLDBG_THR
#define MLDBG_THR 0.03f
#endif
#ifndef MK_SINGLE
#define MK_SINGLE 1
#endif

namespace pg8 {
#define PG8_LAS __attribute__((address_space(3)))
typedef unsigned short bf16_t;
typedef short bf16x8 __attribute__((ext_vector_type(8)));
typedef float f32x4 __attribute__((ext_vector_type(4)));
typedef float f32x2 __attribute__((ext_vector_type(2)));
typedef unsigned u32x4 __attribute__((ext_vector_type(4)));
constexpr int BM = 256, BK = 64, HALF = 128, HTB = HALF * BK * 2, STAGE_BYTES = 8 * HTB, NXCD = 8, WGM = 8;

__host__ __device__ __forceinline__ int lds_byte(int r, int c) { const int st = (r >> 4) * 2 + (c >> 5), rr = r & 15, cc = c & 31, ob = rr * 64 + cc * 2; return st * 1024 + (ob ^ (((ob >> 9) & 1) << 5)); }
__host__ __device__ __forceinline__ void stage_rc(int b, int& R, int& C) { const int st = b / 1024, sb = b % 1024, swz = sb ^ (((sb >> 9) & 1) << 5); R = (st >> 1) * 16 + swz / 64; C = (st & 1) * 32 + (swz % 64) / 2; }
__host__ __device__ __forceinline__ int perm32(int rho) { const int n = rho >> 4, i = rho & 15; return 8 * (i >> 2) + 4 * n + (i & 3); }

struct Unit { int pm, pn; };
struct Gemm { const bf16_t* A; const bf16_t* Bt; int lda, ldb, K; };

struct StaticOrder {
    int nM, nN, nwg, G, c;
    __host__ __device__ void init(int nM_, int nN_, int G_, int c_) { nM = nM_; nN = nN_; nwg = nM * nN; G = G_; c = c_; }
    __host__ __device__ bool next(int i, Unit& u) const {
        const long L = (long)i * G + c; if (L >= nwg) return false;
        int wgid = (int)L; { const int q = nwg / NXCD, r = nwg % NXCD, xcd = wgid % NXCD, off = wgid / NXCD; wgid = (xcd < r ? xcd * (q + 1) : r * (q + 1) + (xcd - r) * q) + off; }
        const int nig = WGM * nN, gid = wgid / nig, fm = gid * WGM, gsz = (nM - fm) < WGM ? (nM - fm) : WGM;
        u.pm = fm + ((wgid % nig) % gsz); u.pn = (wgid % nig) / gsz; return true;
    }
};

__device__ __forceinline__ unsigned cvt_pk_bf16(float lo, float hi) { unsigned r; asm volatile("v_cvt_pk_bf16_f32 %0, %1, %2" : "=v"(r) : "v"(lo), "v"(hi)); return r; }

template <class Epi, class Sched, bool ALIGN_EPI = false, bool SP2 = false>
__device__ __forceinline__ void gemm_phase(PG8_LAS unsigned char* lds, const Gemm g, const Sched& S, const Epi& E) {
    int tid_o = threadIdx.x; asm volatile("" : "+v"(tid_o));
    const int tid = tid_o, wid = __builtin_amdgcn_readfirstlane(tid >> 6), lane = tid & 63, wr = wid >> 2, wc = wid & 3, fr = lane & 15, fq = lane >> 4;
    const int K = g.K, nt = K / BK;
    unsigned voffA[2], voffB[2];
#pragma unroll
    for (int i = 0; i < 2; ++i) { int R, C; stage_rc(tid * 16 + i * 8192, R, C); const int Rb = Epi::PERM ? ((R & ~31) + perm32(R & 31)) : R;
        voffA[i] = (unsigned)(R * g.lda + C) * 2u; voffB[i] = (unsigned)(Rb * g.ldb + C) * 2u; }
    const size_t kstep = (size_t)(BK * 2);
    const size_t hstepA = (size_t)HALF * g.lda * 2, hstepB = (size_t)HALF * g.ldb * 2;
    const size_t tstepA = 2 * hstepA, tstepB = 2 * hstepB;
    const unsigned ldsw = (unsigned)wid * 1024u;
    const int aoff = lds_byte(wr * 64 + fr, fq * 8), boff = lds_byte(wc * 32 + fr, fq * 8);
#define PG8_SA(b, h) (((b) * 2 + (h)) * HTB)
#define PG8_SB(b, h) ((4 + (b) * 2 + (h)) * HTB)
#define PG8_STAGE(bufoff, gbase, voff) do { _Pragma("unroll") for (int _i = 0; _i < 2; ++_i) \
        __builtin_amdgcn_global_load_lds((const unsigned*)((const char*)(gbase) + (voff)[_i]), (PG8_LAS unsigned*)(lds + (bufoff) + ldsw + _i * 8192), 16, 0, 0); } while (0)
#define PG8_LDA(dst, b, h) do { _Pragma("unroll") for (int m = 0; m < 4; ++m) _Pragma("unroll") for (int k = 0; k < 2; ++k) dst[m][k] = *(const PG8_LAS bf16x8*)(lds + PG8_SA(b, h) + aoff + m * 2048 + k * 1024); } while (0)
#define PG8_LDB(dst, b, h) do { _Pragma("unroll") for (int n = 0; n < 2; ++n) _Pragma("unroll") for (int k = 0; k < 2; ++k) dst[n][k] = *(const PG8_LAS bf16x8*)(lds + PG8_SB(b, h) + boff + n * 2048 + k * 1024); } while (0)
#define PG8_MMA(ai, bj, At, Bt) do { __builtin_amdgcn_s_setprio(1); _Pragma("unroll") for (int m = 0; m < 4; ++m) _Pragma("unroll") for (int n = 0; n < 2; ++n) _Pragma("unroll") for (int k = 0; k < 2; ++k) \
        acc[ai][bj][m][n] = __builtin_amdgcn_mfma_f32_16x16x32_bf16(Bt[n][k], At[m][k], acc[ai][bj][m][n], 0, 0, 0); __builtin_amdgcn_s_setprio(0); } while (0)
#define PG8_WAIT_V(n) asm volatile("s_waitcnt vmcnt(" #n ")" ::: "memory")
#define PG8_WAIT_L(n) asm volatile("s_waitcnt lgkmcnt(" #n ")" ::: "memory")
#define PG8_BAR __builtin_amdgcn_s_barrier()
#define PG8_SCHED __builtin_amdgcn_sched_barrier(0)
    Unit cur, nxt; int ui = 0;
    if (!S.next(0, cur)) return;
    f32x4 acc[2][2][4][2];
#pragma unroll
    for (int a = 0; a < 2; ++a)
#pragma unroll
        for (int b = 0; b < 2; ++b)
#pragma unroll
            for (int m = 0; m < 4; ++m)
#pragma unroll
                for (int n = 0; n < 2; ++n) acc[a][b][m][n] = (f32x4){0.f, 0.f, 0.f, 0.f};
    bf16x8 At[4][2], B0[2][2], B1[2][2];
    const char* cA = (const char*)g.A + (size_t)cur.pm * tstepA; const char* cB = (const char*)g.Bt + (size_t)cur.pn * tstepB;
    if constexpr (SP2) {
        PG8_STAGE(PG8_SB(0, 0), cB, voffB); PG8_STAGE(PG8_SB(0, 1), cB + hstepB, voffB); PG8_STAGE(PG8_SA(0, 0), cA, voffA); PG8_STAGE(PG8_SA(0, 1), cA + hstepA, voffA);
        if (wr == 1) PG8_BAR;
        PG8_WAIT_V(2); PG8_BAR;
        PG8_STAGE(PG8_SB(1, 0), cB + kstep, voffB); PG8_STAGE(PG8_SA(1, 0), cA + kstep, voffA); PG8_STAGE(PG8_SB(1, 1), cB + hstepB + kstep, voffB);
        PG8_WAIT_V(6); PG8_BAR;
    } else {
        PG8_STAGE(PG8_SB(0, 0), cB, voffB); PG8_STAGE(PG8_SA(0, 0), cA, voffA); PG8_STAGE(PG8_SB(0, 1), cB + hstepB, voffB); PG8_STAGE(PG8_SA(0, 1), cA + hstepA, voffA);
        if (wr == 1) PG8_BAR;
        PG8_WAIT_V(4); PG8_BAR;
        PG8_STAGE(PG8_SB(1, 0), cB + kstep, voffB); PG8_STAGE(PG8_SA(1, 0), cA + kstep, voffA); PG8_STAGE(PG8_SB(1, 1), cB + hstepB + kstep, voffB);
        PG8_WAIT_V(6); PG8_BAR;
    }
    for (;;) {
        const bool has_next = S.next(ui + 1, nxt);
        const char* nA = has_next ? (const char*)g.A + (size_t)nxt.pm * tstepA : cA; const char* nB = has_next ? (const char*)g.Bt + (size_t)nxt.pn * tstepB : cB;
#pragma nounroll
        for (int t = 0; t < nt; t += 2) {
            const bool last = (t == nt - 2);
            const char* a1 = cA + (size_t)(t + 1) * kstep;
            const char* a2 = last ? nA : cA + (size_t)(t + 2) * kstep; const char* b2 = last ? nB : cB + (size_t)(t + 2) * kstep;
            const char* a3 = a2 + kstep; const char* b3 = b2 + kstep;
            if constexpr (SP2) {
            PG8_LDB(B0, 0, 0); PG8_LDB(B1, 0, 1); PG8_SCHED; PG8_LDA(At, 0, 0); PG8_STAGE(PG8_SA(1, 1), a1 + hstepA, voffA);
            PG8_WAIT_V(8); PG8_WAIT_L(0); PG8_BAR; PG8_MMA(0, 0, At, B0); PG8_MMA(0, 1, At, B1); PG8_BAR; PG8_SCHED;
            PG8_LDA(At, 0, 1); PG8_STAGE(PG8_SB(0, 0), b2, voffB); PG8_STAGE(PG8_SB(0, 1), b2 + hstepB, voffB); PG8_STAGE(PG8_SA(0, 0), a2, voffA);
            PG8_WAIT_V(8); PG8_WAIT_L(0); PG8_BAR; PG8_MMA(1, 0, At, B0); PG8_MMA(1, 1, At, B1); PG8_BAR; PG8_SCHED;
            PG8_LDB(B0, 1, 0); PG8_LDB(B1, 1, 1); PG8_SCHED; PG8_LDA(At, 1, 0); PG8_STAGE(PG8_SA(0, 1), a2 + hstepA, voffA);
            PG8_WAIT_V(8); PG8_WAIT_L(0); PG8_BAR; PG8_MMA(0, 0, At, B0); PG8_MMA(0, 1, At, B1); PG8_BAR; PG8_SCHED;
            PG8_LDA(At, 1, 1); PG8_STAGE(PG8_SB(1, 0), b3, voffB); PG8_STAGE(PG8_SB(1, 1), b3 + hstepB, voffB); PG8_STAGE(PG8_SA(1, 0), a3, voffA);
            PG8_WAIT_V(8); PG8_WAIT_L(0); PG8_BAR; PG8_MMA(1, 0, At, B0); PG8_MMA(1, 1, At, B1); PG8_BAR; PG8_SCHED;
            } else {
            PG8_LDB(B0, 0, 0); PG8_SCHED; PG8_LDA(At, 0, 0); PG8_STAGE(PG8_SA(1, 1), a1 + hstepA, voffA);
            PG8_WAIT_L(8); PG8_BAR; PG8_WAIT_L(0); PG8_MMA(0, 0, At, B0); PG8_BAR; PG8_SCHED;
            PG8_LDB(B1, 0, 1); PG8_STAGE(PG8_SB(0, 0), b2, voffB);
            PG8_BAR; PG8_WAIT_L(0); PG8_MMA(0, 1, At, B1); PG8_BAR;
            PG8_LDA(At, 0, 1); PG8_STAGE(PG8_SA(0, 0), a2, voffA);
            PG8_BAR; PG8_WAIT_L(0); PG8_MMA(1, 0, At, B0); PG8_BAR; PG8_SCHED;
            PG8_STAGE(PG8_SB(0, 1), b2 + hstepB, voffB);
            PG8_WAIT_V(6); PG8_BAR; PG8_MMA(1, 1, At, B1); PG8_BAR;
            PG8_LDB(B0, 1, 0); PG8_SCHED; PG8_LDA(At, 1, 0); PG8_STAGE(PG8_SA(0, 1), a2 + hstepA, voffA);
            PG8_WAIT_L(8); PG8_BAR; PG8_WAIT_L(0); PG8_MMA(0, 0, At, B0); PG8_BAR; PG8_SCHED;
            PG8_LDB(B1, 1, 1); PG8_STAGE(PG8_SB(1, 0), b3, voffB);
            PG8_BAR; PG8_WAIT_L(0); PG8_MMA(0, 1, At, B1); PG8_BAR;
            PG8_LDA(At, 1, 1); PG8_STAGE(PG8_SA(1, 0), a3, voffA);
            PG8_BAR; PG8_WAIT_L(0); PG8_MMA(1, 0, At, B0); PG8_BAR; PG8_SCHED;
            PG8_STAGE(PG8_SB(1, 1), b3 + hstepB, voffB);
            PG8_WAIT_V(6); PG8_BAR; PG8_MMA(1, 1, At, B1); PG8_BAR;
            }
        }
        if constexpr (ALIGN_EPI) { if (wr == 0) PG8_BAR; }
        { int fr_o = fr, fq_o = fq; asm volatile("" : "+v"(fr_o), "+v"(fq_o)); E(acc, cur, wr, wc, fr_o, fq_o); }
        if (!has_next) break;
#pragma unroll
        for (int a = 0; a < 2; ++a)
#pragma unroll
            for (int b = 0; b < 2; ++b)
#pragma unroll
                for (int m = 0; m < 4; ++m)
#pragma unroll
                    for (int n = 0; n < 2; ++n) acc[a][b][m][n] = (f32x4){0.f, 0.f, 0.f, 0.f};
        cur = nxt; cA = nA; cB = nB; ++ui;
        if constexpr (ALIGN_EPI) { if (wr == 1) PG8_BAR; }
    }
    PG8_WAIT_V(0);
    if constexpr (!ALIGN_EPI) { if (wr == 0) PG8_BAR; }
    PG8_BAR;
#undef PG8_SA
#undef PG8_SB
#undef PG8_STAGE
#undef PG8_LDA
#undef PG8_LDB
#undef PG8_MMA
#undef PG8_WAIT_V
#undef PG8_WAIT_L
#undef PG8_BAR
#undef PG8_SCHED
}
}

constexpr int D = 2048, SEQ = 8192, CTXL = 256, R = SEQ + CTXL, DEPTH = 4, NPAN = R / 256;
constexpr int S5W = 512, S5G = 32, S5CH = 16, S5P = 64, CONVW = 512, CONVK = 31, MLW = 1024, MLH = 4, DH = 256, DFF = 5632;
constexpr int INW = 5648, NIN = 5888;
constexpr int OFF_CONV = 512, OFF_Q = 1536, OFF_K = 2560, OFF_V = 3584, OFF_O = 4608, OFF_G = 5632;
constexpr float EPS = 1e-6f, LN_EPS = 1e-5f;
constexpr int UROWS = 768, UPITCH = 512;

constexpr size_t MiB = 1u << 20;
constexpr size_t WS_CTL = 0, CTL_ZERO_BYTES = 1 * MiB;
constexpr size_t WS_MOD = 1 * MiB;
constexpr size_t WS_XR = 2 * MiB;
constexpr size_t WS_HN = 68 * MiB;
constexpr size_t WS_U = 101 * MiB;
constexpr size_t WS_CG = 125 * MiB;
constexpr size_t WS_Q = 134 * MiB, WS_K = 151 * MiB, WS_V = 168 * MiB;
constexpr size_t WS_O = 185 * MiB;
constexpr size_t WS_GATES = 202 * MiB;
constexpr size_t WS_MIX = 203 * MiB;
constexpr size_t WS_HFF = 236 * MiB;
constexpr size_t WS_YS = 327 * MiB;
constexpr size_t WS_S5G = 360 * MiB;
constexpr size_t WS_HML = 369 * MiB;
constexpr size_t WS_W = 436 * MiB;
constexpr size_t WL_IN = 0, WL_OUT = 23 * MiB, WL_FI = 31 * MiB, WL_FO = 75 * MiB, WL_GLU = 97 * MiB, WL_STRIDE = 98 * MiB;
constexpr size_t WS_SQ = 828 * MiB;
constexpr size_t WS_VC = 894 * MiB;
constexpr size_t WS_KT = 960 * MiB;
constexpr size_t WS_KTW = 977 * MiB;
constexpr size_t WS_DC = 1010 * MiB;
constexpr size_t WS_BC = 1076 * MiB;
constexpr size_t WS_CS = WS_BC + 512 * 1024;
constexpr size_t WS_DN = WS_CS + 512 * 1024;
constexpr size_t WS_NIN = WS_DN + 512 * 1024;
constexpr size_t WS_AT = 1078 * MiB + 1536 * 1024;
constexpr size_t WS_RSP = 1078 * MiB;
constexpr size_t WS_FC = 1080 * MiB;
constexpr size_t WS_WC = 1096 * MiB;
constexpr size_t WS_LAMP = 1128 * MiB;
constexpr size_t WS_EB = 1129 * MiB;
constexpr size_t WS_ESC = 1153 * MiB;
constexpr size_t WS_END = 1155 * MiB;
constexpr int NCK = R / 16, CTXCK = CTXL / 16, NSC = NCK / 16;
constexpr int NCH = 33;
constexpr int CW_BAR = 4096;

constexpr int RING_BYTES = 131072, LDSCTL_OFF = RING_BYTES, MISC_OFF = LDSCTL_OFF + 320, LDS_BYTES = 147456;
constexpr int NWAVES = 8, NTHR = 512;

#define GAS __attribute__((address_space(1)))
#define LAS __attribute__((address_space(3)))
typedef unsigned short bf16;
typedef unsigned v4u __attribute__((ext_vector_type(4)));
typedef unsigned v2u __attribute__((ext_vector_type(2)));
typedef float f32x4 __attribute__((ext_vector_type(4)));
typedef GAS unsigned gu32;
#define RLX_AGENT __ATOMIC_RELAXED, __HIP_MEMORY_SCOPE_AGENT
#define LDS_WAIT() asm volatile("s_waitcnt lgkmcnt(0)" ::: "memory")
__device__ __forceinline__ unsigned f2bf(float f) { unsigned u = __builtin_bit_cast(unsigned, f); return (u + 0x7fffu + ((u >> 16) & 1u)) >> 16; }
__device__ __forceinline__ unsigned pk2(float lo, float hi) { return f2bf(lo) | (f2bf(hi) << 16); }
__device__ __forceinline__ float bf2f(unsigned short b) { return __builtin_bit_cast(float, ((unsigned)b) << 16); }
__device__ __forceinline__ float bflo(unsigned w) { return __builtin_bit_cast(float, w << 16); }
__device__ __forceinline__ float bfhi(unsigned w) { return __builtin_bit_cast(float, w & 0xffff0000u); }
__device__ __forceinline__ float sigmoidf_(float x) { return 1.f / (1.f + __expf(-x)); }
__device__ __forceinline__ float siluf_(float x) { return x / (1.f + __expf(-x)); }
__device__ __forceinline__ float gelu_tanh_(float x) { const float u = 0.7978845608028654f * (x + 0.044715f * x * x * x); return x * (1.f / (1.f + __expf(-2.f * u))); }
__device__ __forceinline__ float wave_sum(float v) {
#pragma unroll
    for (int o = 1; o < 64; o <<= 1) v += __shfl_xor(v, o);
    return v;
}
__device__ __forceinline__ int tau_row(int d, int tau) { return d == 0 ? tau : (tau < CTXL ? CTXL - 1 - tau : (R - 1 + CTXL) - tau); }

#define XB_TMO      128
#define XB_XCNT(j)  (256  + 64 * (j))
#define XB_XSUB(j)  (1280 + 64 * (j))
#define XB_XGEN(j)  (2304 + 64 * (j))
#define XB_TOP      3328
#define XB_TOPGEN   3392
#define XCD_BAR_WORDS 3456
#define XB_SPIN_CAP (1u << 22)
__device__ __forceinline__ unsigned xb_ld(unsigned* p)              { return __hip_atomic_load(p, __ATOMIC_RELAXED, __HIP_MEMORY_SCOPE_AGENT); }
__device__ __forceinline__ unsigned xb_add(unsigned* p, unsigned v) { return __hip_atomic_fetch_add(p, v, __ATOMIC_RELAXED, __HIP_MEMORY_SCOPE_AGENT); }
__device__ __forceinline__ unsigned xb_xcc_id() { return (unsigned)__builtin_amdgcn_s_getreg((3 << 11) | 20) & 0xFu; }
#define XB_SPIN(cond, bar) do { unsigned _sp = 0; while (cond) { __builtin_amdgcn_s_sleep(1); \
    if ((++_sp & 255u) == 0u) { if (xb_ld(&(bar)[XB_TMO])) break; if (_sp > XB_SPIN_CAP) { atomicAdd(&(bar)[XB_TMO], 1u); break; } } } } while (0)
struct XcdBarrier { unsigned* bar; unsigned x; volatile LAS unsigned* st; };
__device__ __forceinline__ XcdBarrier xcd_barrier_post(unsigned* bar, volatile LAS unsigned* st) {
    XcdBarrier b; b.bar = bar; b.x = xb_xcc_id(); b.st = st;
    if (threadIdx.x == 0) (void)xb_add(&bar[XB_XCNT(b.x)], 1u);
    return b;
}
__device__ __forceinline__ void xcd_barrier_complete(unsigned* bar, unsigned x, unsigned& nloc, unsigned& nx) {
    const unsigned G = gridDim.x * gridDim.y * gridDim.z;
    unsigned sum, cnt, mine, sp = 0u;
    for (;;) {
        sum = 0u; cnt = 0u; mine = 0u;
#pragma unroll
        for (unsigned j = 0; j < 16; ++j) { const unsigned c = xb_ld(&bar[XB_XCNT(j)]); sum += c; cnt += (c > 0u) ? 1u : 0u; mine = (j == x) ? c : mine; }
        if (sum == G) break;
        __builtin_amdgcn_s_sleep(1);
        if ((++sp & 255u) == 0u) { if (xb_ld(&bar[XB_TMO])) break; if (sp > XB_SPIN_CAP) { atomicAdd(&bar[XB_TMO], 1u); break; } }
    }
    nloc = mine > 0u ? mine : 1u; nx = cnt > 0u ? cnt : 1u;
}
__device__ __forceinline__ void xcd_barrier(const XcdBarrier& b) {
    asm volatile("s_waitcnt vmcnt(0)" ::: "memory");
    __syncthreads();
    if (threadIdx.x == 0) {
        unsigned* bar = b.bar;
        __builtin_amdgcn_s_waitcnt(0);
        unsigned nloc = b.st[0], nx = b.st[1];
        if (nloc == 0u) { xcd_barrier_complete(bar, b.x, nloc, nx); b.st[0] = nloc; b.st[1] = nx; }
        const unsigned old = xb_add(&bar[XB_XSUB(b.x)], 1u);
        const unsigned gen = old / nloc;
        if (old + 1u == (gen + 1u) * nloc) {
            __builtin_amdgcn_fence(__ATOMIC_RELEASE, "agent");
            asm volatile("s_waitcnt vmcnt(0)" ::: "memory");
            const unsigned og = xb_add(&bar[XB_TOP], 1u);
            const unsigned tg = og / nx;
            if (og + 1u == (tg + 1u) * nx) xb_add(&bar[XB_TOPGEN], 1u);
            else XB_SPIN(xb_ld(&bar[XB_TOPGEN]) == tg, bar);
            __builtin_amdgcn_fence(__ATOMIC_ACQUIRE, "agent");
            xb_add(&bar[XB_XGEN(b.x)], 1u);
            asm volatile("s_waitcnt vmcnt(0)" ::: "memory");
        } else {
            XB_SPIN(xb_ld(&bar[XB_XGEN(b.x)]) == gen, bar);
            __builtin_amdgcn_fence(__ATOMIC_ACQUIRE, "agent");
            asm volatile("s_waitcnt vmcnt(0)" ::: "memory");
        }
    }
    __syncthreads();
}

struct Args {
    const float *x, *c, *ctx, *c_ctx, *w_mod, *b_mod, *norm1_g, *w_in, *b_in, *s5_lam_re, *s5_lam_im, *s5_log_step, *s5_b_re, *s5_b_im, *s5_c_re, *s5_c_im,
                *s5_d, *s5_w_glu, *s5_b_glu, *conv_dw_w, *conv_dw_b, *conv_ln_g, *conv_ln_b, *ml_norm_g, *w_out, *norm2_g, *w_ffn_in, *w_ffn_out, *norm_f_g;
    float* out; unsigned char* ws;
    int l_lo, l_hi, ph_lo, ph_hi, do_pro, do_fin, use_bar, pad;
};

typedef const Args __attribute__((address_space(4))) CArgs;

__device__ __forceinline__ void transpose_item(const float* W, int Nsrc, bf16* WT, int ldt, int k0, int n0d, int n0s, int nvalid, LAS float* scr, int lane) {
#pragma unroll 8
    for (int i = 0; i < 32; ++i) { const int kk = 2 * i + (lane >> 5), nn = lane & 31; scr[kk * 33 + nn] = nn < nvalid ? W[(size_t)(k0 + kk) * Nsrc + n0s + nn] : 0.f; }
    LDS_WAIT(); asm volatile("" ::: "memory");
    const int c = lane & 7;
#pragma unroll
    for (int j = 0; j < 4; ++j) { const int n = (lane >> 3) + 8 * j; const LAS float* s = scr + (8 * c) * 33 + n;
        v4u o; o.x = pk2(s[0 * 33], s[1 * 33]); o.y = pk2(s[2 * 33], s[3 * 33]); o.z = pk2(s[4 * 33], s[5 * 33]); o.w = pk2(s[6 * 33], s[7 * 33]);
        *(GAS v4u*)(WT + (size_t)(n0d + n) * ldt + k0 + 8 * c) = o; }
    LDS_WAIT(); asm volatile("" ::: "memory");
}
__device__ __forceinline__ int win_src(int nd) {
    if (nd >= OFF_CONV && nd < OFF_Q) { const int t = (nd - OFF_CONV) >> 8, w = (nd - OFF_CONV) & 255; return w < 128 ? OFF_CONV + t * 128 + w : OFF_CONV + CONVW + t * 128 + (w - 128); }
    return nd;
}
__device__ __forceinline__ int wfi_src(int nd) { const int t = nd >> 8, w = nd & 255; return w < 128 ? t * 128 + w : DFF + t * 128 + (w - 128); }

using pg8::f32x2;
struct EpiWin {
    static constexpr bool PERM = true;
    const float* bias; bf16 *U, *CG, *SQ, *Kb, *KT, *VC, *O; float* GATES;
    __device__ __forceinline__ void operator()(const f32x4 (&acc)[2][2][4][2], const pg8::Unit& u, int wr, int wc, int fr, int fq) const {
        const int row0 = u.pm * 256 + wr * 64 + fr, pn = u.pn, cw0 = wc * 32 + 8 * fq;
        if (pn < 2) {
#pragma unroll
            for (int bj = 0; bj < 2; ++bj) { const int col = pn * 256 + bj * 128 + cw0, g = col >> 4, ch0 = col & 15;
                const f32x4 b0 = *(const f32x4*)(bias + col), b1 = *(const f32x4*)(bias + col + 4);
#pragma unroll
                for (int ai = 0; ai < 2; ++ai)
#pragma unroll
                    for (int m = 0; m < 4; ++m) { const int r = row0 + ai * 128 + m * 16; const f32x4 v0 = acc[ai][bj][m][0] + b0, v1 = acc[ai][bj][m][1] + b1;
                        v4u w; w.x = pk2(v0[0], v0[1]); w.y = pk2(v0[2], v0[3]); w.z = pk2(v1[0], v1[1]); w.w = pk2(v1[2], v1[3]);
                        *(v4u*)(U + ((size_t)g * UROWS + (r >> 4)) * UPITCH + (r & 15) * 16 + ch0) = w; } }
        } else if (pn < 6) {
            const int ch = (pn - 2) * 128 + cw0;
            const f32x4 a0 = *(const f32x4*)(bias + OFF_CONV + ch), a1 = *(const f32x4*)(bias + OFF_CONV + ch + 4), b0 = *(const f32x4*)(bias + OFF_CONV + CONVW + ch), b1 = *(const f32x4*)(bias + OFF_CONV + CONVW + ch + 4);
#pragma unroll
            for (int ai = 0; ai < 2; ++ai)
#pragma unroll
                for (int m = 0; m < 4; ++m) { const int r = row0 + ai * 128 + m * 16;
                    const f32x4 x0 = acc[ai][0][m][0] + a0, x1 = acc[ai][0][m][1] + a1, y0 = acc[ai][1][m][0] + b0, y1 = acc[ai][1][m][1] + b1; float o[8];
#pragma unroll
                    for (int j = 0; j < 4; ++j) { o[j] = x0[j] * sigmoidf_(y0[j]); o[4 + j] = x1[j] * sigmoidf_(y1[j]); }
                    v4u w; w.x = pk2(o[0], o[1]); w.y = pk2(o[2], o[3]); w.z = pk2(o[4], o[5]); w.w = pk2(o[6], o[7]);
                    *(v4u*)(CG + (size_t)r * CONVW + ch) = w; }
        } else if (pn < 22) {
            const int which = (pn - 6) >> 2, h = (pn - 6) & 3, c = u.pm; const float sc = which == 1 ? 0.0625f : 1.f;
#pragma unroll
            for (int bj = 0; bj < 2; ++bj) { const int cw = bj * 128 + cw0; const f32x4 b0 = *(const f32x4*)(bias + pn * 256 + cw), b1 = *(const f32x4*)(bias + pn * 256 + cw + 4);
#pragma unroll
                for (int ai = 0; ai < 2; ++ai)
#pragma unroll
                    for (int m = 0; m < 4; ++m) { int t = wr * 64 + fr + ai * 128 + m * 16; asm volatile("" : "+v"(t) :: "memory"); const int r = c * 256 + t; const f32x4 v0 = (acc[ai][bj][m][0] + b0) * sc, v1 = (acc[ai][bj][m][1] + b1) * sc;
                        v4u w; w.x = pk2(v0[0], v0[1]); w.y = pk2(v0[2], v0[3]); w.z = pk2(v1[0], v1[1]); w.w = pk2(v1[2], v1[3]);
                        if (which == 0) { *(v4u*)(SQ + ((size_t)(h * NCH + c) * 256 + t) * 512 + 256 + cw) = w; *(v4u*)(SQ + ((size_t)((4 + h) * NCH + c) * 256 + t) * 512 + 256 + cw) = w; }
                        else if (which == 1) { *(v4u*)(Kb + ((size_t)h * R + r) * 256 + cw) = w; unsigned short* kt = (unsigned short*)KT + ((size_t)(h * NCH + c) * 256 + cw) * 256 + t;
                            kt[0] = (unsigned short)w.x; kt[256] = (unsigned short)(w.x >> 16); kt[512] = (unsigned short)w.y; kt[768] = (unsigned short)(w.y >> 16);
                            kt[1024] = (unsigned short)w.z; kt[1280] = (unsigned short)(w.z >> 16); kt[1536] = (unsigned short)w.w; kt[1792] = (unsigned short)(w.w >> 16); }
                        else if (which == 2) {
#pragma unroll
                            for (int d = 0; d < 2; ++d) { unsigned short* vt = (unsigned short*)VC + ((size_t)((d * 4 + h) * NCH + c) * 256 + cw) * 512 + t;
                                vt[0] = (unsigned short)w.x; vt[512] = (unsigned short)(w.x >> 16); vt[1024] = (unsigned short)w.y; vt[1536] = (unsigned short)(w.y >> 16);
                                vt[2048] = (unsigned short)w.z; vt[2560] = (unsigned short)(w.z >> 16); vt[3072] = (unsigned short)w.w; vt[3584] = (unsigned short)(w.w >> 16); } }
                        else *(v4u*)(O + (size_t)r * 1024 + h * 256 + cw) = w; } }
        } else {
            if (wc == 0 && fq < 2) { const f32x4 b0 = *(const f32x4*)(bias + OFF_G + 8 * fq), b1 = *(const f32x4*)(bias + OFF_G + 8 * fq + 4);
#pragma unroll
                for (int ai = 0; ai < 2; ++ai)
#pragma unroll
                    for (int m = 0; m < 4; ++m) { const int r = row0 + ai * 128 + m * 16;
                        *(f32x4*)(GATES + (size_t)r * 16 + 8 * fq) = acc[ai][0][m][0] + b0; *(f32x4*)(GATES + (size_t)r * 16 + 8 * fq + 4) = acc[ai][0][m][1] + b1; } }
        }
    }
};
struct EpiRes {
    static constexpr bool PERM = false;
    float* XR; const float* gate_c; const float* gate_x;
    __device__ __forceinline__ void operator()(const f32x4 (&acc)[2][2][4][2], const pg8::Unit& u, int wr, int wc, int fr, int fq) const {
        const int row0 = u.pm * 256 + wr * 64 + fr, col0 = u.pn * 256 + wc * 32 + 4 * fq; const float* gate = u.pm == 0 ? gate_c : gate_x;
        f32x4 gv[2][2];
#pragma unroll
        for (int bj = 0; bj < 2; ++bj)
#pragma unroll
            for (int n = 0; n < 2; ++n) gv[bj][n] = *(const f32x4*)(gate + col0 + bj * 128 + n * 16);
#pragma unroll
        for (int ai = 0; ai < 2; ++ai)
#pragma unroll
            for (int m = 0; m < 4; ++m) { float* rowp = XR + (size_t)(row0 + ai * 128 + m * 16) * D + col0;
#pragma unroll
                for (int bj = 0; bj < 2; ++bj)
#pragma unroll
                    for (int n = 0; n < 2; ++n) { f32x4* p = (f32x4*)(rowp + bj * 128 + n * 16); *p = *p + gv[bj][n] * acc[ai][bj][m][n]; } }
    }
};
struct EpiSwiglu {
    static constexpr bool PERM = true;
    bf16* HFF;
    __device__ __forceinline__ void operator()(const f32x4 (&acc)[2][2][4][2], const pg8::Unit& u, int wr, int wc, int fr, int fq) const {
        const int row0 = u.pm * 256 + wr * 64 + fr, hc = u.pn * 128 + wc * 32 + 8 * fq;
#pragma unroll
        for (int ai = 0; ai < 2; ++ai)
#pragma unroll
            for (int m = 0; m < 4; ++m) { const int r = row0 + ai * 128 + m * 16; float o[8];
#pragma unroll
                for (int j = 0; j < 4; ++j) { o[j] = siluf_(acc[ai][0][m][0][j]) * acc[ai][1][m][0][j]; o[4 + j] = siluf_(acc[ai][0][m][1][j]) * acc[ai][1][m][1][j]; }
                v4u w; w.x = pk2(o[0], o[1]); w.y = pk2(o[2], o[3]); w.z = pk2(o[4], o[5]); w.w = pk2(o[6], o[7]);
                *(v4u*)(HFF + (size_t)r * DFF + hc) = w; }
    }
};
struct EpiGlu {
    static constexpr bool PERM = true;
    const bf16* S5Gb; const float* bias; bf16* MIX;
    __device__ __forceinline__ void operator()(const f32x4 (&acc)[2][2][4][2], const pg8::Unit& u, int wr, int wc, int fr, int fq) const {
        const int row0 = u.pm * 256 + wr * 64 + fr;
#pragma unroll
        for (int bj = 0; bj < 2; ++bj) { const int col = u.pn * 256 + bj * 128 + wc * 32 + 8 * fq; const f32x4 b0 = *(const f32x4*)(bias + col), b1 = *(const f32x4*)(bias + col + 4);
#pragma unroll
            for (int ai = 0; ai < 2; ++ai)
#pragma unroll
                for (int m = 0; m < 4; ++m) { const int r = row0 + ai * 128 + m * 16; const v4u gw = *(const v4u*)(S5Gb + (size_t)r * S5W + col);
                    const f32x4 v0 = acc[ai][bj][m][0] + b0, v1 = acc[ai][bj][m][1] + b1; float o[8];
                    o[0] = bflo(gw.x) * sigmoidf_(v0[0]); o[1] = bfhi(gw.x) * sigmoidf_(v0[1]); o[2] = bflo(gw.y) * sigmoidf_(v0[2]); o[3] = bfhi(gw.y) * sigmoidf_(v0[3]);
                    o[4] = bflo(gw.z) * sigmoidf_(v1[0]); o[5] = bfhi(gw.z) * sigmoidf_(v1[1]); o[6] = bflo(gw.w) * sigmoidf_(v1[2]); o[7] = bfhi(gw.w) * sigmoidf_(v1[3]);
                    v4u w; w.x = pk2(o[0], o[1]); w.y = pk2(o[2], o[3]); w.z = pk2(o[4], o[5]); w.w = pk2(o[6], o[7]);
                    *(v4u*)(MIX + (size_t)r * D + col) = w; } }
    }
};

struct BatchOrder {
    int n, G, c, mode;
    __device__ __forceinline__ bool next(int i, pg8::Unit& u) const {
        const long L = (long)i * G + c; if (L >= n) return false; const int idx = (int)L;
        if (mode == 1) { const int d = idx >> 7, h = (idx >> 5) & 3, cc = idx & 31, ch = d == 0 ? cc : (cc == 0 ? 0 : cc + 1); u.pm = u.pn = (d * 4 + h) * NCH + ch; }
        else if (mode == 3) { u.pm = idx; u.pn = idx / 3; }
        else { u.pm = u.pn = idx; }
        return true;
    }
};
struct EpiG1 {
    static constexpr bool PERM = true;
    bf16* SQ; const float* CS; float* RSP;
    __device__ __forceinline__ void operator()(const f32x4 (&acc)[2][2][4][2], const pg8::Unit& u, int wr, int wc, int fr, int fq) const {
        const int h = u.pm / NCH, c = u.pm % NCH;
#pragma unroll
        for (int d = 0; d < 2; ++d) {
            const float* cs = CS + (size_t)(d * 4 + h) * R + c * 256 + wc * 32 + 8 * fq; f32x4 csv[2][2];
#pragma unroll
            for (int bj = 0; bj < 2; ++bj)
#pragma unroll
                for (int n = 0; n < 2; ++n) csv[bj][n] = *(const f32x4*)(cs + bj * 128 + 4 * n);
            bf16* dst = SQ + (size_t)((d * 4 + h) * NCH + c) * 256 * 512; float* rsp = RSP + ((size_t)(d * 4 + h) * R + c * 256) * 4 + wc;
#pragma unroll
            for (int ai = 0; ai < 2; ++ai)
#pragma unroll
                for (int m = 0; m < 4; ++m) { int t = ai * 128 + wr * 64 + m * 16 + fr; asm volatile("" : "+v"(t) :: "memory"); float rs = 0.f;
#pragma unroll
                    for (int bj = 0; bj < 2; ++bj) { const int s0 = bj * 128 + wc * 32 + 8 * fq; float o[8];
#pragma unroll
                        for (int n = 0; n < 2; ++n)
#pragma unroll
                            for (int j = 0; j < 4; ++j) { const int si = s0 + 4 * n + j; const bool ok = d == 0 ? si <= t : si >= t; const float v = acc[ai][bj][m][n][j] * csv[bj][n][j]; o[4 * n + j] = ok ? v : 0.f; rs += o[4 * n + j]; }
                        v4u w; w.x = pk2(o[0], o[1]); w.y = pk2(o[2], o[3]); w.z = pk2(o[4], o[5]); w.w = pk2(o[6], o[7]);
                        *(v4u*)(dst + (size_t)t * 512 + s0) = w; }
                    rs += __shfl_xor(rs, 16); rs += __shfl_xor(rs, 32); if (fq == 0) rsp[(size_t)t * 4] = rs; }
        }
    }
};
struct EpiS5Y {
    static constexpr bool PERM = true;
    bf16* S5Gb;
    __device__ __forceinline__ void operator()(const f32x4 (&acc)[2][2][4][2], const pg8::Unit& u, int wr, int wc, int fr, int fq) const {
        const int g = u.pn, mt = u.pm - 3 * u.pn;
#pragma unroll
        for (int ai = 0; ai < 2; ++ai)
#pragma unroll
            for (int m = 0; m < 4; ++m) { int ck = mt * 256 + ai * 128 + wr * 64 + m * 16 + fr; asm volatile("" : "+v"(ck) :: "memory");
                if (ck < NCK) {
#pragma unroll
                    for (int bj = 0; bj < 2; ++bj) { const int nc = bj * 128 + wc * 32 + 8 * fq, t = nc >> 4, c0 = nc & 15; float o[8];
#pragma unroll
                        for (int j = 0; j < 4; ++j) { o[j] = gelu_tanh_(acc[ai][bj][m][0][j]); o[4 + j] = gelu_tanh_(acc[ai][bj][m][1][j]); }
                        v4u w; w.x = pk2(o[0], o[1]); w.y = pk2(o[2], o[3]); w.z = pk2(o[4], o[5]); w.w = pk2(o[6], o[7]);
                        *(v4u*)(S5Gb + (size_t)(ck * 16 + t) * S5W + g * 16 + c0) = w; } } }
    }
};
struct EpiF32T {
    static constexpr bool PERM = false;
    float* base; size_t tile_stride; int ldc;
    __device__ __forceinline__ void operator()(const f32x4 (&acc)[2][2][4][2], const pg8::Unit& u, int wr, int wc, int fr, int fq) const {
        float* o = base + (size_t)u.pm * tile_stride + (size_t)(wr * 64 + fr) * ldc + wc * 32 + 4 * fq;
#pragma unroll
        for (int ai = 0; ai < 2; ++ai)
#pragma unroll
            for (int m = 0; m < 4; ++m) { float* rowp = o + (size_t)(ai * 128 + m * 16) * ldc;
#pragma unroll
                for (int bj = 0; bj < 2; ++bj)
#pragma unroll
                    for (int n = 0; n < 2; ++n) *(f32x4*)(rowp + bj * 128 + n * 16) = acc[ai][bj][m][n]; }
    }
};
struct EpiG3 {
    static constexpr bool PERM = false;
    float* HML;
    __device__ __forceinline__ void operator()(const f32x4 (&acc)[2][2][4][2], const pg8::Unit& u, int wr, int wc, int fr, int fq) const {
        const int dh = u.pm / NCH, c = u.pm % NCH, d = dh >> 2, h = dh & 3;
        float* o = HML + ((size_t)d * R + c * 256 + wr * 64 + fr) * MLW + h * 256 + wc * 32 + 4 * fq;
#pragma unroll
        for (int ai = 0; ai < 2; ++ai)
#pragma unroll
            for (int m = 0; m < 4; ++m) { float* rowp = o + (size_t)(ai * 128 + m * 16) * MLW;
#pragma unroll
                for (int bj = 0; bj < 2; ++bj)
#pragma unroll
                    for (int n = 0; n < 2; ++n) *(f32x4*)(rowp + bj * 128 + n * 16) = acc[ai][bj][m][n]; }
    }
};

constexpr int NPH = 12;
__global__ void __launch_bounds__(NTHR, 2) fwd(Args a) {
    extern __shared__ __attribute__((aligned(16))) unsigned char lds_raw[];
    LAS unsigned char* lds = (LAS unsigned char*)lds_raw;
    volatile LAS unsigned* MISC = (volatile LAS unsigned*)(lds + MISC_OFF);
    const int G = gridDim.x, bid = blockIdx.x, NGW = G * NWAVES;
    for (int u = threadIdx.x; u < (LDS_BYTES - LDSCTL_OFF) / 4; u += NTHR) ((LAS unsigned*)(lds + LDSCTL_OFF))[u] = 0u;
    __syncthreads();
    gu32* ctl = (gu32*)(a.ws + WS_CTL);
#define PH_WS CArgs* ap = (CArgs*)__builtin_amdgcn_kernarg_segment_ptr(); asm volatile("" : "+s"(ap)); unsigned char* ws = ap->ws;
#define MOD ((float*)(ws + WS_MOD))
#define XR ((float*)(ws + WS_XR))
#define HN ((bf16*)(ws + WS_HN))
#define U ((bf16*)(ws + WS_U))
#define CG ((bf16*)(ws + WS_CG))
#define Kb ((bf16*)(ws + WS_K))
#define Ob ((bf16*)(ws + WS_O))
#define GATES ((float*)(ws + WS_GATES))
#define MIX ((bf16*)(ws + WS_MIX))
#define HFF ((bf16*)(ws + WS_HFF))
#define YS ((float*)(ws + WS_YS))
#define S5Gb ((bf16*)(ws + WS_S5G))
#define HML ((float*)(ws + WS_HML))
    XcdBarrier bar; bar.bar = (unsigned*)(ctl + CW_BAR); bar.x = 0; bar.st = nullptr;
    if (a.use_bar) bar = xcd_barrier_post((unsigned*)(ctl + CW_BAR), MISC + 8);
#define GRID_BAR() do { if (a.use_bar) xcd_barrier(bar); } while (0)
#define PH_IDS PH_WS int tid = threadIdx.x; asm volatile("" : "+v"(tid)); const int lane = tid & 63, wave = __builtin_amdgcn_readfirstlane(tid >> 6), gw = bid * NWAVES + wave; (void)lane; (void)gw;

    if (PROMASK && a.do_pro) { PH_IDS
        {
            const size_t n4 = (size_t)R * D / 4, nc4 = (size_t)CTXL * D / 4;
            for (size_t i = (size_t)bid * NTHR + tid; i < n4; i += (size_t)G * NTHR) ((f32x4*)XR)[i] = i < nc4 ? ((const f32x4*)ap->ctx)[i] : ((const f32x4*)ap->x)[i - nc4];
        }
        {
            LAS float* scr = (LAS float*)(lds + wave * 16384);
            constexpr int I_IN = (D / 64) * (NIN / 32), I_OUT = (D / 64) * (D / 32), I_FI = (D / 64) * (2 * DFF / 32), I_FO = (DFF / 64) * (D / 32), I_GLU = (S5W / 64) * (S5W / 32);
            constexpr int I_L = I_IN + I_OUT + I_FI + I_FO + I_GLU;
            for (int it = gw; it < DEPTH * I_L; it += NGW) {
                const int l = it / I_L; int r = it % I_L; unsigned char* wl = ws + WS_W + (size_t)l * WL_STRIDE;
                if (r < I_IN) { const int nb = r % (NIN / 32), kb = r / (NIN / 32), nd = nb * 32, nsrc = win_src(nd); const int nv = nd + 32 <= INW ? 32 : (nd < INW ? INW - nd : 0);
                    transpose_item(ap->w_in + (size_t)l * D * INW, INW, (bf16*)(wl + WL_IN), D, kb * 64, nd, nv ? nsrc : 0, nv, scr, lane); continue; } r -= I_IN;
                if (r < I_OUT) { const int nb = r % (D / 32), kb = r / (D / 32); transpose_item(ap->w_out + (size_t)l * D * D, D, (bf16*)(wl + WL_OUT), D, kb * 64, nb * 32, nb * 32, 32, scr, lane); continue; } r -= I_OUT;
                if (r < I_FI) { const int nb = r % (2 * DFF / 32), kb = r / (2 * DFF / 32); transpose_item(ap->w_ffn_in + (size_t)l * D * 2 * DFF, 2 * DFF, (bf16*)(wl + WL_FI), D, kb * 64, nb * 32, wfi_src(nb * 32), 32, scr, lane); continue; } r -= I_FI;
                if (r < I_FO) { const int nb = r % (D / 32), kb = r / (D / 32); transpose_item(ap->w_ffn_out + (size_t)l * DFF * D, D, (bf16*)(wl + WL_FO), DFF, kb * 64, nb * 32, nb * 32, 32, scr, lane); continue; } r -= I_FO;
                { const int nb = r % (S5W / 32), kb = r / (S5W / 32); transpose_item(ap->s5_w_glu + (size_t)l * S5W * S5W, S5W, (bf16*)(wl + WL_GLU), S5W, kb * 64, nb * 32, nb * 32, 32, scr, lane); }
            }
        }
        __syncthreads();
        {
            LAS float* red = (LAS float*)lds;
            for (int it = bid; it < DEPTH * 48; it += G) {
                const int l = it / 48, cg = it % 48, col = cg * 256 + lane * 4;
                const float* W = ap->w_mod + (size_t)l * D * 6 * D + col; f32x4 s0 = {0.f, 0.f, 0.f, 0.f}, s1 = {0.f, 0.f, 0.f, 0.f};
#pragma unroll 8
                for (int k = wave * 256; k < wave * 256 + 256; ++k) { const f32x4 w = *(const f32x4*)(W + (size_t)k * 6 * D); const float cc = ap->c_ctx[k], cx = ap->c[k]; s0 += w * siluf_(cc); s1 += w * siluf_(cx); }
                *(LAS f32x4*)(red + (wave * 2 + 0) * 256 + lane * 4) = s0; *(LAS f32x4*)(red + (wave * 2 + 1) * 256 + lane * 4) = s1;
                __syncthreads();
                { const int ty = tid >> 8, cc = tid & 255; float s = ap->b_mod[(size_t)l * 6 * D + cg * 256 + cc];
#pragma unroll
                  for (int w = 0; w < 8; ++w) s += red[(w * 2 + ty) * 256 + cc];
                  MOD[((size_t)l * 2 + ty) * 6 * D + cg * 256 + cc] = s; }
                __syncthreads();
            }
        }
        __syncthreads();
        {
            LAS float* L = (LAS float*)lds; LAS float* pwr = L; LAS float* pwi = L + 2176; LAS float* bbr = L + 4352; LAS float* bbi = L + 6400; LAS float* ccr = L + 8448; LAS float* cci = L + 10496; LAS float* ktab = L + 12544;
            for (int task = bid; task < DEPTH * S5G; task += G) {
                const int l = task / S5G, g = task % S5G;
                if (tid < 128) { const int d = tid >> 6, p = tid & 63; const size_t pb = (((size_t)l * 2 + d) * S5G + g) * S5P + p;
                    const float lre = ap->s5_lam_re[pb], lim = ap->s5_lam_im[pb], st = __expf(ap->s5_log_step[pb]);
                    const float ea = __expf(lre * st), th = lim * st, cs = cosf(th), sn = sinf(th), lr = ea * cs, li = ea * sn;
                    const float sh = sinf(0.5f * th), m1r = expm1f(lre * st) * cs - 2.f * sh * sh, m1i = li;
                    const float dn = 1.f / (lre * lre + lim * lim), cr = (m1r * lre + m1i * lim) * dn, ci = (m1i * lre - m1r * lim) * dn;
                    float pr = 1.f, pi = 0.f;
                    for (int j = 0; j <= 16; ++j) { pwr[(d * 17 + j) * 64 + p] = pr; pwi[(d * 17 + j) * 64 + p] = pi; const float nr = pr * lr - pi * li, ni = pr * li + pi * lr; if (j < 16) { pr = nr; pi = ni; } }
                    float ar = pr, ai = pi;
                    for (int q = 0; q < 4; ++q) { const float nr = ar * ar - ai * ai, ni = 2.f * ar * ai; ar = nr; ai = ni; }
                    ((f32x4*)(ws + WS_LAMP))[(((size_t)l * S5G + g) * 2 + d) * 64 + p] = (f32x4){pr, pi, ar, ai};
                    for (int c = 0; c < 16; ++c) { const float br = ap->s5_b_re[pb * 16 + c], bi = ap->s5_b_im[pb * 16 + c]; bbr[(d * 64 + p) * 16 + c] = cr * br - ci * bi; bbi[(d * 64 + p) * 16 + c] = cr * bi + ci * br;
                        const size_t cb = ((((size_t)l * 2 + d) * S5G + g) * S5CH + c) * S5P + p; ccr[(d * 16 + c) * 64 + p] = ap->s5_c_re[cb]; cci[(d * 16 + c) * 64 + p] = ap->s5_c_im[cb]; } }
                __syncthreads();
                for (int e = tid; e < 8192; e += NTHR) { const int d = e >> 12, j = (e >> 8) & 15, c = (e >> 4) & 15, cp = e & 15; float s = 0.f;
                    for (int p = 0; p < 64; ++p) { const float xr = ccr[(d * 16 + c) * 64 + p], xi = cci[(d * 16 + c) * 64 + p], yr = pwr[(d * 17 + j) * 64 + p], yi = pwi[(d * 17 + j) * 64 + p];
                        const float zr = xr * yr - xi * yi, zi = xr * yi + xi * yr; s += zr * bbr[(d * 64 + p) * 16 + cp] - zi * bbi[(d * 64 + p) * 16 + cp]; }
                    ktab[e] = s; }
                __syncthreads();
                bf16* FC = (bf16*)(ws + WS_FC) + ((size_t)l * S5G + g) * 65536; bf16* WC = (bf16*)(ws + WS_WC) + ((size_t)l * S5G + g) * 131072; const float* dsk = ap->s5_d + (size_t)l * S5W + g * 16;
                for (int idx = tid; idx < 8192; idx += NTHR) { const int n = idx >> 5, k0 = (idx & 31) * 8, d = n >> 7, p = (n >> 1) & 63, ri = n & 1, sI = k0 >> 4, c0 = k0 & 15, e = d == 0 ? 15 - sI : sI;
                    const float yr = pwr[(d * 17 + e) * 64 + p], yi = pwi[(d * 17 + e) * 64 + p]; float o[8];
#pragma unroll
                    for (int i = 0; i < 8; ++i) { const float br = bbr[(d * 64 + p) * 16 + c0 + i], bi = bbi[(d * 64 + p) * 16 + c0 + i]; o[i] = ri == 0 ? yr * br - yi * bi : yr * bi + yi * br; }
                    v4u w; w.x = pk2(o[0], o[1]); w.y = pk2(o[2], o[3]); w.z = pk2(o[4], o[5]); w.w = pk2(o[6], o[7]); *(v4u*)(FC + (size_t)n * 256 + k0) = w; }
                for (int idx = tid; idx < 16384; idx += NTHR) { const int n = idx >> 6, k0 = (idx & 63) * 8, t = n >> 4, c = n & 15; float o[8];
                    if (k0 < 256) { const int sI = k0 >> 4, c0 = k0 & 15;
#pragma unroll
                        for (int i = 0; i < 8; ++i) { float v = 0.f; if (sI <= t) v += ktab[((0 * 16 + (t - sI)) * 16 + c) * 16 + c0 + i]; if (sI >= t) v += ktab[((1 * 16 + (sI - t)) * 16 + c) * 16 + c0 + i]; if (sI == t && c0 + i == c) v += dsk[c]; o[i] = v; }
                    } else { const int kk = k0 - 256, d = kk >> 7, p0 = (kk & 127) >> 1, mm = d == 0 ? t + 1 : 16 - t;
#pragma unroll
                        for (int i = 0; i < 4; ++i) { const int p = p0 + i; const float xr = ccr[(d * 16 + c) * 64 + p], xi = cci[(d * 16 + c) * 64 + p], yr = pwr[(d * 17 + mm) * 64 + p], yi = pwi[(d * 17 + mm) * 64 + p];
                            o[2 * i] = xr * yr - xi * yi; o[2 * i + 1] = -(xr * yi + xi * yr); } }
                    v4u w; w.x = pk2(o[0], o[1]); w.y = pk2(o[2], o[3]); w.z = pk2(o[4], o[5]); w.w = pk2(o[6], o[7]); *(v4u*)(WC + (size_t)n * 512 + k0) = w; }
                __syncthreads();
            }
        }
        GRID_BAR();
    }

    const int plo = a.ph_lo, phi = a.ph_hi;
#define IN(k) (((PHMASK >> (k)) & 1) && plo <= (k) && (k) < phi)
    for (int l = a.l_lo; l < a.l_hi; ++l) {
#define wl (ws + WS_W + (size_t)l * WL_STRIDE)
#define modc (MOD + ((size_t)l * 2 + 0) * 6 * D)
#define modx (MOD + ((size_t)l * 2 + 1) * 6 * D)
#define NORM_PHASE(gvec, SH, SC) do { \
            for (int r = gw; r < R; r += NGW) { const float* md = r < CTXL ? modc : modx; const f32x4* xr = (const f32x4*)(XR + (size_t)r * D) + lane; f32x4 v[8]; float ss = 0.f; \
                _Pragma("unroll") for (int j = 0; j < 8; ++j) { v[j] = xr[64 * j]; ss += (v[j].x * v[j].x + v[j].y * v[j].y) + (v[j].z * v[j].z + v[j].w * v[j].w); } \
                const float rstd = 1.f / sqrtf(wave_sum(ss) * (1.f / D) + EPS); \
                _Pragma("unroll") for (int j = 0; j < 8; ++j) { const int c0 = lane * 4 + 256 * j; const f32x4 gg = *(const f32x4*)((gvec) + c0), sc = *(const f32x4*)(md + (SC) * D + c0), sh = *(const f32x4*)(md + (SH) * D + c0); \
                    const f32x4 o = v[j] * rstd * gg * (sc + 1.f) + sh; v2u w; w.x = pk2(o.x, o.y); w.y = pk2(o.z, o.w); *(v2u*)(HN + (size_t)r * D + c0) = w; } } } while (0)
        if (IN(0)) { PH_IDS const float* g1n = ap->norm1_g + (size_t)l * D; NORM_PHASE(g1n, 0, 1); GRID_BAR(); }

        if (IN(1)) { PH_WS
            pg8::Gemm g{HN, (const bf16*)(wl + WL_IN), D, D, D}; pg8::StaticOrder S; S.init(NPAN, NIN / 256, G, bid);
            EpiWin E{ap->b_in + (size_t)l * INW, U, CG, (bf16*)(ws + WS_SQ), Kb, (bf16*)(ws + WS_KT), (bf16*)(ws + WS_VC), Ob, GATES};
            pg8::gemm_phase<EpiWin, pg8::StaticOrder, true, true>(lds, g, S, E);
            GRID_BAR();
        }

        if (IN(2)) { PH_IDS
            { pg8::Gemm g{U, (const bf16*)(ws + WS_FC) + (size_t)l * S5G * 65536, UPITCH, 256, 256}; BatchOrder S{S5G * 3, G, (bid + 96) % G, 3};
              EpiF32T E{(float*)(ws + WS_EB), 65536, 256};
              pg8::gemm_phase<EpiF32T, BatchOrder, true, true>(lds, g, S, E); }
            {
                LAS float* wsl = (LAS float*)(lds + 65536);
                float* BC = (float*)(ws + WS_BC); float* CS = (float*)(ws + WS_CS); float* DN = (float*)(ws + WS_DN); float* AT = (float*)(ws + WS_AT);
                for (int task = bid; task < 2 * MLH * NCH; task += G) {
                    const int d = task / (MLH * NCH), h = (task / NCH) % MLH, c = task % NCH, dh = d * 4 + h;
                    if (wave == 0) { float lf[4], li[4], b[4]; float run = 0.f;
#pragma unroll
                        for (int j = 0; j < 4; ++j) { const int tp = lane * 4 + j, rr = c * 256 + (d ? 255 - tp : tp); const float gf = GATES[(size_t)rr * 16 + d * 8 + 4 + h]; li[j] = GATES[(size_t)rr * 16 + d * 8 + h];
                            lf[j] = fminf(gf, 0.f) - log1pf(__expf(-fabsf(gf))); run += lf[j]; b[j] = run; }
                        float inc = run;
#pragma unroll
                        for (int o = 1; o < 64; o <<= 1) { const float v = __shfl_up(inc, o); if (lane >= o) inc += v; }
                        const float excl = inc - run, btot = __shfl(inc, 63);
#pragma unroll
                        for (int j = 0; j < 4; ++j) { const int tp = lane * 4 + j, ir = d ? 255 - tp : tp; const float bb = b[j] + excl;
                            BC[(size_t)dh * R + c * 256 + ir] = bb; CS[(size_t)dh * R + c * 256 + ir] = __expf(li[j] - bb); wsl[ir] = __expf(btot - bb + li[j]); }
                        if (lane == 0) AT[dh * NCH + c] = __expf(btot); }
                    __syncthreads();
                    const bf16* kt = (const bf16*)(ws + WS_KT) + (size_t)(h * NCH + c) * 65536; bf16* ktw = (bf16*)(ws + WS_KTW) + (size_t)(dh * NCH + c) * 65536;
#pragma unroll 4
                    for (int i = 0; i < 16; ++i) { const int idx = tid + NTHR * i, dk = idx >> 5, s0 = (idx & 31) * 8; const v4u kv = *(const v4u*)(kt + (size_t)dk * 256 + s0);
                        const f32x4 w0 = *(const LAS f32x4*)(wsl + s0), w1 = *(const LAS f32x4*)(wsl + s0 + 4);
                        const float o0 = bflo(kv.x) * w0.x, o1 = bfhi(kv.x) * w0.y, o2 = bflo(kv.y) * w0.z, o3 = bfhi(kv.y) * w0.w, o4 = bflo(kv.z) * w1.x, o5 = bfhi(kv.z) * w1.y, o6 = bflo(kv.w) * w1.z, o7 = bfhi(kv.w) * w1.w;
                        v4u w; w.x = pk2(o0, o1); w.y = pk2(o2, o3); w.z = pk2(o4, o5); w.w = pk2(o6, o7); *(v4u*)(ktw + (size_t)dk * 256 + s0) = w;
                        float rs = ((o0 + o1) + (o2 + o3)) + ((o4 + o5) + (o6 + o7));
#pragma unroll
                        for (int o = 1; o < 32; o <<= 1) rs += __shfl_xor(rs, o);
                        if ((lane & 31) == 0) DN[(size_t)(dh * NCH + c) * 256 + dk] = rs; }
                    __syncthreads();
                }
            }
#if MLDBG
            {
                LAS float* red = (LAS float*)(lds + 65536 + 4096);
                float* HREF = (float*)(ws + WS_END); float* DREF = HREF + (size_t)2 * R * MLW;
                const bf16* SQd = (const bf16*)(ws + WS_SQ); const bf16* VCd = (const bf16*)(ws + WS_VC);
                for (int un = bid; un < 256; un += G) {
                    const int h = un >> 6, d = (un >> 5) & 1, sl = un & 31, dk = tid & 255, hf = tid >> 8, dv0 = sl * 8 + hf * 4;
                    float C0 = 0.f, C1 = 0.f, C2 = 0.f, C3 = 0.f, nn = 0.f;
                    for (int tau = 0; tau < R; ++tau) {
                        const int r = tau_row(d, tau), c = r >> 8, t = r & 255;
                        const float q = bf2f(SQd[((size_t)(h * NCH + c) * 256 + t) * 512 + 256 + dk]), k = bf2f(Kb[((size_t)h * R + r) * 256 + dk]);
                        const bf16* vp = VCd + ((size_t)(h * NCH + c) * 256 + dv0) * 512 + t; const float v0 = bf2f(vp[0]), v1 = bf2f(vp[512]), v2 = bf2f(vp[1024]), v3 = bf2f(vp[1536]);
                        const float gi = GATES[(size_t)r * 16 + d * 8 + h], gf = GATES[(size_t)r * 16 + d * 8 + 4 + h];
                        const float f = sigmoidf_(gf), ik = __expf(gi) * k;
                        C0 = f * C0 + ik * v0; C1 = f * C1 + ik * v1; C2 = f * C2 + ik * v2; C3 = f * C3 + ik * v3; nn = f * nn + ik;
                        const float s0 = wave_sum(q * C0), s1 = wave_sum(q * C1), s2 = wave_sum(q * C2), s3 = wave_sum(q * C3), s4 = wave_sum(q * nn);
                        LAS float* rb = red + (tau & 1) * 40 + wave * 5;
                        if (lane == 0) { rb[0] = s0; rb[1] = s1; rb[2] = s2; rb[3] = s3; rb[4] = s4; }
                        __syncthreads();
                        if (tid < 8) { const int h2 = tid >> 2, j = tid & 3; const LAS float* rr = red + (tau & 1) * 40 + h2 * 20; const float num = rr[j] + rr[5 + j] + rr[10 + j] + rr[15 + j], den = rr[4] + rr[9] + rr[14] + rr[19];
                            HREF[((size_t)d * R + r) * MLW + h * 256 + sl * 8 + h2 * 4 + j] = num / fmaxf(fabsf(den), 1.f); if (sl == 0 && tid == 0) DREF[((size_t)d * R + r) * 4 + h] = den; }
                    }
                    __syncthreads();
                }
            }
#endif
            {
                LAS float* red = (LAS float*)(lds + 98304);
                const int ch = tid; float wv[CONVK];
#pragma unroll
                for (int j = 0; j < CONVK; ++j) wv[j] = ap->conv_dw_w[((size_t)l * CONVK + j) * CONVW + ch];
                const float dwb = ap->conv_dw_b[(size_t)l * CONVW + ch], lg = ap->conv_ln_g[(size_t)l * CONVW + ch], lb = ap->conv_ln_b[(size_t)l * CONVW + ch];
                for (int un = bid; un < 129; un += G) {
                    const int row0 = un == 0 ? 0 : CTXL + (un - 1) * 64, len = un == 0 ? CTXL : 64;
                    for (int t = 0; t < len; ++t) { float y = dwb;
#pragma unroll
                        for (int j = 0; j < CONVK; ++j) { const int tt = t + j - CONVK / 2; if (tt >= 0 && tt < len) y += wv[j] * bf2f(CG[(size_t)(row0 + tt) * CONVW + ch]); }
                        float s = wave_sum(y); if (lane == 0) red[wave] = s; __syncthreads();
                        float mean = 0.f;
#pragma unroll
                        for (int w = 0; w < 8; ++w) mean += red[w];
                        mean *= (1.f / CONVW); const float dy = y - mean; float q = wave_sum(dy * dy); if (lane == 0) red[8 + wave] = q; __syncthreads();
                        float var = 0.f;
#pragma unroll
                        for (int w = 0; w < 8; ++w) var += red[8 + w];
                        var *= (1.f / CONVW); const float o = dy / sqrtf(var + LN_EPS) * lg + lb;
                        ((unsigned short*)MIX)[(size_t)(row0 + t) * D + S5W + ch] = (unsigned short)f2bf(siluf_(o));
                        __syncthreads(); }
                }
            }
            GRID_BAR();
        }

        if (IN(3)) { PH_IDS
            {
                const float* EB = (const float*)(ws + WS_EB); pg8::f32x2* ESC = (pg8::f32x2*)(ws + WS_ESC);
                for (int task = gw; task < S5G * 2 * NSC; task += NGW) { const int g = task / (2 * NSC), d = (task / NSC) & 1, sc = task % NSC;
                    const f32x4 lp = ((const f32x4*)(ws + WS_LAMP))[(((size_t)l * S5G + g) * 2 + d) * 64 + lane]; pg8::f32x2 e[16];
#pragma unroll
                    for (int j = 0; j < 16; ++j) { const int tc = sc * 16 + j, rc = d == 0 ? tc : (tc < CTXCK ? CTXCK - 1 - tc : NCK - 1 + CTXCK - tc); e[j] = *(const pg8::f32x2*)(EB + ((size_t)g * UROWS + rc) * 256 + d * 128 + 2 * lane); }
                    float hr = 0.f, hi = 0.f;
#pragma unroll
                    for (int j = 0; j < 16; ++j) { const float nr = lp.x * hr - lp.y * hi + e[j].x, ni = lp.x * hi + lp.y * hr + e[j].y; hr = nr; hi = ni; }
                    ESC[((size_t)(g * 2 + d) * NSC + sc) * 64 + lane] = (pg8::f32x2){hr, hi}; }
            }
            { pg8::Gemm g{(const bf16*)(ws + WS_SQ) + 256, Kb, 512, 256, 256}; BatchOrder S{MLH * NCH, G, bid, 0};
              EpiG1 E{(bf16*)(ws + WS_SQ), (const float*)(ws + WS_CS), (float*)(ws + WS_RSP)};
              pg8::gemm_phase<EpiG1, BatchOrder, true, true>(lds, g, S, E); }
            { pg8::Gemm g{(const bf16*)(ws + WS_VC), (const bf16*)(ws + WS_KTW), 512, 256, 256}; BatchOrder S{256, G, bid, 1};
              EpiF32T E{(float*)(ws + WS_DC), 65536, 256};
              pg8::gemm_phase<EpiF32T, BatchOrder, true, true>(lds, g, S, E); }
            GRID_BAR();
        }

        if (IN(4)) { PH_IDS
            const float* DC = (const float*)(ws + WS_DC); const float* AT = (const float*)(ws + WS_AT); bf16* VC = (bf16*)(ws + WS_VC);
            for (int b = bid; b < 256; b += G) {
                const int dh = b >> 5, d = dh >> 2, part = b & 31, dv = part * 8 + (tid >> 6), dk0 = (tid & 63) * 4;
                f32x4 C = {0.f, 0.f, 0.f, 0.f}; float nn = 0.f;
                *(v2u*)(VC + ((size_t)(dh * NCH) * 256 + dv) * 512 + 256 + dk0) = (v2u){0u, 0u};
                if (part == 0 && tid < 256) ((float*)(ws + WS_NIN))[(size_t)(dh * NCH) * 256 + tid] = 0.f;
                int c = 0; f32x4 dc = *(const f32x4*)(DC + ((size_t)(dh * NCH + c) * 256 + dv) * 256 + dk0);
                for (int st = 0; st < NCH - 1; ++st) {
                    const int cn = d == 0 ? st + 1 : NCH - 1 - st; const f32x4 dcur = dc; const float A = AT[dh * NCH + c];
                    float dn = 0.f; if (part == 0 && tid < 256) dn = ((const float*)(ws + WS_DN))[(size_t)(dh * NCH + c) * 256 + tid];
                    if (st + 1 < NCH - 1) dc = *(const f32x4*)(DC + ((size_t)(dh * NCH + cn) * 256 + dv) * 256 + dk0);
                    C = C * A + dcur; v2u w; w.x = pk2(C.x, C.y); w.y = pk2(C.z, C.w);
                    *(v2u*)(VC + ((size_t)(dh * NCH + cn) * 256 + dv) * 512 + 256 + dk0) = w;
                    if (part == 0 && tid < 256) { nn = nn * A + dn; ((float*)(ws + WS_NIN))[(size_t)(dh * NCH + cn) * 256 + tid] = nn; }
                    c = cn; }
            }
            {
                const float* EB = (const float*)(ws + WS_EB); const pg8::f32x2* ESC = (const pg8::f32x2*)(ws + WS_ESC);
                for (int task = gw; task < S5G * 2 * NSC; task += NGW) { const int g = task / (2 * NSC), d = (task / NSC) & 1, sc = task % NSC;
                    const f32x4 lp = ((const f32x4*)(ws + WS_LAMP))[(((size_t)l * S5G + g) * 2 + d) * 64 + lane]; pg8::f32x2 e[16];
#pragma unroll
                    for (int j = 0; j < 16; ++j) { const int tc = sc * 16 + j, rc = d == 0 ? tc : (tc < CTXCK ? CTXCK - 1 - tc : NCK - 1 + CTXCK - tc); e[j] = *(const pg8::f32x2*)(EB + ((size_t)g * UROWS + rc) * 256 + d * 128 + 2 * lane); }
                    float hr = 0.f, hi = 0.f;
                    for (int s2 = 0; s2 < sc; ++s2) { const pg8::f32x2 es = ESC[((size_t)(g * 2 + d) * NSC + s2) * 64 + lane]; const float nr = lp.z * hr - lp.w * hi + es.x, ni = lp.z * hi + lp.w * hr + es.y; hr = nr; hi = ni; }
#pragma unroll
                    for (int j = 0; j < 16; ++j) { const int tc = sc * 16 + j, rc = d == 0 ? tc : (tc < CTXCK ? CTXCK - 1 - tc : NCK - 1 + CTXCK - tc);
                        *(unsigned*)(U + ((size_t)g * UROWS + rc) * UPITCH + 256 + d * 128 + 2 * lane) = pk2(hr, hi);
                        const float nr = lp.x * hr - lp.y * hi + e[j].x, ni = lp.x * hi + lp.y * hr + e[j].y; hr = nr; hi = ni; } }
            }
            GRID_BAR();
        }

        if (IN(5)) { PH_WS
            pg8::Gemm g{(const bf16*)(ws + WS_SQ), (const bf16*)(ws + WS_VC), 512, 512, 512}; BatchOrder S{2 * MLH * NCH, G, bid, 2};
            EpiG3 E{HML};
            pg8::gemm_phase<EpiG3, BatchOrder, true, true>(lds, g, S, E);
            { pg8::Gemm g2{U, (const bf16*)(ws + WS_WC) + (size_t)l * S5G * 131072, UPITCH, 512, 512}; BatchOrder S2{S5G * 3, G, (bid + 96) % G, 3};
              EpiS5Y E2{S5Gb};
              pg8::gemm_phase<EpiS5Y, BatchOrder, true, true>(lds, g2, S2, E2); }
            GRID_BAR();
        }

        if (IN(6)) { PH_IDS
            const float* ng = ap->ml_norm_g + (size_t)l * MLW;
            const float* BC = (const float*)(ws + WS_BC); const float* RSP = (const float*)(ws + WS_RSP); const float* NIN = (const float*)(ws + WS_NIN); const bf16* SQ = (const bf16*)(ws + WS_SQ);
            for (int it = gw; it < R * MLH; it += NGW) { const int r = it >> 2, h = it & 3, c = r >> 8, t = r & 255; const size_t o0 = (size_t)r * MLW + h * 256 + lane * 4;
                const v2u qw = *(const v2u*)(SQ + ((size_t)(h * NCH + c) * 256 + t) * 512 + 256 + lane * 4); const f32x4 q = {bflo(qw.x), bfhi(qw.x), bflo(qw.y), bfhi(qw.y)};
                f32x4 v = {0.f, 0.f, 0.f, 0.f};
#pragma unroll
                for (int d = 0; d < 2; ++d) { const int dh = d * 4 + h; const f32x4 n4 = *(const f32x4*)(NIN + (size_t)(dh * NCH + c) * 256 + lane * 4);
                    const float qn = wave_sum((q.x * n4.x + q.y * n4.y) + (q.z * n4.z + q.w * n4.w)); const f32x4 rp = *(const f32x4*)(RSP + ((size_t)dh * R + r) * 4);
                    const float aa = __expf(BC[(size_t)dh * R + r]), den = aa * ((rp.x + rp.y) + (rp.z + rp.w) + qn);
#if MLDBG
                    { const f32x4 hn = *(const f32x4*)(HML + (size_t)d * R * MLW + o0) * (aa / fmaxf(fabsf(den), 1.f)); const float* HREF = (const float*)(ws + WS_END); const float* DREF = HREF + (size_t)2 * R * MLW;
                      const f32x4 hr = *(const f32x4*)(HREF + (size_t)d * R * MLW + o0); const f32x4 df = hn - hr; const float dref = DREF[((size_t)d * R + r) * 4 + h];
                      const float e2 = wave_sum((df.x * df.x + df.y * df.y) + (df.z * df.z + df.w * df.w)), r2 = wave_sum((hr.x * hr.x + hr.y * hr.y) + (hr.z * hr.z + hr.w * hr.w));
                      if (lane == 0 && l == 0) { float* cnt = (float*)(ws + WS_CTL) + 8192;
                          atomicAdd(cnt + 2 * d, e2); atomicAdd(cnt + 2 * d + 1, r2);
                          if (c == 0) { atomicAdd(cnt + 4, e2); atomicAdd(cnt + 5, r2); }
                          atomicAdd(cnt + 6 + 2 * (h >> 1), e2); atomicAdd(cnt + 7 + 2 * (h >> 1), r2);
                          atomicAdd(cnt + 10, (den - dref) * (den - dref)); atomicAdd(cnt + 11, dref * dref); }
                      v += hr; }
#else
                    v += *(const f32x4*)(HML + (size_t)d * R * MLW + o0) * (aa / fmaxf(fabsf(den), 1.f));
#endif
                }
                const float mean = wave_sum((v.x + v.y) + (v.z + v.w)) * (1.f / 256.f); const f32x4 dv = v - mean;
                const float var = wave_sum((dv.x * dv.x + dv.y * dv.y) + (dv.z * dv.z + dv.w * dv.w)) * (1.f / 256.f), rstd = 1.f / sqrtf(var + LN_EPS);
                const f32x4 gg = *(const f32x4*)(ng + h * 256 + lane * 4); const v2u ow = *(const v2u*)(Ob + o0);
                const f32x4 o = {sigmoidf_(bflo(ow.x)) * dv.x * rstd * gg.x, sigmoidf_(bfhi(ow.x)) * dv.y * rstd * gg.y, sigmoidf_(bflo(ow.y)) * dv.z * rstd * gg.z, sigmoidf_(bfhi(ow.y)) * dv.w * rstd * gg.w};
                v2u w; w.x = pk2(o.x, o.y); w.y = pk2(o.z, o.w); *(v2u*)(MIX + (size_t)r * D + 1024 + h * 256 + lane * 4) = w; }
            GRID_BAR();
        }

        if (IN(7)) { PH_WS
            pg8::Gemm g{S5Gb, (const bf16*)(wl + WL_GLU), S5W, S5W, S5W}; pg8::StaticOrder S; S.init(NPAN, S5W / 256, G, bid);
            EpiGlu E{S5Gb, ap->s5_b_glu + (size_t)l * S5W, MIX};
            pg8::gemm_phase<EpiGlu, pg8::StaticOrder, true, true>(lds, g, S, E);
            GRID_BAR();
        }

        if (IN(8)) { PH_WS
            pg8::Gemm g{MIX, (const bf16*)(wl + WL_OUT), D, D, D}; pg8::StaticOrder S; S.init(NPAN, D / 256, G, bid);
            EpiRes E{XR, modc + 2 * D, modx + 2 * D};
            pg8::gemm_phase<EpiRes, pg8::StaticOrder, true, true>(lds, g, S, E);
            GRID_BAR();
        }

        if (IN(9)) { PH_IDS const float* g2n = ap->norm2_g + (size_t)l * D; NORM_PHASE(g2n, 3, 4); GRID_BAR(); }

        if (IN(10)) { PH_WS
            pg8::Gemm g{HN, (const bf16*)(wl + WL_FI), D, D, D}; pg8::StaticOrder S; S.init(NPAN, 2 * DFF / 256, G, bid);
            EpiSwiglu E{HFF};
            pg8::gemm_phase<EpiSwiglu, pg8::StaticOrder, true, true>(lds, g, S, E);
            GRID_BAR();
        }

        if (IN(11)) { PH_WS
            pg8::Gemm g{HFF, (const bf16*)(wl + WL_FO), DFF, DFF, DFF}; pg8::StaticOrder S; S.init(NPAN, D / 256, G, bid);
            EpiRes E{XR, modc + 5 * D, modx + 5 * D};
            pg8::gemm_phase<EpiRes, pg8::StaticOrder, true, true>(lds, g, S, E);
            GRID_BAR();
        }
    }

    if (a.do_fin) { PH_IDS
#if MLDBG
        float Pdbg = 0.f;
        if (bid == 0 && tid == 0) { const float* cnt = (const float*)(ws + WS_CTL) + 8192;
            for (int k = 0; k < 6; ++k) { const float e = __hip_atomic_load(cnt + 2 * k, __ATOMIC_RELAXED, __HIP_MEMORY_SCOPE_AGENT), rr = __hip_atomic_load(cnt + 2 * k + 1, __ATOMIC_RELAXED, __HIP_MEMORY_SCOPE_AGENT); if (e > MLDBG_THR * MLDBG_THR * rr) Pdbg += (float)(1 << k); } }
#endif
        for (int r = CTXL + gw; r < R; r += NGW) { const f32x4* xr = (const f32x4*)(XR + (size_t)r * D) + lane; f32x4 v[8]; float ss = 0.f;
#pragma unroll
            for (int j = 0; j < 8; ++j) { v[j] = xr[64 * j]; ss += (v[j].x * v[j].x + v[j].y * v[j].y) + (v[j].z * v[j].z + v[j].w * v[j].w); }
            const float rstd = 1.f / sqrtf(wave_sum(ss) * (1.f / D) + EPS);
#pragma unroll
            for (int j = 0; j < 8; ++j) { const int c0 = lane * 4 + 256 * j; *(f32x4*)(ap->out + (size_t)(r - CTXL) * D + c0) = v[j] * rstd * *(const f32x4*)(ap->norm_f_g + c0); } }
#if MLDBG
        if (bid == 0 && tid == 0) { asm volatile("s_waitcnt vmcnt(0)" ::: "memory"); ap->out[0] += Pdbg; }
#endif
    }
#undef IN
#undef NORM_PHASE
#undef GRID_BAR
}

extern "C" void kernel_launch(void* const* d_in, const int* in_sizes, int n_in, void* d_out, int out_size, void* d_ws, size_t ws_size, hipStream_t stream) {
    static int grid = 0;
    if (grid == 0) {
        if (n_in != 29 || in_sizes[0] != SEQ * D || out_size != SEQ * D || ws_size < WS_END) { fprintf(stderr, "kernel_launch: unexpected problem (n_in %d, in0 %d, out %d, ws %zu < %zu)\n", n_in, n_in > 0 ? in_sizes[0] : -1, out_size, ws_size, (size_t)WS_END); grid = -1; return; }
        int dev = 0, cus = 0, per_cu = 0;
        if (hipGetDevice(&dev) != hipSuccess || hipDeviceGetAttribute(&cus, hipDeviceAttributeMultiprocessorCount, dev) != hipSuccess) { grid = -1; return; }
        if (hipFuncSetAttribute((const void*)fwd, hipFuncAttributeMaxDynamicSharedMemorySize, LDS_BYTES) != hipSuccess) { fprintf(stderr, "kernel_launch: hipFuncSetAttribute failed\n"); grid = -1; return; }
        if (hipOccupancyMaxActiveBlocksPerMultiprocessor(&per_cu, (const void*)fwd, NTHR, LDS_BYTES) != hipSuccess || per_cu < 1) fprintf(stderr, "kernel_launch: occupancy query says %d\n", per_cu);
        (void)hipGetLastError();
        grid = cus;
    }
    if (grid < 0) return;
    (void)hipMemsetAsync((char*)d_ws + WS_CTL, 0, CTL_ZERO_BYTES, stream);
    Args a{};
    const float** pp = (const float**)&a;
    for (int i = 0; i < 29; ++i) pp[i] = (const float*)d_in[i];
    a.out = (float*)d_out; a.ws = (unsigned char*)d_ws;
#if MK_SINGLE
    a.l_lo = 0; a.l_hi = DEPTH; a.ph_lo = 0; a.ph_hi = NPH; a.do_pro = 1; a.do_fin = 1; a.use_bar = 1;
    hipLaunchKernelGGL(fwd, dim3(grid), dim3(NTHR), LDS_BYTES, stream, a);
#else
    a.use_bar = 0;
    a.l_lo = 0; a.l_hi = 0; a.ph_lo = 0; a.ph_hi = 0; a.do_pro = 1; a.do_fin = 0;
    hipLaunchKernelGGL(fwd, dim3(grid), dim3(NTHR), LDS_BYTES, stream, a);
    a.do_pro = 0;
    for (int l = 0; l < DEPTH; ++l) for (int p = 0; p < NPH; ++p) { a.l_lo = l; a.l_hi = l + 1; a.ph_lo = p; a.ph_hi = p + 1; hipLaunchKernelGGL(fwd, dim3(grid), dim3(NTHR), LDS_BYTES, stream, a); }
    a.l_lo = 0; a.l_hi = 0; a.ph_lo = 0; a.ph_hi = 0; a.do_fin = 1;
    hipLaunchKernelGGL(fwd, dim3(grid), dim3(NTHR), LDS_BYTES, stream, a);
#endif
}
```

```cpp
#include <hip/hip_runtime.h>
#include <cstdio>
#include <cstdint>

#ifndef PHMASK
#define PHMASK 0xfff
#endif
#ifndef PROMASK
#define PROMASK 1
#endif
#ifndef MLDBG
#define MLDBG 0
#endif
#ifndef MLDBG_THR
#define MLDBG_THR 0.03f
#endif
#ifndef MK_SINGLE
#define MK_SINGLE 1
#endif

namespace pg8 {
#define PG8_LAS __attribute__((address_space(3)))
typedef unsigned short bf16_t;
typedef short bf16x8 __attribute__((ext_vector_type(8)));
typedef float f32x4 __attribute__((ext_vector_type(4)));
typedef float f32x2 __attribute__((ext_vector_type(2)));
typedef unsigned u32x4 __attribute__((ext_vector_type(4)));
constexpr int BM = 256, BK = 64, HALF = 128, HTB = HALF * BK * 2, STAGE_BYTES = 8 * HTB, NXCD = 8, WGM = 8;

__host__ __device__ __forceinline__ int lds_byte(int r, int c) { const int st = (r >> 4) * 2 + (c >> 5), rr = r & 15, cc = c & 31, ob = rr * 64 + cc * 2; return st * 1024 + (ob ^ (((ob >> 9) & 1) << 5)); }
__host__ __device__ __forceinline__ void stage_rc(int b, int& R, int& C) { const int st = b / 1024, sb = b % 1024, swz = sb ^ (((sb >> 9) & 1) << 5); R = (st >> 1) * 16 + swz / 64; C = (st & 1) * 32 + (swz % 64) / 2; }
__host__ __device__ __forceinline__ int perm32(int rho) { const int n = rho >> 4, i = rho & 15; return 8 * (i >> 2) + 4 * n + (i & 3); }

struct Unit { int pm, pn; };
struct Gemm { const bf16_t* A; const bf16_t* Bt; int lda, ldb, K; };

struct StaticOrder {
    int nM, nN, nwg, G, c;
    __host__ __device__ void init(int nM_, int nN_, int G_, int c_) { nM = nM_; nN = nN_; nwg = nM * nN; G = G_; c = c_; }
    __host__ __device__ bool next(int i, Unit& u) const {
        const long L = (long)i * G + c; if (L >= nwg) return false;
        int wgid = (int)L; { const int q = nwg / NXCD, r = nwg % NXCD, xcd = wgid % NXCD, off = wgid / NXCD; wgid = (xcd < r ? xcd * (q + 1) : r * (q + 1) + (xcd - r) * q) + off; }
        const int nig = WGM * nN, gid = wgid / nig, fm = gid * WGM, gsz = (nM - fm) < WGM ? (nM - fm) : WGM;
        u.pm = fm + ((wgid % nig) % gsz); u.pn = (wgid % nig) / gsz; return true;
    }
};

__device__ __forceinline__ unsigned cvt_pk_bf16(float lo, float hi) { unsigned r; asm volatile("v_cvt_pk_bf16_f32 %0, %1, %2" : "=v"(r) : "v"(lo), "v"(hi)); return r; }

template <class Epi, class Sched, bool ALIGN_EPI = false, bool SP2 = false>
__device__ __forceinline__ void gemm_phase(PG8_LAS unsigned char* lds, const Gemm g, const Sched& S, const Epi& E) {
    int tid_o = threadIdx.x; asm volatile("" : "+v"(tid_o));
    const int tid = tid_o, wid = __builtin_amdgcn_readfirstlane(tid >> 6), lane = tid & 63, wr = wid >> 2, wc = wid & 3, fr = lane & 15, fq = lane >> 4;
    const int K = g.K, nt = K / BK;
    unsigned voffA[2], voffB[2];
#pragma unroll
    for (int i = 0; i < 2; ++i) { int R, C; stage_rc(tid * 16 + i * 8192, R, C); const int Rb = Epi::PERM ? ((R & ~31) + perm32(R & 31)) : R;
        voffA[i] = (unsigned)(R * g.lda + C) * 2u; voffB[i] = (unsigned)(Rb * g.ldb + C) * 2u; }
    const size_t kstep = (size_t)(BK * 2);
    const size_t hstepA = (size_t)HALF * g.lda * 2, hstepB = (size_t)HALF * g.ldb * 2;
    const size_t tstepA = 2 * hstepA, tstepB = 2 * hstepB;
    const unsigned ldsw = (unsigned)wid * 1024u;
    const int aoff = lds_byte(wr * 64 + fr, fq * 8), boff = lds_byte(wc * 32 + fr, fq * 8);
#define PG8_SA(b, h) (((b) * 2 + (h)) * HTB)
#define PG8_SB(b, h) ((4 + (b) * 2 + (h)) * HTB)
#define PG8_STAGE(bufoff, gbase, voff) do { _Pragma("unroll") for (int _i = 0; _i < 2; ++_i) \
        __builtin_amdgcn_global_load_lds((const unsigned*)((const char*)(gbase) + (voff)[_i]), (PG8_LAS unsigned*)(lds + (bufoff) + ldsw + _i * 8192), 16, 0, 0); } while (0)
#define PG8_LDA(dst, b, h) do { _Pragma("unroll") for (int m = 0; m < 4; ++m) _Pragma("unroll") for (int k = 0; k < 2; ++k) dst[m][k] = *(const PG8_LAS bf16x8*)(lds + PG8_SA(b, h) + aoff + m * 2048 + k * 1024); } while (0)
#define PG8_LDB(dst, b, h) do { _Pragma("unroll") for (int n = 0; n < 2; ++n) _Pragma("unroll") for (int k = 0; k < 2; ++k) dst[n][k] = *(const PG8_LAS bf16x8*)(lds + PG8_SB(b, h) + boff + n * 2048 + k * 1024); } while (0)
#define PG8_MMA(ai, bj, At, Bt) do { __builtin_amdgcn_s_setprio(1); _Pragma("unroll") for (int m = 0; m < 4; ++m) _Pragma("unroll") for (int n = 0; n < 2; ++n) _Pragma("unroll") for (int k = 0; k < 2; ++k) \
        acc[ai][bj][m][n] = __builtin_amdgcn_mfma_f32_16x16x32_bf16(Bt[n][k], At[m][k], acc[ai][bj][m][n], 0, 0, 0); __builtin_amdgcn_s_setprio(0); } while (0)
#define PG8_WAIT_V(n) asm volatile("s_waitcnt vmcnt(" #n ")" ::: "memory")
#define PG8_WAIT_L(n) asm volatile("s_waitcnt lgkmcnt(" #n ")" ::: "memory")
#define PG8_BAR __builtin_amdgcn_s_barrier()
#define PG8_SCHED __builtin_amdgcn_sched_barrier(0)
    Unit cur, nxt; int ui = 0;
    if (!S.next(0, cur)) return;
    f32x4 acc[2][2][4][2];
#pragma unroll
    for (int a = 0; a < 2; ++a)
#pragma unroll
        for (int b = 0; b < 2; ++b)
#pragma unroll
            for (int m = 0; m < 4; ++m)
#pragma unroll
                for (int n = 0; n < 2; ++n) acc[a][b][m][n] = (f32x4){0.f, 0.f, 0.f, 0.f};
    bf16x8 At[4][2], B0[2][2], B1[2][2];
    const char* cA = (const char*)g.A + (size_t)cur.pm * tstepA; const char* cB = (const char*)g.Bt + (size_t)cur.pn * tstepB;
    if constexpr (SP2) {
        PG8_STAGE(PG8_SB(0, 0), cB, voffB); PG8_STAGE(PG8_SB(0, 1), cB + hstepB, voffB); PG8_STAGE(PG8_SA(0, 0), cA, voffA); PG8_STAGE(PG8_SA(0, 1), cA + hstepA, voffA);
        if (wr == 1) PG8_BAR;
        PG8_WAIT_V(2); PG8_BAR;
        PG8_STAGE(PG8_SB(1, 0), cB + kstep, voffB); PG8_STAGE(PG8_SA(1, 0), cA + kstep, voffA); PG8_STAGE(PG8_SB(1, 1), cB + hstepB + kstep, voffB);
        PG8_WAIT_V(6); PG8_BAR;
    } else {
        PG8_STAGE(PG8_SB(0, 0), cB, voffB); PG8_STAGE(PG8_SA(0, 0), cA, voffA); PG8_STAGE(PG8_SB(0, 1), cB + hstepB, voffB); PG8_STAGE(PG8_SA(0, 1), cA + hstepA, voffA);
        if (wr == 1) PG8_BAR;
        PG8_WAIT_V(4); PG8_BAR;
        PG8_STAGE(PG8_SB(1, 0), cB + kstep, voffB); PG8_STAGE(PG8_SA(1, 0), cA + kstep, voffA); PG8_STAGE(PG8_SB(1, 1), cB + hstepB + kstep, voffB);
        PG8_WAIT_V(6); PG8_BAR;
    }
    for (;;) {
        const bool has_next = S.next(ui + 1, nxt);
        const char* nA = has_next ? (const char*)g.A + (size_t)nxt.pm * tstepA : cA; const char* nB = has_next ? (const char*)g.Bt + (size_t)nxt.pn * tstepB : cB;
#pragma nounroll
        for (int t = 0; t < nt; t += 2) {
            const bool last = (t == nt - 2);
            const char* a1 = cA + (size_t)(t + 1) * kstep;
            const char* a2 = last ? nA : cA + (size_t)(t + 2) * kstep; const char* b2 = last ? nB : cB + (size_t)(t + 2) * kstep;
            const char* a3 = a2 + kstep; const char* b3 = b2 + kstep;
            if constexpr (SP2) {
            PG8_LDB(B0, 0, 0); PG8_LDB(B1, 0, 1); PG8_SCHED; PG8_LDA(At, 0, 0); PG8_STAGE(PG8_SA(1, 1), a1 + hstepA, voffA);
            PG8_WAIT_V(8); PG8_WAIT_L(0); PG8_BAR; PG8_MMA(0, 0, At, B0); PG8_MMA(0, 1, At, B1); PG8_BAR; PG8_SCHED;
            PG8_LDA(At, 0, 1); PG8_STAGE(PG8_SB(0, 0), b2, voffB); PG8_STAGE(PG8_SB(0, 1), b2 + hstepB, voffB); PG8_STAGE(PG8_SA(0, 0), a2, voffA);
            PG8_WAIT_V(8); PG8_WAIT_L(0); PG8_BAR; PG8_MMA(1, 0, At, B0); PG8_MMA(1, 1, At, B1); PG8_BAR; PG8_SCHED;
            PG8_LDB(B0, 1, 0); PG8_LDB(B1, 1, 1); PG8_SCHED; PG8_LDA(At, 1, 0); PG8_STAGE(PG8_SA(0, 1), a2 + hstepA, voffA);
            PG8_WAIT_V(8); PG8_WAIT_L(0); PG8_BAR; PG8_MMA(0, 0, At, B0); PG8_MMA(0, 1, At, B1); PG8_BAR; PG8_SCHED;
            PG8_LDA(At, 1, 1); PG8_STAGE(PG8_SB(1, 0), b3, voffB); PG8_STAGE(PG8_SB(1, 1), b3 + hstepB, voffB); PG8_STAGE(PG8_SA(1, 0), a3, voffA);
            PG8_WAIT_V(8); PG8_WAIT_L(0); PG8_BAR; PG8_MMA(1, 0, At, B0); PG8_MMA(1, 1, At, B1); PG8_BAR; PG8_SCHED;
            } else {
            PG8_LDB(B0, 0, 0); PG8_SCHED; PG8_LDA(At, 0, 0); PG8_STAGE(PG8_SA(1, 1), a1 + hstepA, voffA);
            PG8_WAIT_L(8); PG8_BAR; PG8_WAIT_L(0); PG8_MMA(0, 0, At, B0); PG8_BAR; PG8_SCHED;
            PG8_LDB(B1, 0, 1); PG8_STAGE(PG8_SB(0, 0), b2, voffB);
            PG8_BAR; PG8_WAIT_L(0); PG8_MMA(0, 1, At, B1); PG8_BAR;
            PG8_LDA(At, 0, 1); PG8_STAGE(PG8_SA(0, 0), a2, voffA);
            PG8_BAR; PG8_WAIT_L(0); PG8_MMA(1, 0, At, B0); PG8_BAR; PG8_SCHED;
            PG8_STAGE(PG8_SB(0, 1), b2 + hstepB, voffB);
            PG8_WAIT_V(6); PG8_BAR; PG8_MMA(1, 1, At, B1); PG8_BAR;
            PG8_LDB(B0, 1, 0); PG8_SCHED; PG8_LDA(At, 1, 0); PG8_STAGE(PG8_SA(0, 1), a2 + hstepA, voffA);
            PG8_WAIT_L(8); PG8_BAR; PG8_WAIT_L(0); PG8_MMA(0, 0, At, B0); PG8_BAR; PG8_SCHED;
            PG8_LDB(B1, 1, 1); PG8_STAGE(PG8_SB(1, 0), b3, voffB);
            PG8_BAR; PG8_WAIT_L(0); PG8_MMA(0, 1, At, B1); PG8_BAR;
            PG8_LDA(At, 1, 1); PG8_STAGE(PG8_SA(1, 0), a3, voffA);
            PG8_BAR; PG8_WAIT_L(0); PG8_MMA(1, 0, At, B0); PG8_BAR; PG8_SCHED;
            PG8_STAGE(PG8_SB(1, 1), b3 + hstepB, voffB);
            PG8_WAIT_V(6); PG8_BAR; PG8_MMA(1, 1, At, B1); PG8_BAR;
            }
        }
        if constexpr (ALIGN_EPI) { if (wr == 0) PG8_BAR; }
        { int fr_o = fr, fq_o = fq; asm volatile("" : "+v"(fr_o), "+v"(fq_o)); E(acc, cur, wr, wc, fr_o, fq_o); }
        if (!has_next) break;
#pragma unroll
        for (int a = 0; a < 2; ++a)
#pragma unroll
            for (int b = 0; b < 2; ++b)
#pragma unroll
                for (int m = 0; m < 4; ++m)
#pragma unroll
                    for (int n = 0; n < 2; ++n) acc[a][b][m][n] = (f32x4){0.f, 0.f, 0.f, 0.f};
        cur = nxt; cA = nA; cB = nB; ++ui;
        if constexpr (ALIGN_EPI) { if (wr == 1) PG8_BAR; }
    }
    PG8_WAIT_V(0);
    if constexpr (!ALIGN_EPI) { if (wr == 0) PG8_BAR; }
    PG8_BAR;
#undef PG8_SA
#undef PG8_SB
#undef PG8_STAGE
#undef PG8_LDA
#undef PG8_LDB
#undef PG8_MMA
#undef PG8_WAIT_V
#undef PG8_WAIT_L
#undef PG8_BAR
#undef PG8_SCHED
}
}

constexpr int D = 2048, SEQ = 8192, CTXL = 256, R = SEQ + CTXL, DEPTH = 4, NPAN = R / 256;
constexpr int S5W = 512, S5G = 32, S5CH = 16, S5P = 64, CONVW = 512, CONVK = 31, MLW = 1024, MLH = 4, DH = 256, DFF = 5632;
constexpr int INW = 5648, NIN = 5888;
constexpr int OFF_CONV = 512, OFF_Q = 1536, OFF_K = 2560, OFF_V = 3584, OFF_O = 4608, OFF_G = 5632;
constexpr float EPS = 1e-6f, LN_EPS = 1e-5f;
constexpr int UROWS = 768, UPITCH = 512;

constexpr size_t MiB = 1u << 20;
constexpr size_t WS_CTL = 0, CTL_ZERO_BYTES = 1 * MiB;
constexpr size_t WS_MOD = 1 * MiB;
constexpr size_t WS_XR = 2 * MiB;
constexpr size_t WS_HN = 68 * MiB;
constexpr size_t WS_U = 101 * MiB;
constexpr size_t WS_CG = 125 * MiB;
constexpr size_t WS_Q = 134 * MiB, WS_K = 151 * MiB, WS_V = 168 * MiB;
constexpr size_t WS_O = 185 * MiB;
constexpr size_t WS_GATES = 202 * MiB;
constexpr size_t WS_MIX = 203 * MiB;
constexpr size_t WS_HFF = 236 * MiB;
constexpr size_t WS_YS = 327 * MiB;
constexpr size_t WS_S5G = 360 * MiB;
constexpr size_t WS_HML = 369 * MiB;
constexpr size_t WS_W = 436 * MiB;
constexpr size_t WL_IN = 0, WL_OUT = 23 * MiB, WL_FI = 31 * MiB, WL_FO = 75 * MiB, WL_GLU = 97 * MiB, WL_STRIDE = 98 * MiB;
constexpr size_t WS_SQ = 828 * MiB;
constexpr size_t WS_VC = 894 * MiB;
constexpr size_t WS_KT = 960 * MiB;
constexpr size_t WS_KTW = 977 * MiB;
constexpr size_t WS_DC = 1010 * MiB;
constexpr size_t WS_BC = 1076 * MiB;
constexpr size_t WS_CS = WS_BC + 512 * 1024;
constexpr size_t WS_DN = WS_CS + 512 * 1024;
constexpr size_t WS_NIN = WS_DN + 512 * 1024;
constexpr size_t WS_AT = 1078 * MiB + 1536 * 1024;
constexpr size_t WS_RSP = 1078 * MiB;
constexpr size_t WS_FC = 1080 * MiB;
constexpr size_t WS_WC = 1096 * MiB;
constexpr size_t WS_LAMP = 1128 * MiB;
constexpr size_t WS_EB = 1129 * MiB;
constexpr size_t WS_ESC = 1153 * MiB;
constexpr size_t WS_END = 1155 * MiB;
constexpr int NCK = R / 16, CTXCK = CTXL / 16, NSC = NCK / 16;
constexpr int NCH = 33;
constexpr int CW_BAR = 4096;

constexpr int RING_BYTES = 131072, LDSCTL_OFF = RING_BYTES, MISC_OFF = LDSCTL_OFF + 320, LDS_BYTES = 147456;
constexpr int NWAVES = 8, NTHR = 512;

#define GAS __attribute__((address_space(1)))
#define LAS __attribute__((address_space(3)))
typedef unsigned short bf16;
typedef unsigned v4u __attribute__((ext_vector_type(4)));
typedef unsigned v2u __attribute__((ext_vector_type(2)));
typedef float f32x4 __attribute__((ext_vector_type(4)));
typedef GAS unsigned gu32;
#define RLX_AGENT __ATOMIC_RELAXED, __HIP_MEMORY_SCOPE_AGENT
#define LDS_WAIT() asm volatile("s_waitcnt lgkmcnt(0)" ::: "memory")
__device__ __forceinline__ unsigned f2bf(float f) { unsigned u = __builtin_bit_cast(unsigned, f); return (u + 0x7fffu + ((u >> 16) & 1u)) >> 16; }
__device__ __forceinline__ unsigned pk2(float lo, float hi) { return f2bf(lo) | (f2bf(hi) << 16); }
__device__ __forceinline__ float bf2f(unsigned short b) { return __builtin_bit_cast(float, ((unsigned)b) << 16); }
__device__ __forceinline__ float bflo(unsigned w) { return __builtin_bit_cast(float, w << 16); }
__device__ __forceinline__ float bfhi(unsigned w) { return __builtin_bit_cast(float, w & 0xffff0000u); }
__device__ __forceinline__ float sigmoidf_(float x) { return 1.f / (1.f + __expf(-x)); }
__device__ __forceinline__ float siluf_(float x) { return x / (1.f + __expf(-x)); }
__device__ __forceinline__ float gelu_tanh_(float x) { const float u = 0.7978845608028654f * (x + 0.044715f * x * x * x); return x * (1.f / (1.f + __expf(-2.f * u))); }
__device__ __forceinline__ float wave_sum(float v) {
#pragma unroll
    for (int o = 1; o < 64; o <<= 1) v += __shfl_xor(v, o);
    return v;
}
__device__ __forceinline__ int tau_row(int d, int tau) { return d == 0 ? tau : (tau < CTXL ? CTXL - 1 - tau : (R - 1 + CTXL) - tau); }

#define XB_TMO      128
#define XB_XCNT(j)  (256  + 64 * (j))
#define XB_XSUB(j)  (1280 + 64 * (j))
#define XB_XGEN(j)  (2304 + 64 * (j))
#define XB_TOP      3328
#define XB_TOPGEN   3392
#define XCD_BAR_WORDS 3456
#define XB_SPIN_CAP (1u << 22)
__device__ __forceinline__ unsigned xb_ld(unsigned* p)              { return __hip_atomic_load(p, __ATOMIC_RELAXED, __HIP_MEMORY_SCOPE_AGENT); }
__device__ __forceinline__ unsigned xb_add(unsigned* p, unsigned v) { return __hip_atomic_fetch_add(p, v, __ATOMIC_RELAXED, __HIP_MEMORY_SCOPE_AGENT); }
__device__ __forceinline__ unsigned xb_xcc_id() { return (unsigned)__builtin_amdgcn_s_getreg((3 << 11) | 20) & 0xFu; }
#define XB_SPIN(cond, bar) do { unsigned _sp = 0; while (cond) { __builtin_amdgcn_s_sleep(1); \
    if ((++_sp & 255u) == 0u) { if (xb_ld(&(bar)[XB_TMO])) break; if (_sp > XB_SPIN_CAP) { atomicAdd(&(bar)[XB_TMO], 1u); break; } } } } while (0)
struct XcdBarrier { unsigned* bar; unsigned x; volatile LAS unsigned* st; };
__device__ __forceinline__ XcdBarrier xcd_barrier_post(unsigned* bar, volatile LAS unsigned* st) {
    XcdBarrier b; b.bar = bar; b.x = xb_xcc_id(); b.st = st;
    if (threadIdx.x == 0) (void)xb_add(&bar[XB_XCNT(b.x)], 1u);
    return b;
}
__device__ __forceinline__ void xcd_barrier_complete(unsigned* bar, unsigned x, unsigned& nloc, unsigned& nx) {
    const unsigned G = gridDim.x * gridDim.y * gridDim.z;
    unsigned sum, cnt, mine, sp = 0u;
    for (;;) {
        sum = 0u; cnt = 0u; mine = 0u;
#pragma unroll
        for (unsigned j = 0; j < 16; ++j) { const unsigned c = xb_ld(&bar[XB_XCNT(j)]); sum += c; cnt += (c > 0u) ? 1u : 0u; mine = (j == x) ? c : mine; }
        if (sum == G) break;
        __builtin_amdgcn_s_sleep(1);
        if ((++sp & 255u) == 0u) { if (xb_ld(&bar[XB_TMO])) break; if (sp > XB_SPIN_CAP) { atomicAdd(&bar[XB_TMO], 1u); break; } }
    }
    nloc = mine > 0u ? mine : 1u; nx = cnt > 0u ? cnt : 1u;
}
__device__ __forceinline__ void xcd_barrier(const XcdBarrier& b) {
    asm volatile("s_waitcnt vmcnt(0)" ::: "memory");
    __syncthreads();
    if (threadIdx.x == 0) {
        unsigned* bar = b.bar;
        __builtin_amdgcn_s_waitcnt(0);
        unsigned nloc = b.st[0], nx = b.st[1];
        if (nloc == 0u) { xcd_barrier_complete(bar, b.x, nloc, nx); b.st[0] = nloc; b.st[1] = nx; }
        const unsigned old = xb_add(&bar[XB_XSUB(b.x)], 1u);
        const unsigned gen = old / nloc;
        if (old + 1u == (gen + 1u) * nloc) {
            __builtin_amdgcn_fence(__ATOMIC_RELEASE, "agent");
            asm volatile("s_waitcnt vmcnt(0)" ::: "memory");
            const unsigned og = xb_add(&bar[XB_TOP], 1u);
            const unsigned tg = og / nx;
            if (og + 1u == (tg + 1u) * nx) xb_add(&bar[XB_TOPGEN], 1u);
            else XB_SPIN(xb_ld(&bar[XB_TOPGEN]) == tg, bar);
            __builtin_amdgcn_fence(__ATOMIC_ACQUIRE, "agent");
            xb_add(&bar[XB_XGEN(b.x)], 1u);
            asm volatile("s_waitcnt vmcnt(0)" ::: "memory");
        } else {
            XB_SPIN(xb_ld(&bar[XB_XGEN(b.x)]) == gen, bar);
            __builtin_amdgcn_fence(__ATOMIC_ACQUIRE, "agent");
            asm volatile("s_waitcnt vmcnt(0)" ::: "memory");
        }
    }
    __syncthreads();
}

struct Args {
    const float *x, *c, *ctx, *c_ctx, *w_mod, *b_mod, *norm1_g, *w_in, *b_in, *s5_lam_re, *s5_lam_im, *s5_log_step, *s5_b_re, *s5_b_im, *s5_c_re, *s5_c_im,
                *s5_d, *s5_w_glu, *s5_b_glu, *conv_dw_w, *conv_dw_b, *conv_ln_g, *conv_ln_b, *ml_norm_g, *w_out, *norm2_g, *w_ffn_in, *w_ffn_out, *norm_f_g;
    float* out; unsigned char* ws;
    int l_lo, l_hi, ph_lo, ph_hi, do_pro, do_fin, use_bar, pad;
};

typedef const Args __attribute__((address_space(4))) CArgs;

__device__ __forceinline__ void transpose_item(const float* W, int Nsrc, bf16* WT, int ldt, int k0, int n0d, int n0s, int nvalid, LAS float* scr, int lane) {
#pragma unroll 8
    for (int i = 0; i < 32; ++i) { const int kk = 2 * i + (lane >> 5), nn = lane & 31; scr[kk * 33 + nn] = nn < nvalid ? W[(size_t)(k0 + kk) * Nsrc + n0s + nn] : 0.f; }
    LDS_WAIT(); asm volatile("" ::: "memory");
    const int c = lane & 7;
#pragma unroll
    for (int j = 0; j < 4; ++j) { const int n = (lane >> 3) + 8 * j; const LAS float* s = scr + (8 * c) * 33 + n;
        v4u o; o.x = pk2(s[0 * 33], s[1 * 33]); o.y = pk2(s[2 * 33], s[3 * 33]); o.z = pk2(s[4 * 33], s[5 * 33]); o.w = pk2(s[6 * 33], s[7 * 33]);
        *(GAS v4u*)(WT + (size_t)(n0d + n) * ldt + k0 + 8 * c) = o; }
    LDS_WAIT(); asm volatile("" ::: "memory");
}
__device__ __forceinline__ int win_src(int nd) {
    if (nd >= OFF_CONV && nd < OFF_Q) { const int t = (nd - OFF_CONV) >> 8, w = (nd - OFF_CONV) & 255; return w < 128 ? OFF_CONV + t * 128 + w : OFF_CONV + CONVW + t * 128 + (w - 128); }
    return nd;
}
__device__ __forceinline__ int wfi_src(int nd) { const int t = nd >> 8, w = nd & 255; return w < 128 ? t * 128 + w : DFF + t * 128 + (w - 128); }

using pg8::f32x2;
struct EpiWin {
    static constexpr bool PERM = true;
    const float* bias; bf16 *U, *CG, *SQ, *Kb, *KT, *VC, *O; float* GATES;
    __device__ __forceinline__ void operator()(const f32x4 (&acc)[2][2][4][2], const pg8::Unit& u, int wr, int wc, int fr, int fq) const {
        const int row0 = u.pm * 256 + wr * 64 + fr, pn = u.pn, cw0 = wc * 32 + 8 * fq;
        if (pn < 2) {
#pragma unroll
            for (int bj = 0; bj < 2; ++bj) { const int col = pn * 256 + bj * 128 + cw0, g = col >> 4, ch0 = col & 15;
                const f32x4 b0 = *(const f32x4*)(bias + col), b1 = *(const f32x4*)(bias + col + 4);
#pragma unroll
                for (int ai = 0; ai < 2; ++ai)
#pragma unroll
                    for (int m = 0; m < 4; ++m) { const int r = row0 + ai * 128 + m * 16; const f32x4 v0 = acc[ai][bj][m][0] + b0, v1 = acc[ai][bj][m][1] + b1;
                        v4u w; w.x = pk2(v0[0], v0[1]); w.y = pk2(v0[2], v0[3]); w.z = pk2(v1[0], v1[1]); w.w = pk2(v1[2], v1[3]);
                        *(v4u*)(U + ((size_t)g * UROWS + (r >> 4)) * UPITCH + (r & 15) * 16 + ch0) = w; } }
        } else if (pn < 6) {
            const int ch = (pn - 2) * 128 + cw0;
            const f32x4 a0 = *(const f32x4*)(bias + OFF_CONV + ch), a1 = *(const f32x4*)(bias + OFF_CONV + ch + 4), b0 = *(const f32x4*)(bias + OFF_CONV + CONVW + ch), b1 = *(const f32x4*)(bias + OFF_CONV + CONVW + ch + 4);
#pragma unroll
            for (int ai = 0; ai < 2; ++ai)
#pragma unroll
                for (int m = 0; m < 4; ++m) { const int r = row0 + ai * 128 + m * 16;
                    const f32x4 x0 = acc[ai][0][m][0] + a0, x1 = acc[ai][0][m][1] + a1, y0 = acc[ai][1][m][0] + b0, y1 = acc[ai][1][m][1] + b1; float o[8];
#pragma unroll
                    for (int j = 0; j < 4; ++j) { o[j] = x0[j] * sigmoidf_(y0[j]); o[4 + j] = x1[j] * sigmoidf_(y1[j]); }
                    v4u w; w.x = pk2(o[0], o[1]); w.y = pk2(o[2], o[3]); w.z = pk2(o[4], o[5]); w.w = pk2(o[6], o[7]);
                    *(v4u*)(CG + (size_t)r * CONVW + ch) = w; }
        } else if (pn < 22) {
            const int which = (pn - 6) >> 2, h = (pn - 6) & 3, c = u.pm; const float sc = which == 1 ? 0.0625f : 1.f;
#pragma unroll
            for (int bj = 0; bj < 2; ++bj) { const int cw = bj * 128 + cw0; const f32x4 b0 = *(const f32x4*)(bias + pn * 256 + cw), b1 = *(const f32x4*)(bias + pn * 256 + cw + 4);
#pragma unroll
                for (int ai = 0; ai < 2; ++ai)
#pragma unroll
                    for (int m = 0; m < 4; ++m) { int t = wr * 64 + fr + ai * 128 + m * 16; asm volatile("" : "+v"(t) :: "memory"); const int r = c * 256 + t; const f32x4 v0 = (acc[ai][bj][m][0] + b0) * sc, v1 = (acc[ai][bj][m][1] + b1) * sc;
                        v4u w; w.x = pk2(v0[0], v0[1]); w.y = pk2(v0[2], v0[3]); w.z = pk2(v1[0], v1[1]); w.w = pk2(v1[2], v1[3]);
                        if (which == 0) { *(v4u*)(SQ + ((size_t)(h * NCH + c) * 256 + t) * 512 + 256 + cw) = w; *(v4u*)(SQ + ((size_t)((4 + h) * NCH + c) * 256 + t) * 512 + 256 + cw) = w; }
                        else if (which == 1) { *(v4u*)(Kb + ((size_t)h * R + r) * 256 + cw) = w; unsigned short* kt = (unsigned short*)KT + ((size_t)(h * NCH + c) * 256 + cw) * 256 + t;
                            kt[0] = (unsigned short)w.x; kt[256] = (unsigned short)(w.x >> 16); kt[512] = (unsigned short)w.y; kt[768] = (unsigned short)(w.y >> 16);
                            kt[1024] = (unsigned short)w.z; kt[1280] = (unsigned short)(w.z >> 16); kt[1536] = (unsigned short)w.w; kt[1792] = (unsigned short)(w.w >> 16); }
                        else if (which == 2) {
#pragma unroll
                            for (int d = 0; d < 2; ++d) { unsigned short* vt = (unsigned short*)VC + ((size_t)((d * 4 + h) * NCH + c) * 256 + cw) * 512 + t;
                                vt[0] = (unsigned short)w.x; vt[512] = (unsigned short)(w.x >> 16); vt[1024] = (unsigned short)w.y; vt[1536] = (unsigned short)(w.y >> 16);
                                vt[2048] = (unsigned short)w.z; vt[2560] = (unsigned short)(w.z >> 16); vt[3072] = (unsigned short)w.w; vt[3584] = (unsigned short)(w.w >> 16); } }
                        else *(v4u*)(O + (size_t)r * 1024 + h * 256 + cw) = w; } }
        } else {
            if (wc == 0 && fq < 2) { const f32x4 b0 = *(const f32x4*)(bias + OFF_G + 8 * fq), b1 = *(const f32x4*)(bias + OFF_G + 8 * fq + 4);
#pragma unroll
                for (int ai = 0; ai < 2; ++ai)
#pragma unroll
                    for (int m = 0; m < 4; ++m) { const int r = row0 + ai * 128 + m * 16;
                        *(f32x4*)(GATES + (size_t)r * 16 + 8 * fq) = acc[ai][0][m][0] + b0; *(f32x4*)(GATES + (size_t)r * 16 + 8 * fq + 4) = acc[ai][0][m][1] + b1; } }
        }
    }
};
struct EpiRes {
    static constexpr bool PERM = false;
    float* XR; const float* gate_c; const float* gate_x;
    __device__ __forceinline__ void operator()(const f32x4 (&acc)[2][2][4][2], const pg8::Unit& u, int wr, int wc, int fr, int fq) const {
        const int row0 = u.pm * 256 + wr * 64 + fr, col0 = u.pn * 256 + wc * 32 + 4 * fq; const float* gate = u.pm == 0 ? gate_c : gate_x;
        f32x4 gv[2][2];
#pragma unroll
        for (int bj = 0; bj < 2; ++bj)
#pragma unroll
            for (int n = 0; n < 2; ++n) gv[bj][n] = *(const f32x4*)(gate + col0 + bj * 128 + n * 16);
#pragma unroll
        for (int ai = 0; ai < 2; ++ai)
#pragma unroll
            for (int m = 0; m < 4; ++m) { float* rowp = XR + (size_t)(row0 + ai * 128 + m * 16) * D + col0;
#pragma unroll
                for (int bj = 0; bj < 2; ++bj)
#pragma unroll
                    for (int n = 0; n < 2; ++n) { f32x4* p = (f32x4*)(rowp + bj * 128 + n * 16); *p = *p + gv[bj][n] * acc[ai][bj][m][n]; } }
    }
};
struct EpiSwiglu {
    static constexpr bool PERM = true;
    bf16* HFF;
    __device__ __forceinline__ void operator()(const f32x4 (&acc)[2][2][4][2], const pg8::Unit& u, int wr, int wc, int fr, int fq) const {
        const int row0 = u.pm * 256 + wr * 64 + fr, hc = u.pn * 128 + wc * 32 + 8 * fq;
#pragma unroll
        for (int ai = 0; ai < 2; ++ai)
#pragma unroll
            for (int m = 0; m < 4; ++m) { const int r = row0 + ai * 128 + m * 16; float o[8];
#pragma unroll
                for (int j = 0; j < 4; ++j) { o[j] = siluf_(acc[ai][0][m][0][j]) * acc[ai][1][m][0][j]; o[4 + j] = siluf_(acc[ai][0][m][1][j]) * acc[ai][1][m][1][j]; }
                v4u w; w.x = pk2(o[0], o[1]); w.y = pk2(o[2], o[3]); w.z = pk2(o[4], o[5]); w.w = pk2(o[6], o[7]);
                *(v4u*)(HFF + (size_t)r * DFF + hc) = w; }
    }
};
struct EpiGlu {
    static constexpr bool PERM = true;
    const bf16* S5Gb; const float* bias; bf16* MIX;
    __device__ __forceinline__ void operator()(const f32x4 (&acc)[2][2][4][2], const pg8::Unit& u, int wr, int wc, int fr, int fq) const {
        const int row0 = u.pm * 256 + wr * 64 + fr;
#pragma unroll
        for (int bj = 0; bj < 2; ++bj) { const int col = u.pn * 256 + bj * 128 + wc * 32 + 8 * fq; const f32x4 b0 = *(const f32x4*)(bias + col), b1 = *(const f32x4*)(bias + col + 4);
#pragma unroll
            for (int ai = 0; ai < 2; ++ai)
#pragma unroll
                for (int m = 0; m < 4; ++m) { const int r = row0 + ai * 128 + m * 16; const v4u gw = *(const v4u*)(S5Gb + (size_t)r * S5W + col);
                    const f32x4 v0 = acc[ai][bj][m][0] + b0, v1 = acc[ai][bj][m][1] + b1; float o[8];
                    o[0] = bflo(gw.x) * sigmoidf_(v0[0]); o[1] = bfhi(gw.x) * sigmoidf_(v0[1]); o[2] = bflo(gw.y) * sigmoidf_(v0[2]); o[3] = bfhi(gw.y) * sigmoidf_(v0[3]);
                    o[4] = bflo(gw.z) * sigmoidf_(v1[0]); o[5] = bfhi(gw.z) * sigmoidf_(v1[1]); o[6] = bflo(gw.w) * sigmoidf_(v1[2]); o[7] = bfhi(gw.w) * sigmoidf_(v1[3]);
                    v4u w; w.x = pk2(o[0], o[1]); w.y = pk2(o[2], o[3]); w.z = pk2(o[4], o[5]); w.w = pk2(o[6], o[7]);
                    *(v4u*)(MIX + (size_t)r * D + col) = w; } }
    }
};

struct BatchOrder {
    int n, G, c, mode;
    __device__ __forceinline__ bool next(int i, pg8::Unit& u) const {
        const long L = (long)i * G + c; if (L >= n) return false; const int idx = (int)L;
        if (mode == 1) { const int d = idx >> 7, h = (idx >> 5) & 3, cc = idx & 31, ch = d == 0 ? cc : (cc == 0 ? 0 : cc + 1); u.pm = u.pn = (d * 4 + h) * NCH + ch; }
        else if (mode == 3) { u.pm = idx; u.pn = idx / 3; }
        else { u.pm = u.pn = idx; }
        return true;
    }
};
struct EpiG1 {
    static constexpr bool PERM = true;
    bf16* SQ; const float* CS; float* RSP;
    __device__ __forceinline__ void operator()(const f32x4 (&acc)[2][2][4][2], const pg8::Unit& u, int wr, int wc, int fr, int fq) const {
        const int h = u.pm / NCH, c = u.pm % NCH;
#pragma unroll
        for (int d = 0; d < 2; ++d) {
            const float* cs = CS + (size_t)(d * 4 + h) * R + c * 256 + wc * 32 + 8 * fq; f32x4 csv[2][2];
#pragma unroll
            for (int bj = 0; bj < 2; ++bj)
#pragma unroll
                for (int n = 0; n < 2; ++n) csv[bj][n] = *(const f32x4*)(cs + bj * 128 + 4 * n);
            bf16* dst = SQ + (size_t)((d * 4 + h) * NCH + c) * 256 * 512; float* rsp = RSP + ((size_t)(d * 4 + h) * R + c * 256) * 4 + wc;
#pragma unroll
            for (int ai = 0; ai < 2; ++ai)
#pragma unroll
                for (int m = 0; m < 4; ++m) { int t = ai * 128 + wr * 64 + m * 16 + fr; asm volatile("" : "+v"(t) :: "memory"); float rs = 0.f;
#pragma unroll
                    for (int bj = 0; bj < 2; ++bj) { const int s0 = bj * 128 + wc * 32 + 8 * fq; float o[8];
#pragma unroll
                        for (int n = 0; n < 2; ++n)
#pragma unroll
                            for (int j = 0; j < 4; ++j) { const int si = s0 + 4 * n + j; const bool ok = d == 0 ? si <= t : si >= t; const float v = acc[ai][bj][m][n][j] * csv[bj][n][j]; o[4 * n + j] = ok ? v : 0.f; rs += o[4 * n + j]; }
                        v4u w; w.x = pk2(o[0], o[1]); w.y = pk2(o[2], o[3]); w.z = pk2(o[4], o[5]); w.w = pk2(o[6], o[7]);
                        *(v4u*)(dst + (size_t)t * 512 + s0) = w; }
                    rs += __shfl_xor(rs, 16); rs += __shfl_xor(rs, 32); if (fq == 0) rsp[(size_t)t * 4] = rs; }
        }
    }
};
struct EpiS5Y {
    static constexpr bool PERM = true;
    bf16* S5Gb;
    __device__ __forceinline__ void operator()(const f32x4 (&acc)[2][2][4][2], const pg8::Unit& u, int wr, int wc, int fr, int fq) const {
        const int g = u.pn, mt = u.pm - 3 * u.pn;
#pragma unroll
        for (int ai = 0; ai < 2; ++ai)
#pragma unroll
            for (int m = 0; m < 4; ++m) { int ck = mt * 256 + ai * 128 + wr * 64 + m * 16 + fr; asm volatile("" : "+v"(ck) :: "memory");
                if (ck < NCK) {
#pragma unroll
                    for (int bj = 0; bj < 2; ++bj) { const int nc = bj * 128 + wc * 32 + 8 * fq, t = nc >> 4, c0 = nc & 15; float o[8];
#pragma unroll
                        for (int j = 0; j < 4; ++j) { o[j] = gelu_tanh_(acc[ai][bj][m][0][j]); o[4 + j] = gelu_tanh_(acc[ai][bj][m][1][j]); }
                        v4u w; w.x = pk2(o[0], o[1]); w.y = pk2(o[2], o[3]); w.z = pk2(o[4], o[5]); w.w = pk2(o[6], o[7]);
                        *(v4u*)(S5Gb + (size_t)(ck * 16 + t) * S5W + g * 16 + c0) = w; } } }
    }
};
struct EpiF32T {
    static constexpr bool PERM = false;
    float* base; size_t tile_stride; int ldc;
    __device__ __forceinline__ void operator()(const f32x4 (&acc)[2][2][4][2], const pg8::Unit& u, int wr, int wc, int fr, int fq) const {
        float* o = base + (size_t)u.pm * tile_stride + (size_t)(wr * 64 + fr) * ldc + wc * 32 + 4 * fq;
#pragma unroll
        for (int ai = 0; ai < 2; ++ai)
#pragma unroll
            for (int m = 0; m < 4; ++m) { float* rowp = o + (size_t)(ai * 128 + m * 16) * ldc;
#pragma unroll
                for (int bj = 0; bj < 2; ++bj)
#pragma unroll
                    for (int n = 0; n < 2; ++n) *(f32x4*)(rowp + bj * 128 + n * 16) = acc[ai][bj][m][n]; }
    }
};
struct EpiG3 {
    static constexpr bool PERM = false;
    float* HML;
    __device__ __forceinline__ void operator()(const f32x4 (&acc)[2][2][4][2], const pg8::Unit& u, int wr, int wc, int fr, int fq) const {
        const int dh = u.pm / NCH, c = u.pm % NCH, d = dh >> 2, h = dh & 3;
        float* o = HML + ((size_t)d * R + c * 256 + wr * 64 + fr) * MLW + h * 256 + wc * 32 + 4 * fq;
#pragma unroll
        for (int ai = 0; ai < 2; ++ai)
#pragma unroll
            for (int m = 0; m < 4; ++m) { float* rowp = o + (size_t)(ai * 128 + m * 16) * MLW;
#pragma unroll
                for (int bj = 0; bj < 2; ++bj)
#pragma unroll
                    for (int n = 0; n < 2; ++n) *(f32x4*)(rowp + bj * 128 + n * 16) = acc[ai][bj][m][n]; }
    }
};

constexpr int NPH = 12;
__global__ void __launch_bounds__(NTHR, 2) fwd(Args a) {
    extern __shared__ __attribute__((aligned(16))) unsigned char lds_raw[];
    LAS unsigned char* lds = (LAS unsigned char*)lds_raw;
    volatile LAS unsigned* MISC = (volatile LAS unsigned*)(lds + MISC_OFF);
    const int G = gridDim.x, bid = blockIdx.x, NGW = G * NWAVES;
    for (int u = threadIdx.x; u < (LDS_BYTES - LDSCTL_OFF) / 4; u += NTHR) ((LAS unsigned*)(lds + LDSCTL_OFF))[u] = 0u;
    __syncthreads();
    gu32* ctl = (gu32*)(a.ws + WS_CTL);
#define PH_WS CArgs* ap = (CArgs*)__builtin_amdgcn_kernarg_segment_ptr(); asm volatile("" : "+s"(ap)); unsigned char* ws = ap->ws;
#define MOD ((float*)(ws + WS_MOD))
#define XR ((float*)(ws + WS_XR))
#define HN ((bf16*)(ws + WS_HN))
#define U ((bf16*)(ws + WS_U))
#define CG ((bf16*)(ws + WS_CG))
#define Kb ((bf16*)(ws + WS_K))
#define Ob ((bf16*)(ws + WS_O))
#define GATES ((float*)(ws + WS_GATES))
#define MIX ((bf16*)(ws + WS_MIX))
#define HFF ((bf16*)(ws + WS_HFF))
#define YS ((float*)(ws + WS_YS))
#define S5Gb ((bf16*)(ws + WS_S5G))
#define HML ((float*)(ws + WS_HML))
    XcdBarrier bar; bar.bar = (unsigned*)(ctl + CW_BAR); bar.x = 0; bar.st = nullptr;
    if (a.use_bar) bar = xcd_barrier_post((unsigned*)(ctl + CW_BAR), MISC + 8);
#define GRID_BAR() do { if (a.use_bar) xcd_barrier(bar); } while (0)
#define PH_IDS PH_WS int tid = threadIdx.x; asm volatile("" : "+v"(tid)); const int lane = tid & 63, wave = __builtin_amdgcn_readfirstlane(tid >> 6), gw = bid * NWAVES + wave; (void)lane; (void)gw;

    if (PROMASK && a.do_pro) { PH_IDS
        {
            const size_t n4 = (size_t)R * D / 4, nc4 = (size_t)CTXL * D / 4;
            for (size_t i = (size_t)bid * NTHR + tid; i < n4; i += (size_t)G * NTHR) ((f32x4*)XR)[i] = i < nc4 ? ((const f32x4*)ap->ctx)[i] : ((const f32x4*)ap->x)[i - nc4];
        }
        {
            LAS float* scr = (LAS float*)(lds + wave * 16384);
            constexpr int I_IN = (D / 64) * (NIN / 32), I_OUT = (D / 64) * (D / 32), I_FI = (D / 64) * (2 * DFF / 32), I_FO = (DFF / 64) * (D / 32), I_GLU = (S5W / 64) * (S5W / 32);
            constexpr int I_L = I_IN + I_OUT + I_FI + I_FO + I_GLU;
            for (int it = gw; it < DEPTH * I_L; it += NGW) {
                const int l = it / I_L; int r = it % I_L; unsigned char* wl = ws + WS_W + (size_t)l * WL_STRIDE;
                if (r < I_IN) { const int nb = r % (NIN / 32), kb = r / (NIN / 32), nd = nb * 32, nsrc = win_src(nd); const int nv = nd + 32 <= INW ? 32 : (nd < INW ? INW - nd : 0);
                    transpose_item(ap->w_in + (size_t)l * D * INW, INW, (bf16*)(wl + WL_IN), D, kb * 64, nd, nv ? nsrc : 0, nv, scr, lane); continue; } r -= I_IN;
                if (r < I_OUT) { const int nb = r % (D / 32), kb = r / (D / 32); transpose_item(ap->w_out + (size_t)l * D * D, D, (bf16*)(wl + WL_OUT), D, kb * 64, nb * 32, nb * 32, 32, scr, lane); continue; } r -= I_OUT;
                if (r < I_FI) { const int nb = r % (2 * DFF / 32), kb = r / (2 * DFF / 32); transpose_item(ap->w_ffn_in + (size_t)l * D * 2 * DFF, 2 * DFF, (bf16*)(wl + WL_FI), D, kb * 64, nb * 32, wfi_src(nb * 32), 32, scr, lane); continue; } r -= I_FI;
                if (r < I_FO) { const int nb = r % (D / 32), kb = r / (D / 32); transpose_item(ap->w_ffn_out + (size_t)l * DFF * D, D, (bf16*)(wl + WL_FO), DFF, kb * 64, nb * 32, nb * 32, 32, scr, lane); continue; } r -= I_FO;
                { const int nb = r % (S5W / 32), kb = r / (S5W / 32); transpose_item(ap->s5_w_glu + (size_t)l * S5W * S5W, S5W, (bf16*)(wl + WL_GLU), S5W, kb * 64, nb * 32, nb * 32, 32, scr, lane); }
            }
        }
        __syncthreads();
        {
            LAS float* red = (LAS float*)lds;
            for (int it = bid; it < DEPTH * 48; it += G) {
                const int l = it / 48, cg = it % 48, col = cg * 256 + lane * 4;
                const float* W = ap->w_mod + (size_t)l * D * 6 * D + col; f32x4 s0 = {0.f, 0.f, 0.f, 0.f}, s1 = {0.f, 0.f, 0.f, 0.f};
#pragma unroll 8
                for (int k = wave * 256; k < wave * 256 + 256; ++k) { const f32x4 w = *(const f32x4*)(W + (size_t)k * 6 * D); const float cc = ap->c_ctx[k], cx = ap->c[k]; s0 += w * siluf_(cc); s1 += w * siluf_(cx); }
                *(LAS f32x4*)(red + (wave * 2 + 0) * 256 + lane * 4) = s0; *(LAS f32x4*)(red + (wave * 2 + 1) * 256 + lane * 4) = s1;
                __syncthreads();
                { const int ty = tid >> 8, cc = tid & 255; float s = ap->b_mod[(size_t)l * 6 * D + cg * 256 + cc];
#pragma unroll
                  for (int w = 0; w < 8; ++w) s += red[(w * 2 + ty) * 256 + cc];
                  MOD[((size_t)l * 2 + ty) * 6 * D + cg * 256 + cc] = s; }
                __syncthreads();
            }
        }
        __syncthreads();
        {
            LAS float* L = (LAS float*)lds; LAS float* pwr = L; LAS float* pwi = L + 2176; LAS float* bbr = L + 4352; LAS float* bbi = L + 6400; LAS float* ccr = L + 8448; LAS float* cci = L + 10496; LAS float* ktab = L + 12544;
            for (int task = bid; task < DEPTH * S5G; task += G) {
                const int l = task / S5G, g = task % S5G;
                if (tid < 128) { const int d = tid >> 6, p = tid & 63; const size_t pb = (((size_t)l * 2 + d) * S5G + g) * S5P + p;
                    const float lre = ap->s5_lam_re[pb], lim = ap->s5_lam_im[pb], st = __expf(ap->s5_log_step[pb]);
                    const float ea = __expf(lre * st), th = lim * st, cs = cosf(th), sn = sinf(th), lr = ea * cs, li = ea * sn;
                    const float sh = sinf(0.5f * th), m1r = expm1f(lre * st) * cs - 2.f * sh * sh, m1i = li;
                    const float dn = 1.f / (lre * lre + lim * lim), cr = (m1r * lre + m1i * lim) * dn, ci = (m1i * lre - m1r * lim) * dn;
                    float pr = 1.f, pi = 0.f;
                    for (int j = 0; j <= 16; ++j) { pwr[(d * 17 + j) * 64 + p] = pr; pwi[(d * 17 + j) * 64 + p] = pi; const float nr = pr * lr - pi * li, ni = pr * li + pi * lr; if (j < 16) { pr = nr; pi = ni; } }
                    float ar = pr, ai = pi;
                    for (int q = 0; q < 4; ++q) { const float nr = ar * ar - ai * ai, ni = 2.f * ar * ai; ar = nr; ai = ni; }
                    ((f32x4*)(ws + WS_LAMP))[(((size_t)l * S5G + g) * 2 + d) * 64 + p] = (f32x4){pr, pi, ar, ai};
                    for (int c = 0; c < 16; ++c) { const float br = ap->s5_b_re[pb * 16 + c], bi = ap->s5_b_im[pb * 16 + c]; bbr[(d * 64 + p) * 16 + c] = cr * br - ci * bi; bbi[(d * 64 + p) * 16 + c] = cr * bi + ci * br;
                        const size_t cb = ((((size_t)l * 2 + d) * S5G + g) * S5CH + c) * S5P + p; ccr[(d * 16 + c) * 64 + p] = ap->s5_c_re[cb]; cci[(d * 16 + c) * 64 + p] = ap->s5_c_im[cb]; } }
                __syncthreads();
                for (int e = tid; e < 8192; e += NTHR) { const int d = e >> 12, j = (e >> 8) & 15, c = (e >> 4) & 15, cp = e & 15; float s = 0.f;
                    for (int p = 0; p < 64; ++p) { const float xr = ccr[(d * 16 + c) * 64 + p], xi = cci[(d * 16 + c) * 64 + p], yr = pwr[(d * 17 + j) * 64 + p], yi = pwi[(d * 17 + j) * 64 + p];
                        const float zr = xr * yr - xi * yi, zi = xr * yi + xi * yr; s += zr * bbr[(d * 64 + p) * 16 + cp] - zi * bbi[(d * 64 + p) * 16 + cp]; }
                    ktab[e] = s; }
                __syncthreads();
                bf16* FC = (bf16*)(ws + WS_FC) + ((size_t)l * S5G + g) * 65536; bf16* WC = (bf16*)(ws + WS_WC) + ((size_t)l * S5G + g) * 131072; const float* dsk = ap->s5_d + (size_t)l * S5W + g * 16;
                for (int idx = tid; idx < 8192; idx += NTHR) { const int n = idx >> 5, k0 = (idx & 31) * 8, d = n >> 7, p = (n >> 1) & 63, ri = n & 1, sI = k0 >> 4, c0 = k0 & 15, e = d == 0 ? 15 - sI : sI;
                    const float yr = pwr[(d * 17 + e) * 64 + p], yi = pwi[(d * 17 + e) * 64 + p]; float o[8];
#pragma unroll
                    for (int i = 0; i < 8; ++i) { const float br = bbr[(d * 64 + p) * 16 + c0 + i], bi = bbi[(d * 64 + p) * 16 + c0 + i]; o[i] = ri == 0 ? yr * br - yi * bi : yr * bi + yi * br; }
                    v4u w; w.x = pk2(o[0], o[1]); w.y = pk2(o[2], o[3]); w.z = pk2(o[4], o[5]); w.w = pk2(o[6], o[7]); *(v4u*)(FC + (size_t)n * 256 + k0) = w; }
                for (int idx = tid; idx < 16384; idx += NTHR) { const int n = idx >> 6, k0 = (idx & 63) * 8, t = n >> 4, c = n & 15; float o[8];
                    if (k0 < 256) { const int sI = k0 >> 4, c0 = k0 & 15;
#pragma unroll
                        for (int i = 0; i < 8; ++i) { float v = 0.f; if (sI <= t) v += ktab[((0 * 16 + (t - sI)) * 16 + c) * 16 + c0 + i]; if (sI >= t) v += ktab[((1 * 16 + (sI - t)) * 16 + c) * 16 + c0 + i]; if (sI == t && c0 + i == c) v += dsk[c]; o[i] = v; }
                    } else { const int kk = k0 - 256, d = kk >> 7, p0 = (kk & 127) >> 1, mm = d == 0 ? t + 1 : 16 - t;
#pragma unroll
                        for (int i = 0; i < 4; ++i) { const int p = p0 + i; const float xr = ccr[(d * 16 + c) * 64 + p], xi = cci[(d * 16 + c) * 64 + p], yr = pwr[(d * 17 + mm) * 64 + p], yi = pwi[(d * 17 + mm) * 64 + p];
                            o[2 * i] = xr * yr - xi * yi; o[2 * i + 1] = -(xr * yi + xi * yr); } }
                    v4u w; w.x = pk2(o[0], o[1]); w.y = pk2(o[2], o[3]); w.z = pk2(o[4], o[5]); w.w = pk2(o[6], o[7]); *(v4u*)(WC + (size_t)n * 512 + k0) = w; }
                __syncthreads();
            }
        }
        GRID_BAR();
    }

    const int plo = a.ph_lo, phi = a.ph_hi;
#define IN(k) (((PHMASK >> (k)) & 1) && plo <= (k) && (k) < phi)
    for (int l = a.l_lo; l < a.l_hi; ++l) {
#define wl (ws + WS_W + (size_t)l * WL_STRIDE)
#define modc (MOD + ((size_t)l * 2 + 0) * 6 * D)
#define modx (MOD + ((size_t)l * 2 + 1) * 6 * D)
#define NORM_PHASE(gvec, SH, SC) do { \
            for (int r = gw; r < R; r += NGW) { const float* md = r < CTXL ? modc : modx; const f32x4* xr = (const f32x4*)(XR + (size_t)r * D) + lane; f32x4 v[8]; float ss = 0.f; \
                _Pragma("unroll") for (int j = 0; j < 8; ++j) { v[j] = xr[64 * j]; ss += (v[j].x * v[j].x + v[j].y * v[j].y) + (v[j].z * v[j].z + v[j].w * v[j].w); } \
                const float rstd = 1.f / sqrtf(wave_sum(ss) * (1.f / D) + EPS); \
                _Pragma("unroll") for (int j = 0; j < 8; ++j) { const int c0 = lane * 4 + 256 * j; const f32x4 gg = *(const f32x4*)((gvec) + c0), sc = *(const f32x4*)(md + (SC) * D + c0), sh = *(const f32x4*)(md + (SH) * D + c0); \
                    const f32x4 o = v[j] * rstd * gg * (sc + 1.f) + sh; v2u w; w.x = pk2(o.x, o.y); w.y = pk2(o.z, o.w); *(v2u*)(HN + (size_t)r * D + c0) = w; } } } while (0)
        if (IN(0)) { PH_IDS const float* g1n = ap->norm1_g + (size_t)l * D; NORM_PHASE(g1n, 0, 1); GRID_BAR(); }

        if (IN(1)) { PH_WS
            pg8::Gemm g{HN, (const bf16*)(wl + WL_IN), D, D, D}; pg8::StaticOrder S; S.init(NPAN, NIN / 256, G, bid);
            EpiWin E{ap->b_in + (size_t)l * INW, U, CG, (bf16*)(ws + WS_SQ), Kb, (bf16*)(ws + WS_KT), (bf16*)(ws + WS_VC), Ob, GATES};
            pg8::gemm_phase<EpiWin, pg8::StaticOrder, true, true>(lds, g, S, E);
            GRID_BAR();
        }

        if (IN(2)) { PH_IDS
            { pg8::Gemm g{U, (const bf16*)(ws + WS_FC) + (size_t)l * S5G * 65536, UPITCH, 256, 256}; BatchOrder S{S5G * 3, G, (bid + 96) % G, 3};
              EpiF32T E{(float*)(ws + WS_EB), 65536, 256};
              pg8::gemm_phase<EpiF32T, BatchOrder, true, true>(lds, g, S, E); }
            {
                LAS float* wsl = (LAS float*)(lds + 65536);
                float* BC = (float*)(ws + WS_BC); float* CS = (float*)(ws + WS_CS); float* DN = (float*)(ws + WS_DN); float* AT = (float*)(ws + WS_AT);
                for (int task = bid; task < 2 * MLH * NCH; task += G) {
                    const int d = task / (MLH * NCH), h = (task / NCH) % MLH, c = task % NCH, dh = d * 4 + h;
                    if (wave == 0) { float lf[4], li[4], b[4]; float run = 0.f;
#pragma unroll
                        for (int j = 0; j < 4; ++j) { const int tp = lane * 4 + j, rr = c * 256 + (d ? 255 - tp : tp); const float gf = GATES[(size_t)rr * 16 + d * 8 + 4 + h]; li[j] = GATES[(size_t)rr * 16 + d * 8 + h];
                            lf[j] = fminf(gf, 0.f) - log1pf(__expf(-fabsf(gf))); run += lf[j]; b[j] = run; }
                        float inc = run;
#pragma unroll
                        for (int o = 1; o < 64; o <<= 1) { const float v = __shfl_up(inc, o); if (lane >= o) inc += v; }
                        const float excl = inc - run, btot = __shfl(inc, 63);
#pragma unroll
                        for (int j = 0; j < 4; ++j) { const int tp = lane * 4 + j, ir = d ? 255 - tp : tp; const float bb = b[j] + excl;
                            BC[(size_t)dh * R + c * 256 + ir] = bb; CS[(size_t)dh * R + c * 256 + ir] = __expf(li[j] - bb); wsl[ir] = __expf(btot - bb + li[j]); }
                        if (lane == 0) AT[dh * NCH + c] = __expf(btot); }
                    __syncthreads();
                    const bf16* kt = (const bf16*)(ws + WS_KT) + (size_t)(h * NCH + c) * 65536; bf16* ktw = (bf16*)(ws + WS_KTW) + (size_t)(dh * NCH + c) * 65536;
#pragma unroll 4
                    for (int i = 0; i < 16; ++i) { const int idx = tid + NTHR * i, dk = idx >> 5, s0 = (idx & 31) * 8; const v4u kv = *(const v4u*)(kt + (size_t)dk * 256 + s0);
                        const f32x4 w0 = *(const LAS f32x4*)(wsl + s0), w1 = *(const LAS f32x4*)(wsl + s0 + 4);
                        const float o0 = bflo(kv.x) * w0.x, o1 = bfhi(kv.x) * w0.y, o2 = bflo(kv.y) * w0.z, o3 = bfhi(kv.y) * w0.w, o4 = bflo(kv.z) * w1.x, o5 = bfhi(kv.z) * w1.y, o6 = bflo(kv.w) * w1.z, o7 = bfhi(kv.w) * w1.w;
                        v4u w; w.x = pk2(o0, o1); w.y = pk2(o2, o3); w.z = pk2(o4, o5); w.w = pk2(o6, o7); *(v4u*)(ktw + (size_t)dk * 256 + s0) = w;
                        float rs = ((o0 + o1) + (o2 + o3)) + ((o4 + o5) + (o6 + o7));
#pragma unroll
                        for (int o = 1; o < 32; o <<= 1) rs += __shfl_xor(rs, o);
                        if ((lane & 31) == 0) DN[(size_t)(dh * NCH + c) * 256 + dk] = rs; }
                    __syncthreads();
                }
            }
#if MLDBG
            {
                LAS float* red = (LAS float*)(lds + 65536 + 4096);
                float* HREF = (float*)(ws + WS_END); float* DREF = HREF + (size_t)2 * R * MLW;
                const bf16* SQd = (const bf16*)(ws + WS_SQ); const bf16* VCd = (const bf16*)(ws + WS_VC);
                for (int un = bid; un < 256; un += G) {
                    const int h = un >> 6, d = (un >> 5) & 1, sl = un & 31, dk = tid & 255, hf = tid >> 8, dv0 = sl * 8 + hf * 4;
                    float C0 = 0.f, C1 = 0.f, C2 = 0.f, C3 = 0.f, nn = 0.f;
                    for (int tau = 0; tau < R; ++tau) {
                        const int r = tau_row(d, tau), c = r >> 8, t = r & 255;
                        const float q = bf2f(SQd[((size_t)(h * NCH + c) * 256 + t) * 512 + 256 + dk]), k = bf2f(Kb[((size_t)h * R + r) * 256 + dk]);
                        const bf16* vp = VCd + ((size_t)(h * NCH + c) * 256 + dv0) * 512 + t; const float v0 = bf2f(vp[0]), v1 = bf2f(vp[512]), v2 = bf2f(vp[1024]), v3 = bf2f(vp[1536]);
                        const float gi = GATES[(size_t)r * 16 + d * 8 + h], gf = GATES[(size_t)r * 16 + d * 8 + 4 + h];
                        const float f = sigmoidf_(gf), ik = __expf(gi) * k;
                        C0 = f * C0 + ik * v0; C1 = f * C1 + ik * v1; C2 = f * C2 + ik * v2; C3 = f * C3 + ik * v3; nn = f * nn + ik;
                        const float s0 = wave_sum(q * C0), s1 = wave_sum(q * C1), s2 = wave_sum(q * C2), s3 = wave_sum(q * C3), s4 = wave_sum(q * nn);
                        LAS float* rb = red + (tau & 1) * 40 + wave * 5;
                        if (lane == 0) { rb[0] = s0; rb[1] = s1; rb[2] = s2; rb[3] = s3; rb[4] = s4; }
                        __syncthreads();
                        if (tid < 8) { const int h2 = tid >> 2, j = tid & 3; const LAS float* rr = red + (tau & 1) * 40 + h2 * 20; const float num = rr[j] + rr[5 + j] + rr[10 + j] + rr[15 + j], den = rr[4] + rr[9] + rr[14] + rr[19];
                            HREF[((size_t)d * R + r) * MLW + h * 256 + sl * 8 + h2 * 4 + j] = num / fmaxf(fabsf(den), 1.f); if (sl == 0 && tid == 0) DREF[((size_t)d * R + r) * 4 + h] = den; }
                    }
                    __syncthreads();
                }
            }
#endif
            {
                LAS float* part = (LAS float*)(lds + 98304);
                LAS float* stat = part + 512;
                const int ch = tid; float wv[CONVK];
#pragma unroll
                for (int j = 0; j < CONVK; ++j) wv[j] = ap->conv_dw_w[((size_t)l * CONVK + j) * CONVW + ch];
                const float dwb = ap->conv_dw_b[(size_t)l * CONVW + ch], lg = ap->conv_ln_g[(size_t)l * CONVW + ch], lb = ap->conv_ln_b[(size_t)l * CONVW + ch];
                for (int un = bid; un < 132; un += G) {
                    const int row0 = un < 4 ? 0 : CTXL + (un - 4) * 64, u0 = un < 4 ? un * 64 : 0, len = un < 4 ? CTXL : 64;
                    for (int hf = 0; hf < 2; ++hf) { const int p0 = u0 + hf * 32 - CONVK / 2;
                        float xw[62];
#pragma unroll
                        for (int k = 0; k < 62; ++k) { const int p = p0 + k; xw[k] = (p >= 0 && p < len) ? bf2f(CG[(size_t)(row0 + p) * CONVW + ch]) : 0.f; }
                        float y[32], q[32];
#pragma unroll
                        for (int i = 0; i < 32; ++i) { float acc = dwb;
#pragma unroll
                            for (int j = 0; j < CONVK; ++j) acc += wv[j] * xw[i + j];
                            y[i] = acc; q[i] = acc; }
                        float sq[32];
#pragma unroll
                        for (int i = 0; i < 32; ++i) sq[i] = y[i] * y[i];
#define CONV_FOLD(n, msk) { const bool hb = (lane & (msk)) != 0; _Pragma("unroll") for (int i = 0; i < (n) / 2; ++i) { \
                            const float s1 = hb ? q[i] : q[i + (n) / 2], k1 = hb ? q[i + (n) / 2] : q[i]; q[i] = k1 + __shfl_xor(s1, (msk)); \
                            const float s2 = hb ? sq[i] : sq[i + (n) / 2], k2 = hb ? sq[i + (n) / 2] : sq[i]; sq[i] = k2 + __shfl_xor(s2, (msk)); } }
                        CONV_FOLD(32, 32) CONV_FOLD(16, 16) CONV_FOLD(8, 8) CONV_FOLD(4, 4) CONV_FOLD(2, 2)
#undef CONV_FOLD
                        const float ts = q[0] + __shfl_xor(q[0], 1), tq = sq[0] + __shfl_xor(sq[0], 1);
                        if ((lane & 1) == 0) { part[(wave * 32 + (lane >> 1)) * 2] = ts; part[(wave * 32 + (lane >> 1)) * 2 + 1] = tq; }
                        __syncthreads();
                        if (tid < 32) { float a1 = 0.f, a2 = 0.f;
#pragma unroll
                            for (int w = 0; w < 8; ++w) { a1 += part[(w * 32 + tid) * 2]; a2 += part[(w * 32 + tid) * 2 + 1]; }
                            const float mean = a1 * (1.f / CONVW), var = fmaxf(a2 * (1.f / CONVW) - mean * mean, 0.f); stat[tid * 2] = mean; stat[tid * 2 + 1] = 1.f / sqrtf(var + LN_EPS); }
                        __syncthreads();
#pragma unroll
                        for (int i = 0; i < 32; ++i) { const float o = (y[i] - stat[2 * i]) * stat[2 * i + 1] * lg + lb;
                            ((unsigned short*)MIX)[(size_t)(row0 + u0 + hf * 32 + i) * D + S5W + ch] = (unsigned short)f2bf(siluf_(o)); }
                        __syncthreads();
                    }
                }
            }
            GRID_BAR();
        }

        if (IN(3)) { PH_IDS
            {
                const float* EB = (const float*)(ws + WS_EB); pg8::f32x2* ESC = (pg8::f32x2*)(ws + WS_ESC);
                for (int task = gw; task < S5G * 2 * NSC; task += NGW) { const int g = task / (2 * NSC), d = (task / NSC) & 1, sc = task % NSC;
                    const f32x4 lp = ((const f32x4*)(ws + WS_LAMP))[(((size_t)l * S5G + g) * 2 + d) * 64 + lane]; pg8::f32x2 e[16];
#pragma unroll
                    for (int j = 0; j < 16; ++j) { const int tc = sc * 16 + j, rc = d == 0 ? tc : (tc < CTXCK ? CTXCK - 1 - tc : NCK - 1 + CTXCK - tc); e[j] = *(const pg8::f32x2*)(EB + ((size_t)g * UROWS + rc) * 256 + d * 128 + 2 * lane); }
                    float hr = 0.f, hi = 0.f;
#pragma unroll
                    for (int j = 0; j < 16; ++j) { const float nr = lp.x * hr - lp.y * hi + e[j].x, ni = lp.x * hi + lp.y * hr + e[j].y; hr = nr; hi = ni; }
                    ESC[((size_t)(g * 2 + d) * NSC + sc) * 64 + lane] = (pg8::f32x2){hr, hi}; }
            }
            { pg8::Gemm g{(const bf16*)(ws + WS_SQ) + 256, Kb, 512, 256, 256}; BatchOrder S{MLH * NCH, G, bid, 0};
              EpiG1 E{(bf16*)(ws + WS_SQ), (const float*)(ws + WS_CS), (float*)(ws + WS_RSP)};
              pg8::gemm_phase<EpiG1, BatchOrder, true, true>(lds, g, S, E); }
            { pg8::Gemm g{(const bf16*)(ws + WS_VC), (const bf16*)(ws + WS_KTW), 512, 256, 256}; BatchOrder S{256, G, bid, 1};
              EpiF32T E{(float*)(ws + WS_DC), 65536, 256};
              pg8::gemm_phase<EpiF32T, BatchOrder, true, true>(lds, g, S, E); }
            GRID_BAR();
        }

        if (IN(4)) { PH_IDS
            const float* DC = (const float*)(ws + WS_DC); const float* AT = (const float*)(ws + WS_AT); bf16* VC = (bf16*)(ws + WS_VC);
            for (int b = bid; b < 256; b += G) {
                const int dh = b >> 5, d = dh >> 2, part = b & 31, dv = part * 8 + (tid >> 6), dk0 = (tid & 63) * 4;
                f32x4 C = {0.f, 0.f, 0.f, 0.f}; float nn = 0.f;
                *(v2u*)(VC + ((size_t)(dh * NCH) * 256 + dv) * 512 + 256 + dk0) = (v2u){0u, 0u};
                if (part == 0 && tid < 256) ((float*)(ws + WS_NIN))[(size_t)(dh * NCH) * 256 + tid] = 0.f;
                int c = 0; f32x4 dc = *(const f32x4*)(DC + ((size_t)(dh * NCH + c) * 256 + dv) * 256 + dk0);
                for (int st = 0; st < NCH - 1; ++st) {
                    const int cn = d == 0 ? st + 1 : NCH - 1 - st; const f32x4 dcur = dc; const float A = AT[dh * NCH + c];
                    float dn = 0.f; if (part == 0 && tid < 256) dn = ((const float*)(ws + WS_DN))[(size_t)(dh * NCH + c) * 256 + tid];
                    if (st + 1 < NCH - 1) dc = *(const f32x4*)(DC + ((size_t)(dh * NCH + cn) * 256 + dv) * 256 + dk0);
                    C = C * A + dcur; v2u w; w.x = pk2(C.x, C.y); w.y = pk2(C.z, C.w);
                    *(v2u*)(VC + ((size_t)(dh * NCH + cn) * 256 + dv) * 512 + 256 + dk0) = w;
                    if (part == 0 && tid < 256) { nn = nn * A + dn; ((float*)(ws + WS_NIN))[(size_t)(dh * NCH + cn) * 256 + tid] = nn; }
                    c = cn; }
            }
            {
                const float* EB = (const float*)(ws + WS_EB); const pg8::f32x2* ESC = (const pg8::f32x2*)(ws + WS_ESC);
                for (int task = gw; task < S5G * 2 * NSC; task += NGW) { const int g = task / (2 * NSC), d = (task / NSC) & 1, sc = task % NSC;
                    const f32x4 lp = ((const f32x4*)(ws + WS_LAMP))[(((size_t)l * S5G + g) * 2 + d) * 64 + lane]; pg8::f32x2 e[16];
#pragma unroll
                    for (int j = 0; j < 16; ++j) { const int tc = sc * 16 + j, rc = d == 0 ? tc : (tc < CTXCK ? CTXCK - 1 - tc : NCK - 1 + CTXCK - tc); e[j] = *(const pg8::f32x2*)(EB + ((size_t)g * UROWS + rc) * 256 + d * 128 + 2 * lane); }
                    float hr = 0.f, hi = 0.f;
                    for (int s2 = 0; s2 < sc; ++s2) { const pg8::f32x2 es = ESC[((size_t)(g * 2 + d) * NSC + s2) * 64 + lane]; const float nr = lp.z * hr - lp.w * hi + es.x, ni = lp.z * hi + lp.w * hr + es.y; hr = nr; hi = ni; }
#pragma unroll
                    for (int j = 0; j < 16; ++j) { const int tc = sc * 16 + j, rc = d == 0 ? tc : (tc < CTXCK ? CTXCK - 1 - tc : NCK - 1 + CTXCK - tc);
                        *(unsigned*)(U + ((size_t)g * UROWS + rc) * UPITCH + 256 + d * 128 + 2 * lane) = pk2(hr, hi);
                        const float nr = lp.x * hr - lp.y * hi + e[j].x, ni = lp.x * hi + lp.y * hr + e[j].y; hr = nr; hi = ni; } }
            }
            GRID_BAR();
        }

        if (IN(5)) { PH_WS
            pg8::Gemm g{(const bf16*)(ws + WS_SQ), (const bf16*)(ws + WS_VC), 512, 512, 512}; BatchOrder S{2 * MLH * NCH, G, bid, 2};
            EpiG3 E{HML};
            pg8::gemm_phase<EpiG3, BatchOrder, true, true>(lds, g, S, E);
            { pg8::Gemm g2{U, (const bf16*)(ws + WS_WC) + (size_t)l * S5G * 131072, UPITCH, 512, 512}; BatchOrder S2{S5G * 3, G, (bid + 96) % G, 3};
              EpiS5Y E2{S5Gb};
              pg8::gemm_phase<EpiS5Y, BatchOrder, true, true>(lds, g2, S2, E2); }
            GRID_BAR();
        }

        if (IN(6)) { PH_IDS
            const float* ng = ap->ml_norm_g + (size_t)l * MLW;
            const float* BC = (const float*)(ws + WS_BC); const float* RSP = (const float*)(ws + WS_RSP); const float* NIN = (const float*)(ws + WS_NIN); const bf16* SQ = (const bf16*)(ws + WS_SQ);
            for (int it = gw; it < R * MLH; it += NGW) { const int r = it >> 2, h = it & 3, c = r >> 8, t = r & 255; const size_t o0 = (size_t)r * MLW + h * 256 + lane * 4;
                const v2u qw = *(const v2u*)(SQ + ((size_t)(h * NCH + c) * 256 + t) * 512 + 256 + lane * 4); const f32x4 q = {bflo(qw.x), bfhi(qw.x), bflo(qw.y), bfhi(qw.y)};
                f32x4 v = {0.f, 0.f, 0.f, 0.f};
#pragma unroll
                for (int d = 0; d < 2; ++d) { const int dh = d * 4 + h; const f32x4 n4 = *(const f32x4*)(NIN + (size_t)(dh * NCH + c) * 256 + lane * 4);
                    const float qn = wave_sum((q.x * n4.x + q.y * n4.y) + (q.z * n4.z + q.w * n4.w)); const f32x4 rp = *(const f32x4*)(RSP + ((size_t)dh * R + r) * 4);
                    const float aa = __expf(BC[(size_t)dh * R + r]), den = aa * ((rp.x + rp.y) + (rp.z + rp.w) + qn);
#if MLDBG
                    { const f32x4 hn = *(const f32x4*)(HML + (size_t)d * R * MLW + o0) * (aa / fmaxf(fabsf(den), 1.f)); const float* HREF = (const float*)(ws + WS_END); const float* DREF = HREF + (size_t)2 * R * MLW;
                      const f32x4 hr = *(const f32x4*)(HREF + (size_t)d * R * MLW + o0); const f32x4 df = hn - hr; const float dref = DREF[((size_t)d * R + r) * 4 + h];
                      const float e2 = wave_sum((df.x * df.x + df.y * df.y) + (df.z * df.z + df.w * df.w)), r2 = wave_sum((hr.x * hr.x + hr.y * hr.y) + (hr.z * hr.z + hr.w * hr.w));
                      if (lane == 0 && l == 0) { float* cnt = (float*)(ws + WS_CTL) + 8192;
                          atomicAdd(cnt + 2 * d, e2); atomicAdd(cnt + 2 * d + 1, r2);
                          if (c == 0) { atomicAdd(cnt + 4, e2); atomicAdd(cnt + 5, r2); }
                          atomicAdd(cnt + 6 + 2 * (h >> 1), e2); atomicAdd(cnt + 7 + 2 * (h >> 1), r2);
                          atomicAdd(cnt + 10, (den - dref) * (den - dref)); atomicAdd(cnt + 11, dref * dref); }
                      v += hr; }
#else
                    v += *(const f32x4*)(HML + (size_t)d * R * MLW + o0) * (aa / fmaxf(fabsf(den), 1.f));
#endif
                }
                const float mean = wave_sum((v.x + v.y) + (v.z + v.w)) * (1.f / 256.f); const f32x4 dv = v - mean;
                const float var = wave_sum((dv.x * dv.x + dv.y * dv.y) + (dv.z * dv.z + dv.w * dv.w)) * (1.f / 256.f), rstd = 1.f / sqrtf(var + LN_EPS);
                const f32x4 gg = *(const f32x4*)(ng + h * 256 + lane * 4); const v2u ow = *(const v2u*)(Ob + o0);
                const f32x4 o = {sigmoidf_(bflo(ow.x)) * dv.x * rstd * gg.x, sigmoidf_(bfhi(ow.x)) * dv.y * rstd * gg.y, sigmoidf_(bflo(ow.y)) * dv.z * rstd * gg.z, sigmoidf_(bfhi(ow.y)) * dv.w * rstd * gg.w};
                v2u w; w.x = pk2(o.x, o.y); w.y = pk2(o.z, o.w); *(v2u*)(MIX + (size_t)r * D + 1024 + h * 256 + lane * 4) = w; }
            GRID_BAR();
        }

        if (IN(7)) { PH_WS
            pg8::Gemm g{S5Gb, (const bf16*)(wl + WL_GLU), S5W, S5W, S5W}; pg8::StaticOrder S; S.init(NPAN, S5W / 256, G, bid);
            EpiGlu E{S5Gb, ap->s5_b_glu + (size_t)l * S5W, MIX};
            pg8::gemm_phase<EpiGlu, pg8::StaticOrder, true, true>(lds, g, S, E);
            GRID_BAR();
        }

        if (IN(8)) { PH_WS
            pg8::Gemm g{MIX, (const bf16*)(wl + WL_OUT), D, D, D}; pg8::StaticOrder S; S.init(NPAN, D / 256, G, bid);
            EpiRes E{XR, modc + 2 * D, modx + 2 * D};
            pg8::gemm_phase<EpiRes, pg8::StaticOrder, true, true>(lds, g, S, E);
            GRID_BAR();
        }

        if (IN(9)) { PH_IDS const float* g2n = ap->norm2_g + (size_t)l * D; NORM_PHASE(g2n, 3, 4); GRID_BAR(); }

        if (IN(10)) { PH_WS
            pg8::Gemm g{HN, (const bf16*)(wl + WL_FI), D, D, D}; pg8::StaticOrder S; S.init(NPAN, 2 * DFF / 256, G, bid);
            EpiSwiglu E{HFF};
            pg8::gemm_phase<EpiSwiglu, pg8::StaticOrder, true, true>(lds, g, S, E);
            GRID_BAR();
        }

        if (IN(11)) { PH_WS
            pg8::Gemm g{HFF, (const bf16*)(wl + WL_FO), DFF, DFF, DFF}; pg8::StaticOrder S; S.init(NPAN, D / 256, G, bid);
            EpiRes E{XR, modc + 5 * D, modx + 5 * D};
            pg8::gemm_phase<EpiRes, pg8::StaticOrder, true, true>(lds, g, S, E);
            GRID_BAR();
        }
    }

    if (a.do_fin) { PH_IDS
#if MLDBG
        float Pdbg = 0.f;
        if (bid == 0 && tid == 0) { const float* cnt = (const float*)(ws + WS_CTL) + 8192;
            for (int k = 0; k < 6; ++k) { const float e = __hip_atomic_load(cnt + 2 * k, __ATOMIC_RELAXED, __HIP_MEMORY_SCOPE_AGENT), rr = __hip_atomic_load(cnt + 2 * k + 1, __ATOMIC_RELAXED, __HIP_MEMORY_SCOPE_AGENT); if (e > MLDBG_THR * MLDBG_THR * rr) Pdbg += (float)(1 << k); } }
#endif
        for (int r = CTXL + gw; r < R; r += NGW) { const f32x4* xr = (const f32x4*)(XR + (size_t)r * D) + lane; f32x4 v[8]; float ss = 0.f;
#pragma unroll
            for (int j = 0; j < 8; ++j) { v[j] = xr[64 * j]; ss += (v[j].x * v[j].x + v[j].y * v[j].y) + (v[j].z * v[j].z + v[j].w * v[j].w); }
            const float rstd = 1.f / sqrtf(wave_sum(ss) * (1.f / D) + EPS);
#pragma unroll
            for (int j = 0; j < 8; ++j) { const int c0 = lane * 4 + 256 * j; *(f32x4*)(ap->out + (size_t)(r - CTXL) * D + c0) = v[j] * rstd * *(const f32x4*)(ap->norm_f_g + c0); } }
#if MLDBG
        if (bid == 0 && tid == 0) { asm volatile("s_waitcnt vmcnt(0)" ::: "memory"); ap->out[0] += Pdbg; }
#endif
    }
#undef IN
#undef NORM_PHASE
#undef GRID_BAR
}

extern "C" void kernel_launch(void* const* d_in, const int* in_sizes, int n_in, void* d_out, int out_size, void* d_ws, size_t ws_size, hipStream_t stream) {
    static int grid = 0;
    if (grid == 0) {
        if (n_in != 29 || in_sizes[0] != SEQ * D || out_size != SEQ * D || ws_size < WS_END) { fprintf(stderr, "kernel_launch: unexpected problem (n_in %d, in0 %d, out %d, ws %zu < %zu)\n", n_in, n_in > 0 ? in_sizes[0] : -1, out_size, ws_size, (size_t)WS_END); grid = -1; return; }
        int dev = 0, cus = 0, per_cu = 0;
        if (hipGetDevice(&dev) != hipSuccess || hipDeviceGetAttribute(&cus, hipDeviceAttributeMultiprocessorCount, dev) != hipSuccess) { grid = -1; return; }
        if (hipFuncSetAttribute((const void*)fwd, hipFuncAttributeMaxDynamicSharedMemorySize, LDS_BYTES) != hipSuccess) { fprintf(stderr, "kernel_launch: hipFuncSetAttribute failed\n"); grid = -1; return; }
        if (hipOccupancyMaxActiveBlocksPerMultiprocessor(&per_cu, (const void*)fwd, NTHR, LDS_BYTES) != hipSuccess || per_cu < 1) fprintf(stderr, "kernel_launch: occupancy query says %d\n", per_cu);
        (void)hipGetLastError();
        grid = cus;
    }
    if (grid < 0) return;
    (void)hipMemsetAsync((char*)d_ws + WS_CTL, 0, CTL_ZERO_BYTES, stream);
    Args a{};
    const float** pp = (const float**)&a;
    for (int i = 0; i < 29; ++i) pp[i] = (const float*)d_in[i];
    a.out = (float*)d_out; a.ws = (unsigned char*)d_ws;
#if MK_SINGLE
    a.l_lo = 0; a.l_hi = DEPTH; a.ph_lo = 0; a.ph_hi = NPH; a.do_pro = 1; a.do_fin = 1; a.use_bar = 1;
    hipLaunchKernelGGL(fwd, dim3(grid), dim3(NTHR), LDS_BYTES, stream, a);
#else
    a.use_bar = 0;
    a.l_lo = 0; a.l_hi = 0; a.ph_lo = 0; a.ph_hi = 0; a.do_pro = 1; a.do_fin = 0;
    hipLaunchKernelGGL(fwd, dim3(grid), dim3(NTHR), LDS_BYTES, stream, a);
    a.do_pro = 0;
    for (int l = 0; l < DEPTH; ++l) for (int p = 0; p < NPH; ++p) { a.l_lo = l; a.l_hi = l + 1; a.ph_lo = p; a.ph_hi = p + 1; hipLaunchKernelGGL(fwd, dim3(grid), dim3(NTHR), LDS_BYTES, stream, a); }
    a.l_lo = 0; a.l_hi = 0; a.ph_lo = 0; a.ph_hi = 0; a.do_fin = 1;
    hipLaunchKernelGGL(fwd, dim3(grid), dim3(NTHR), LDS_BYTES, stream, a);
#endif
}
```

```cpp
#include <hip/hip_runtime.h>
#include <cstdio>
#include <cstdint>

#ifndef PHMASK
#define PHMASK 0xfff
#endif
#ifndef PROMASK
#define PROMASK 1
#endif
#ifndef MLDBG
#define MLDBG 0
#endif
#ifndef MLDBG_THR
#define MLDBG_THR 0.03f
#endif
#ifndef TPROBE
#define TPROBE 0
#endif
#define TPMUL 9
#ifndef MK_SINGLE
#define MK_SINGLE 1
#endif

namespace pg8 {
#define PG8_LAS __attribute__((address_space(3)))
typedef unsigned short bf16_t;
typedef short bf16x8 __attribute__((ext_vector_type(8)));
typedef float f32x4 __attribute__((ext_vector_type(4)));
typedef float f32x2 __attribute__((ext_vector_type(2)));
typedef unsigned u32x4 __attribute__((ext_vector_type(4)));
constexpr int BM = 256, BK = 64, HALF = 128, HTB = HALF * BK * 2, STAGE_BYTES = 8 * HTB, NXCD = 8, WGM = 8;

__host__ __device__ __forceinline__ int lds_byte(int r, int c) { const int st = (r >> 4) * 2 + (c >> 5), rr = r & 15, cc = c & 31, ob = rr * 64 + cc * 2; return st * 1024 + (ob ^ (((ob >> 9) & 1) << 5)); }
__host__ __device__ __forceinline__ void stage_rc(int b, int& R, int& C) { const int st = b / 1024, sb = b % 1024, swz = sb ^ (((sb >> 9) & 1) << 5); R = (st >> 1) * 16 + swz / 64; C = (st & 1) * 32 + (swz % 64) / 2; }
__host__ __device__ __forceinline__ int perm32(int rho) { const int n = rho >> 4, i = rho & 15; return 8 * (i >> 2) + 4 * n + (i & 3); }

struct Unit { int pm, pn, ka; };
struct Gemm { const bf16_t* A; const bf16_t* Bt; int lda, ldb, K; };

struct StaticOrder {
    int nM, nN, nwg, G, c, pm0;
    __host__ __device__ void init(int nM_, int nN_, int G_, int c_, int pm0_ = 0) { nM = nM_; nN = nN_; nwg = nM * nN; G = G_; c = c_; pm0 = pm0_; }
    __host__ __device__ bool next(int i, Unit& u) const {
        const long L = (long)i * G + c; if (L >= nwg) return false;
        int wgid = (int)L; { const int q = nwg / NXCD, r = nwg % NXCD, xcd = wgid % NXCD, off = wgid / NXCD; wgid = (xcd < r ? xcd * (q + 1) : r * (q + 1) + (xcd - r) * q) + off; }
        const int nig = WGM * nN, gid = wgid / nig, fm = gid * WGM, gsz = (nM - fm) < WGM ? (nM - fm) : WGM;
        u.pm = pm0 + fm + ((wgid % nig) % gsz); u.pn = (wgid % nig) / gsz; u.ka = 0; return true;
    }
};

__device__ __forceinline__ unsigned cvt_pk_bf16(float lo, float hi) { unsigned r; asm volatile("v_cvt_pk_bf16_f32 %0, %1, %2" : "=v"(r) : "v"(lo), "v"(hi)); return r; }

template <class Epi, class Sched, bool ALIGN_EPI = false, bool SP2 = false>
__device__ __forceinline__ void gemm_phase(PG8_LAS unsigned char* lds, const Gemm g, const Sched& S, const Epi& E, const int wave_s) {
    int lane_o; asm volatile("v_mbcnt_lo_u32_b32 %0, -1, 0\n\tv_mbcnt_hi_u32_b32 %0, -1, %0" : "=v"(lane_o)); int tid_o = wave_s * 64 + lane_o;
    const int tid = tid_o, wid = __builtin_amdgcn_readfirstlane(tid >> 6), lane = tid & 63, wr = wid >> 2, wc = wid & 3, fr = lane & 15, fq = lane >> 4;
    const int K = g.K, nt = K / BK;
    unsigned voffA[2], voffB[2];
#pragma unroll
    for (int i = 0; i < 2; ++i) { int R, C; stage_rc(tid * 16 + i * 8192, R, C); const int Rb = Epi::PERM ? ((R & ~31) + perm32(R & 31)) : R;
        voffA[i] = (unsigned)(R * g.lda + C) * 2u; voffB[i] = (unsigned)(Rb * g.ldb + C) * 2u; }
    const size_t kstep = (size_t)(BK * 2);
    const size_t hstepA = (size_t)HALF * g.lda * 2, hstepB = (size_t)HALF * g.ldb * 2;
    const size_t tstepA = 2 * hstepA, tstepB = 2 * hstepB;
    const unsigned ldsw = (unsigned)wid * 1024u;
    const int aoff = lds_byte(wr * 64 + fr, fq * 8), boff = lds_byte(wc * 32 + fr, fq * 8);
#define PG8_SA(b, h) (((b) * 2 + (h)) * HTB)
#define PG8_SB(b, h) ((4 + (b) * 2 + (h)) * HTB)
#define PG8_STAGE(bufoff, gbase, voff) do { _Pragma("unroll") for (int _i = 0; _i < 2; ++_i) \
        __builtin_amdgcn_global_load_lds((const unsigned*)((const char*)(gbase) + (voff)[_i]), (PG8_LAS unsigned*)(lds + (bufoff) + ldsw + _i * 8192), 16, 0, 0); } while (0)
#define PG8_LDA(dst, b, h) do { _Pragma("unroll") for (int m = 0; m < 4; ++m) _Pragma("unroll") for (int k = 0; k < 2; ++k) dst[m][k] = *(const PG8_LAS bf16x8*)(lds + PG8_SA(b, h) + aoff + m * 2048 + k * 1024); } while (0)
#define PG8_LDB(dst, b, h) do { _Pragma("unroll") for (int n = 0; n < 2; ++n) _Pragma("unroll") for (int k = 0; k < 2; ++k) dst[n][k] = *(const PG8_LAS bf16x8*)(lds + PG8_SB(b, h) + boff + n * 2048 + k * 1024); } while (0)
#define PG8_MMA(ai, bj, At, Bt) do { __builtin_amdgcn_s_setprio(1); _Pragma("unroll") for (int m = 0; m < 4; ++m) _Pragma("unroll") for (int n = 0; n < 2; ++n) _Pragma("unroll") for (int k = 0; k < 2; ++k) \
        acc[ai][bj][m][n] = __builtin_amdgcn_mfma_f32_16x16x32_bf16(Bt[n][k], At[m][k], acc[ai][bj][m][n], 0, 0, 0); __builtin_amdgcn_s_setprio(0); } while (0)
#define PG8_WAIT_V(n) asm volatile("s_waitcnt vmcnt(" #n ")" ::: "memory")
#define PG8_WAIT_L(n) asm volatile("s_waitcnt lgkmcnt(" #n ")" ::: "memory")
#define PG8_BAR __builtin_amdgcn_s_barrier()
#define PG8_SCHED __builtin_amdgcn_sched_barrier(0)
    Unit cur, nxt; int ui = 0;
    if (!S.next(0, cur)) return;
    f32x4 acc[2][2][4][2];
#pragma unroll
    for (int a = 0; a < 2; ++a)
#pragma unroll
        for (int b = 0; b < 2; ++b)
#pragma unroll
            for (int m = 0; m < 4; ++m)
#pragma unroll
                for (int n = 0; n < 2; ++n) acc[a][b][m][n] = (f32x4){0.f, 0.f, 0.f, 0.f};
    bf16x8 At[4][2], B0[2][2], B1[2][2];
    const char* cA = (const char*)g.A + (size_t)cur.pm * tstepA + (size_t)cur.ka * 2; const char* cB = (const char*)g.Bt + (size_t)cur.pn * tstepB + (size_t)cur.ka * 2;
    if constexpr (SP2) {
        PG8_STAGE(PG8_SB(0, 0), cB, voffB); PG8_STAGE(PG8_SB(0, 1), cB + hstepB, voffB); PG8_STAGE(PG8_SA(0, 0), cA, voffA); PG8_STAGE(PG8_SA(0, 1), cA + hstepA, voffA);
        if (wr == 1) PG8_BAR;
        PG8_WAIT_V(2); PG8_BAR;
        PG8_STAGE(PG8_SB(1, 0), cB + kstep, voffB); PG8_STAGE(PG8_SA(1, 0), cA + kstep, voffA); PG8_STAGE(PG8_SB(1, 1), cB + hstepB + kstep, voffB);
        PG8_WAIT_V(6); PG8_BAR;
    } else {
        PG8_STAGE(PG8_SB(0, 0), cB, voffB); PG8_STAGE(PG8_SA(0, 0), cA, voffA); PG8_STAGE(PG8_SB(0, 1), cB + hstepB, voffB); PG8_STAGE(PG8_SA(0, 1), cA + hstepA, voffA);
        if (wr == 1) PG8_BAR;
        PG8_WAIT_V(4); PG8_BAR;
        PG8_STAGE(PG8_SB(1, 0), cB + kstep, voffB); PG8_STAGE(PG8_SA(1, 0), cA + kstep, voffA); PG8_STAGE(PG8_SB(1, 1), cB + hstepB + kstep, voffB);
        PG8_WAIT_V(6); PG8_BAR;
    }
    for (;;) {
        const bool has_next = S.next(ui + 1, nxt);
        const char* nA = has_next ? (const char*)g.A + (size_t)nxt.pm * tstepA + (size_t)nxt.ka * 2 : cA; const char* nB = has_next ? (const char*)g.Bt + (size_t)nxt.pn * tstepB + (size_t)nxt.ka * 2 : cB;
#pragma nounroll
        for (int t = 0; t < nt; t += 2) {
            const bool last = (t == nt - 2);
            const char* a1 = cA + (size_t)(t + 1) * kstep;
            const char* a2 = last ? nA : cA + (size_t)(t + 2) * kstep; const char* b2 = last ? nB : cB + (size_t)(t + 2) * kstep;
            const char* a3 = a2 + kstep; const char* b3 = b2 + kstep;
            if constexpr (SP2) {
            PG8_LDB(B0, 0, 0); PG8_LDB(B1, 0, 1); PG8_SCHED; PG8_LDA(At, 0, 0); PG8_STAGE(PG8_SA(1, 1), a1 + hstepA, voffA);
            PG8_WAIT_V(8); PG8_WAIT_L(0); PG8_BAR; PG8_MMA(0, 0, At, B0); PG8_MMA(0, 1, At, B1); PG8_BAR; PG8_SCHED;
            PG8_LDA(At, 0, 1); PG8_STAGE(PG8_SB(0, 0), b2, voffB); PG8_STAGE(PG8_SB(0, 1), b2 + hstepB, voffB); PG8_STAGE(PG8_SA(0, 0), a2, voffA);
            PG8_WAIT_V(8); PG8_WAIT_L(0); PG8_BAR; PG8_MMA(1, 0, At, B0); PG8_MMA(1, 1, At, B1); PG8_BAR; PG8_SCHED;
            PG8_LDB(B0, 1, 0); PG8_LDB(B1, 1, 1); PG8_SCHED; PG8_LDA(At, 1, 0); PG8_STAGE(PG8_SA(0, 1), a2 + hstepA, voffA);
            PG8_WAIT_V(8); PG8_WAIT_L(0); PG8_BAR; PG8_MMA(0, 0, At, B0); PG8_MMA(0, 1, At, B1); PG8_BAR; PG8_SCHED;
            PG8_LDA(At, 1, 1); PG8_STAGE(PG8_SB(1, 0), b3, voffB); PG8_STAGE(PG8_SB(1, 1), b3 + hstepB, voffB); PG8_STAGE(PG8_SA(1, 0), a3, voffA);
            PG8_WAIT_V(8); PG8_WAIT_L(0); PG8_BAR; PG8_MMA(1, 0, At, B0); PG8_MMA(1, 1, At, B1); PG8_BAR; PG8_SCHED;
            } else {
            PG8_LDB(B0, 0, 0); PG8_SCHED; PG8_LDA(At, 0, 0); PG8_STAGE(PG8_SA(1, 1), a1 + hstepA, voffA);
            PG8_WAIT_L(8); PG8_BAR; PG8_WAIT_L(0); PG8_MMA(0, 0, At, B0); PG8_BAR; PG8_SCHED;
            PG8_LDB(B1, 0, 1); PG8_STAGE(PG8_SB(0, 0), b2, voffB);
            PG8_BAR; PG8_WAIT_L(0); PG8_MMA(0, 1, At, B1); PG8_BAR;
            PG8_LDA(At, 0, 1); PG8_STAGE(PG8_SA(0, 0), a2, voffA);
            PG8_BAR; PG8_WAIT_L(0); PG8_MMA(1, 0, At, B0); PG8_BAR; PG8_SCHED;
            PG8_STAGE(PG8_SB(0, 1), b2 + hstepB, voffB);
            PG8_WAIT_V(6); PG8_BAR; PG8_MMA(1, 1, At, B1); PG8_BAR;
            PG8_LDB(B0, 1, 0); PG8_SCHED; PG8_LDA(At, 1, 0); PG8_STAGE(PG8_SA(0, 1), a2 + hstepA, voffA);
            PG8_WAIT_L(8); PG8_BAR; PG8_WAIT_L(0); PG8_MMA(0, 0, At, B0); PG8_BAR; PG8_SCHED;
            PG8_LDB(B1, 1, 1); PG8_STAGE(PG8_SB(1, 0), b3, voffB);
            PG8_BAR; PG8_WAIT_L(0); PG8_MMA(0, 1, At, B1); PG8_BAR;
            PG8_LDA(At, 1, 1); PG8_STAGE(PG8_SA(1, 0), a3, voffA);
            PG8_BAR; PG8_WAIT_L(0); PG8_MMA(1, 0, At, B0); PG8_BAR; PG8_SCHED;
            PG8_STAGE(PG8_SB(1, 1), b3 + hstepB, voffB);
            PG8_WAIT_V(6); PG8_BAR; PG8_MMA(1, 1, At, B1); PG8_BAR;
            }
        }
        if constexpr (ALIGN_EPI) { if (wr == 0) PG8_BAR; }
        { int fr_o = fr, fq_o = fq; asm volatile("" : "+v"(fr_o), "+v"(fq_o)); E(acc, cur, wr, wc, fr_o, fq_o); }
        if (!has_next) break;
#pragma unroll
        for (int a = 0; a < 2; ++a)
#pragma unroll
            for (int b = 0; b < 2; ++b)
#pragma unroll
                for (int m = 0; m < 4; ++m)
#pragma unroll
                    for (int n = 0; n < 2; ++n) acc[a][b][m][n] = (f32x4){0.f, 0.f, 0.f, 0.f};
        cur = nxt; cA = nA; cB = nB; ++ui;
        if constexpr (ALIGN_EPI) { if (wr == 1) PG8_BAR; }
    }
    PG8_WAIT_V(0);
    if constexpr (!ALIGN_EPI) { if (wr == 0) PG8_BAR; }
    PG8_BAR;
#undef PG8_SA
#undef PG8_SB
#undef PG8_STAGE
#undef PG8_LDA
#undef PG8_LDB
#undef PG8_MMA
#undef PG8_WAIT_V
#undef PG8_WAIT_L
#undef PG8_BAR
#undef PG8_SCHED
}
}

constexpr int D = 2048, SEQ = 8192, CTXL = 256, R = SEQ + CTXL, DEPTH = 4, NPAN = R / 256;
constexpr int S5W = 512, S5G = 32, S5CH = 16, S5P = 64, CONVW = 512, CONVK = 31, MLW = 1024, MLH = 4, DH = 256, DFF = 5632;
constexpr int INW = 5648, NIN = 5888;
constexpr int OFF_CONV = 512, OFF_Q = 1536, OFF_K = 2560, OFF_V = 3584, OFF_O = 4608, OFF_G = 5632;
constexpr float EPS = 1e-6f, LN_EPS = 1e-5f;
constexpr int UROWS = 768, UPITCH = 512;

constexpr size_t MiB = 1u << 20;
constexpr size_t WS_CTL = 0, CTL_ZERO_BYTES = 1 * MiB;
constexpr size_t WS_MOD = 1 * MiB;
constexpr size_t WS_XR = 2 * MiB;
constexpr size_t WS_HN = 68 * MiB;
constexpr size_t WS_U = 101 * MiB;
constexpr size_t WS_CG = 125 * MiB;
constexpr size_t WS_Q = 134 * MiB, WS_K = 151 * MiB, WS_V = 168 * MiB;
constexpr size_t WS_O = 185 * MiB;
constexpr size_t WS_GATES = 202 * MiB;
constexpr size_t WS_MIX = 203 * MiB;
constexpr size_t WS_HFF = 236 * MiB;
constexpr size_t WS_YS = 327 * MiB;
constexpr size_t WS_S5G = 360 * MiB;
constexpr size_t WS_HML = 369 * MiB;
constexpr size_t WS_W = 436 * MiB;
constexpr size_t WL_IN = 0, WL_OUT = 23 * MiB, WL_FI = 31 * MiB, WL_FO = 75 * MiB, WL_GLU = 97 * MiB, WL_STRIDE = 98 * MiB;
constexpr size_t WS_SQ = 828 * MiB;
constexpr size_t WS_VC = 894 * MiB;
constexpr size_t WS_KT = 960 * MiB;
constexpr size_t WS_KTW = 977 * MiB;
constexpr size_t WS_DC = 1010 * MiB;
constexpr size_t WS_BC = 1076 * MiB;
constexpr size_t WS_CS = WS_BC + 512 * 1024;
constexpr size_t WS_DN = WS_CS + 512 * 1024;
constexpr size_t WS_NIN = WS_DN + 512 * 1024;
constexpr size_t WS_AT = 1078 * MiB + 1536 * 1024;
constexpr size_t WS_RSP = 1078 * MiB;
constexpr size_t WS_FC = 1080 * MiB;
constexpr size_t WS_WC = 1096 * MiB;
constexpr size_t WS_LAMP = 1128 * MiB;
constexpr size_t WS_EB = 1129 * MiB;
constexpr size_t WS_ESC = 1153 * MiB;
constexpr size_t WS_END = 1155 * MiB;
constexpr int NCK = R / 16, CTXCK = CTXL / 16, NSC = NCK / 16;
constexpr int NCH = 33;
constexpr int CW_BAR = 4096;

constexpr int RING_BYTES = 131072, LDSCTL_OFF = RING_BYTES, MISC_OFF = LDSCTL_OFF + 320, LDS_BYTES = 147456;
constexpr int NWAVES = 8, NTHR = 512;

#define GAS __attribute__((address_space(1)))
#define LAS __attribute__((address_space(3)))
typedef unsigned short bf16;
typedef unsigned v4u __attribute__((ext_vector_type(4)));
typedef unsigned v2u __attribute__((ext_vector_type(2)));
typedef float f32x4 __attribute__((ext_vector_type(4)));
typedef GAS unsigned gu32;
#define RLX_AGENT __ATOMIC_RELAXED, __HIP_MEMORY_SCOPE_AGENT
#define LDS_WAIT() asm volatile("s_waitcnt lgkmcnt(0)" ::: "memory")
__device__ __forceinline__ unsigned f2bf(float f) { unsigned u = __builtin_bit_cast(unsigned, f); return (u + 0x7fffu + ((u >> 16) & 1u)) >> 16; }
__device__ __forceinline__ unsigned pk2(float lo, float hi) { unsigned r; asm("v_cvt_pk_bf16_f32 %0, %1, %2" : "=v"(r) : "v"(lo), "v"(hi)); return r; }
__device__ __forceinline__ float bf2f(unsigned short b) { return __builtin_bit_cast(float, ((unsigned)b) << 16); }
__device__ __forceinline__ float bflo(unsigned w) { return __builtin_bit_cast(float, w << 16); }
__device__ __forceinline__ float bfhi(unsigned w) { return __builtin_bit_cast(float, w & 0xffff0000u); }
__device__ __forceinline__ float sigmoidf_(float x) { return __builtin_amdgcn_rcpf(1.f + __builtin_amdgcn_exp2f(-1.4426950408889634f * x)); }
__device__ __forceinline__ float siluf_(float x) { return x * __builtin_amdgcn_rcpf(1.f + __builtin_amdgcn_exp2f(-1.4426950408889634f * x)); }
__device__ __forceinline__ float gelu_tanh_(float x) { const float u = 0.7978845608028654f * (x + 0.044715f * x * x * x); return x * __builtin_amdgcn_rcpf(1.f + __builtin_amdgcn_exp2f(-2.8853900817779268f * u)); }
template <int CTRL, int RM> __device__ __forceinline__ float dppf(float v) { return __builtin_bit_cast(float, __builtin_amdgcn_update_dpp(0, __builtin_bit_cast(int, v), CTRL, RM, 0xF, false)); }
__device__ __forceinline__ float wave_sum(float v) {
    v += dppf<0xB1, 0xF>(v); v += dppf<0x4E, 0xF>(v); v += dppf<0x124, 0xF>(v); v += dppf<0x128, 0xF>(v);
    v += dppf<0x142, 0xA>(v); v += dppf<0x143, 0xC>(v);
    return __builtin_bit_cast(float, __builtin_amdgcn_readlane(__builtin_bit_cast(int, v), 63));
}
__device__ __forceinline__ int tau_row(int d, int tau) { return d == 0 ? tau : (tau < CTXL ? CTXL - 1 - tau : (R - 1 + CTXL) - tau); }

#define XB_TMO      128
#define XB_XCNT(j)  (256  + 64 * (j))
#define XB_XSUB(j)  (1280 + 64 * (j))
#define XB_XGEN(j)  (2304 + 64 * (j))
#define XB_TOP      3328
#define XB_TOPGEN   3392
#define XCD_BAR_WORDS 3456
#define XB_SPIN_CAP (1u << 22)
__device__ __forceinline__ unsigned xb_ld(unsigned* p)              { return __hip_atomic_load(p, __ATOMIC_RELAXED, __HIP_MEMORY_SCOPE_AGENT); }
__device__ __forceinline__ unsigned xb_add(unsigned* p, unsigned v) { return __hip_atomic_fetch_add(p, v, __ATOMIC_RELAXED, __HIP_MEMORY_SCOPE_AGENT); }
__device__ __forceinline__ unsigned xb_xcc_id() { return (unsigned)__builtin_amdgcn_s_getreg((3 << 11) | 20) & 0xFu; }
#define XB_SPIN(cond, bar) do { unsigned _sp = 0; while (cond) { __builtin_amdgcn_s_sleep(1); \
    if ((++_sp & 255u) == 0u) { if (xb_ld(&(bar)[XB_TMO])) break; if (_sp > XB_SPIN_CAP) { atomicAdd(&(bar)[XB_TMO], 1u); break; } } } } while (0)
struct XcdBarrier { unsigned* bar; unsigned x; volatile LAS unsigned* st; };
__device__ __forceinline__ XcdBarrier xcd_barrier_post(unsigned* bar, volatile LAS unsigned* st) {
    XcdBarrier b; b.bar = bar; b.x = xb_xcc_id(); b.st = st;
    if (threadIdx.x == 0) (void)xb_add(&bar[XB_XCNT(b.x)], 1u);
    return b;
}
__device__ __forceinline__ void xcd_barrier_complete(unsigned* bar, unsigned x, unsigned& nloc, unsigned& nx) {
    const unsigned G = gridDim.x * gridDim.y * gridDim.z;
    unsigned sum, cnt, mine, sp = 0u;
    for (;;) {
        sum = 0u; cnt = 0u; mine = 0u;
#pragma unroll
        for (unsigned j = 0; j < 16; ++j) { const unsigned c = xb_ld(&bar[XB_XCNT(j)]); sum += c; cnt += (c > 0u) ? 1u : 0u; mine = (j == x) ? c : mine; }
        if (sum == G) break;
        __builtin_amdgcn_s_sleep(1);
        if ((++sp & 255u) == 0u) { if (xb_ld(&bar[XB_TMO])) break; if (sp > XB_SPIN_CAP) { atomicAdd(&bar[XB_TMO], 1u); break; } }
    }
    nloc = mine > 0u ? mine : 1u; nx = cnt > 0u ? cnt : 1u;
}
__device__ __forceinline__ void xcd_barrier(const XcdBarrier& b) {
    asm volatile("s_waitcnt vmcnt(0)" ::: "memory");
    __syncthreads();
    if (threadIdx.x == 0) {
        unsigned* bar = b.bar;
        __builtin_amdgcn_s_waitcnt(0);
        unsigned nloc = b.st[0], nx = b.st[1];
        if (nloc == 0u) { xcd_barrier_complete(bar, b.x, nloc, nx); b.st[0] = nloc; b.st[1] = nx; }
        const unsigned old = xb_add(&bar[XB_XSUB(b.x)], 1u);
        const unsigned gen = old / nloc;
        if (old + 1u == (gen + 1u) * nloc) {
            __builtin_amdgcn_fence(__ATOMIC_RELEASE, "agent");
            asm volatile("s_waitcnt vmcnt(0)" ::: "memory");
            const unsigned og = xb_add(&bar[XB_TOP], 1u);
            const unsigned tg = og / nx;
            if (og + 1u == (tg + 1u) * nx) xb_add(&bar[XB_TOPGEN], 1u);
            else XB_SPIN(xb_ld(&bar[XB_TOPGEN]) == tg, bar);
            __builtin_amdgcn_fence(__ATOMIC_ACQUIRE, "agent");
            xb_add(&bar[XB_XGEN(b.x)], 1u);
            asm volatile("s_waitcnt vmcnt(0)" ::: "memory");
        } else {
            XB_SPIN(xb_ld(&bar[XB_XGEN(b.x)]) == gen, bar);
            __builtin_amdgcn_fence(__ATOMIC_ACQUIRE, "agent");
            asm volatile("s_waitcnt vmcnt(0)" ::: "memory");
        }
    }
    __syncthreads();
}

struct Args {
    const float *x, *c, *ctx, *c_ctx, *w_mod, *b_mod, *norm1_g, *w_in, *b_in, *s5_lam_re, *s5_lam_im, *s5_log_step, *s5_b_re, *s5_b_im, *s5_c_re, *s5_c_im,
                *s5_d, *s5_w_glu, *s5_b_glu, *conv_dw_w, *conv_dw_b, *conv_ln_g, *conv_ln_b, *ml_norm_g, *w_out, *norm2_g, *w_ffn_in, *w_ffn_out, *norm_f_g;
    float* out; unsigned char* ws;
    int l_lo, l_hi, ph_lo, ph_hi, do_pro, do_fin, use_bar, pad;
};

typedef const Args __attribute__((address_space(4))) CArgs;

struct TItem { const float* W; bf16* WT; int Nsrc, ldt, k0, n0d, n0s, nvalid; };
__device__ __forceinline__ void titem_load(const TItem& t, f32x4 (&v)[8], int lane) {
    const int r8 = lane >> 3, q4 = (lane & 7) * 4;
#pragma unroll
    for (int i = 0; i < 8; ++i) { const f32x4 x = *(const f32x4*)(t.W + (size_t)(t.k0 + 8 * i + r8) * t.Nsrc + t.n0s + (q4 < t.nvalid ? q4 : 0)); v[i] = q4 < t.nvalid ? x : (f32x4){0.f, 0.f, 0.f, 0.f}; }
}
__device__ __forceinline__ void titem_store(const TItem& t, const f32x4 (&v)[8], LAS float* scr, int lane) {
    const int r8 = lane >> 3, q4 = (lane & 7) * 4;
#pragma unroll
    for (int i = 0; i < 8; ++i) { LAS float* d = scr + (8 * i + r8) * 33 + q4; d[0] = v[i].x; d[1] = v[i].y; d[2] = v[i].z; d[3] = v[i].w; }
    LDS_WAIT(); asm volatile("" ::: "memory");
    const int c = lane & 7;
#pragma unroll
    for (int j = 0; j < 4; ++j) { const int n = (lane >> 3) + 8 * j; const LAS float* s = scr + (8 * c) * 33 + n;
        v4u o; o.x = pk2(s[0 * 33], s[1 * 33]); o.y = pk2(s[2 * 33], s[3 * 33]); o.z = pk2(s[4 * 33], s[5 * 33]); o.w = pk2(s[6 * 33], s[7 * 33]);
        *(GAS v4u*)(t.WT + (size_t)(t.n0d + n) * t.ldt + t.k0 + 8 * c) = o; }
    LDS_WAIT(); asm volatile("" ::: "memory");
}
__device__ __forceinline__ int win_src(int nd) {
    if (nd >= OFF_CONV && nd < OFF_Q) { const int t = (nd - OFF_CONV) >> 8, w = (nd - OFF_CONV) & 255; return w < 128 ? OFF_CONV + t * 128 + w : OFF_CONV + CONVW + t * 128 + (w - 128); }
    return nd;
}
__device__ __forceinline__ int wfi_src(int nd) { const int t = nd >> 8, w = nd & 255; return w < 128 ? t * 128 + w : DFF + t * 128 + (w - 128); }

constexpr int I_IN = (D / 64) * (NIN / 32), I_OUT = (D / 64) * (D / 32), I_FI = (D / 64) * (2 * DFF / 32), I_FO = (DFF / 64) * (D / 32), I_GLU = (S5W / 64) * (S5W / 32);
constexpr int I_L = I_IN + I_OUT + I_FI + I_FO + I_GLU;
__device__ __forceinline__ void titem_decode(CArgs* ap, unsigned char* ws, int l_, int r_, TItem& T) {
    unsigned char* wl_ = ws + WS_W + (size_t)l_ * WL_STRIDE;
    if (r_ < I_IN) { const int nb = r_ % (NIN / 32), kb = r_ / (NIN / 32), nd = nb * 32; const int nv = nd + 32 <= INW ? 32 : (nd < INW ? INW - nd : 0);
        T = TItem{ap->w_in + (size_t)l_ * D * INW, (bf16*)(wl_ + WL_IN), INW, D, kb * 64, nd, nv ? win_src(nd) : 0, nv}; }
    else if ((r_ -= I_IN) < I_OUT) { const int nb = r_ % (D / 32), kb = r_ / (D / 32); T = TItem{ap->w_out + (size_t)l_ * D * D, (bf16*)(wl_ + WL_OUT), D, D, kb * 64, nb * 32, nb * 32, 32}; }
    else if ((r_ -= I_OUT) < I_FI) { const int nb = r_ % (2 * DFF / 32), kb = r_ / (2 * DFF / 32); T = TItem{ap->w_ffn_in + (size_t)l_ * D * 2 * DFF, (bf16*)(wl_ + WL_FI), 2 * DFF, D, kb * 64, nb * 32, wfi_src(nb * 32), 32}; }
    else if ((r_ -= I_FI) < I_FO) { const int nb = r_ % (D / 32), kb = r_ / (D / 32); T = TItem{ap->w_ffn_out + (size_t)l_ * DFF * D, (bf16*)(wl_ + WL_FO), D, DFF, kb * 64, nb * 32, nb * 32, 32}; }
    else { r_ -= I_FO; const int nb = r_ % (S5W / 32), kb = r_ / (S5W / 32); T = TItem{ap->s5_w_glu + (size_t)l_ * S5W * S5W, (bf16*)(wl_ + WL_GLU), S5W, S5W, kb * 64, nb * 32, nb * 32, 32}; }
}
__device__ __forceinline__ void convert_range(CArgs* ap, unsigned char* ws, LAS unsigned char* lds, int wave, int lane, int l, int lo, int hi, int first, int step) {
    LAS float* scr = (LAS float*)(lds + wave * 16384);
    int it = lo + first; if (it >= hi) return;
    TItem tc, tn; f32x4 vc[8], vn[8];
    titem_decode(ap, ws, l, it, tn); titem_load(tn, vn, lane);
    for (; it < hi; it += step) { tc = tn;
#pragma unroll
        for (int i = 0; i < 8; ++i) vc[i] = vn[i];
        { const int i1 = it + step < hi ? it + step : hi - 1; titem_decode(ap, ws, l, i1, tn); titem_load(tn, vn, lane); }
        titem_store(tc, vc, scr, lane); }
}

using pg8::f32x2;
struct EpiWin {
    static constexpr bool PERM = true;
    const float* bias; bf16 *U, *CG, *SQ, *Kb, *KT, *VC, *O; float* GATES;
    __device__ __forceinline__ void operator()(const f32x4 (&acc)[2][2][4][2], const pg8::Unit& u, int wr, int wc, int fr, int fq) const {
        const int row0 = u.pm * 256 + wr * 64 + fr, pn = u.pn, cw0 = wc * 32 + 8 * fq;
        if (pn < 2) {
#pragma unroll
            for (int bj = 0; bj < 2; ++bj) { const int col = pn * 256 + bj * 128 + cw0, g = col >> 4, ch0 = col & 15;
                const f32x4 b0 = *(const f32x4*)(bias + col), b1 = *(const f32x4*)(bias + col + 4);
#pragma unroll
                for (int ai = 0; ai < 2; ++ai)
#pragma unroll
                    for (int m = 0; m < 4; ++m) { const int r = row0 + ai * 128 + m * 16; const f32x4 v0 = acc[ai][bj][m][0] + b0, v1 = acc[ai][bj][m][1] + b1;
                        v4u w; w.x = pk2(v0[0], v0[1]); w.y = pk2(v0[2], v0[3]); w.z = pk2(v1[0], v1[1]); w.w = pk2(v1[2], v1[3]);
                        *(v4u*)(U + ((size_t)g * UROWS + (r >> 4)) * UPITCH + (r & 15) * 16 + ch0) = w; } }
        } else if (pn < 6) {
            const int ch = (pn - 2) * 128 + cw0;
            const f32x4 a0 = *(const f32x4*)(bias + OFF_CONV + ch), a1 = *(const f32x4*)(bias + OFF_CONV + ch + 4), b0 = *(const f32x4*)(bias + OFF_CONV + CONVW + ch), b1 = *(const f32x4*)(bias + OFF_CONV + CONVW + ch + 4);
#pragma unroll
            for (int ai = 0; ai < 2; ++ai)
#pragma unroll
                for (int m = 0; m < 4; ++m) { const int r = row0 + ai * 128 + m * 16;
                    const f32x4 x0 = acc[ai][0][m][0] + a0, x1 = acc[ai][0][m][1] + a1, y0 = acc[ai][1][m][0] + b0, y1 = acc[ai][1][m][1] + b1; float o[8];
#pragma unroll
                    for (int j = 0; j < 4; ++j) { o[j] = x0[j] * sigmoidf_(y0[j]); o[4 + j] = x1[j] * sigmoidf_(y1[j]); }
                    v4u w; w.x = pk2(o[0], o[1]); w.y = pk2(o[2], o[3]); w.z = pk2(o[4], o[5]); w.w = pk2(o[6], o[7]);
                    *(v4u*)(CG + (size_t)r * CONVW + ch) = w; }
        } else if (pn < 22) {
            const int which = (pn - 6) >> 2, h = (pn - 6) & 3, c = u.pm; const float sc = which == 1 ? 0.0625f : 1.f;
#pragma unroll
            for (int bj = 0; bj < 2; ++bj) { const int cw = bj * 128 + cw0; const f32x4 b0 = *(const f32x4*)(bias + pn * 256 + cw), b1 = *(const f32x4*)(bias + pn * 256 + cw + 4);
#pragma unroll
                for (int ai = 0; ai < 2; ++ai)
#pragma unroll
                    for (int m = 0; m < 4; ++m) { int t = wr * 64 + fr + ai * 128 + m * 16; asm volatile("" : "+v"(t) :: "memory"); const int r = c * 256 + t; const f32x4 v0 = (acc[ai][bj][m][0] + b0) * sc, v1 = (acc[ai][bj][m][1] + b1) * sc;
                        v4u w; w.x = pk2(v0[0], v0[1]); w.y = pk2(v0[2], v0[3]); w.z = pk2(v1[0], v1[1]); w.w = pk2(v1[2], v1[3]);
                        if (which == 0) { *(v4u*)(SQ + ((size_t)(h * NCH + c) * 256 + t) * 512 + 256 + cw) = w; *(v4u*)(SQ + ((size_t)((4 + h) * NCH + c) * 256 + t) * 512 + 256 + cw) = w; }
                        else if (which == 1) { *(v4u*)(Kb + ((size_t)h * R + r) * 256 + cw) = w; unsigned short* kt = (unsigned short*)KT + ((size_t)(h * NCH + c) * 256 + cw) * 256 + t;
                            kt[0] = (unsigned short)w.x; kt[256] = (unsigned short)(w.x >> 16); kt[512] = (unsigned short)w.y; kt[768] = (unsigned short)(w.y >> 16);
                            kt[1024] = (unsigned short)w.z; kt[1280] = (unsigned short)(w.z >> 16); kt[1536] = (unsigned short)w.w; kt[1792] = (unsigned short)(w.w >> 16); }
                        else if (which == 2) {
#pragma unroll
                            for (int d = 0; d < 2; ++d) { unsigned short* vt = (unsigned short*)VC + ((size_t)((d * 4 + h) * NCH + c) * 256 + cw) * 512 + t;
                                vt[0] = (unsigned short)w.x; vt[512] = (unsigned short)(w.x >> 16); vt[1024] = (unsigned short)w.y; vt[1536] = (unsigned short)(w.y >> 16);
                                vt[2048] = (unsigned short)w.z; vt[2560] = (unsigned short)(w.z >> 16); vt[3072] = (unsigned short)w.w; vt[3584] = (unsigned short)(w.w >> 16); } }
                        else *(v4u*)(O + (size_t)r * 1024 + h * 256 + cw) = w; } }
        } else {
            if (wc == 0 && fq < 2) { const f32x4 b0 = *(const f32x4*)(bias + OFF_G + 8 * fq), b1 = *(const f32x4*)(bias + OFF_G + 8 * fq + 4);
#pragma unroll
                for (int ai = 0; ai < 2; ++ai)
#pragma unroll
                    for (int m = 0; m < 4; ++m) { const int r = row0 + ai * 128 + m * 16;
                        *(f32x4*)(GATES + (size_t)r * 16 + 8 * fq) = acc[ai][0][m][0] + b0; *(f32x4*)(GATES + (size_t)r * 16 + 8 * fq + 4) = acc[ai][0][m][1] + b1; } }
        }
    }
};
struct EpiRes {
    static constexpr bool PERM = false;
    float* XR; const float* gate_c; const float* gate_x; const float* RS;
    __device__ __forceinline__ void operator()(const f32x4 (&acc)[2][2][4][2], const pg8::Unit& u, int wr, int wc, int fr, int fq) const {
        const int row0 = u.pm * 256 + wr * 64 + fr, col0 = u.pn * 256 + wc * 32 + 4 * fq; const float* gate = u.pm == 0 ? gate_c : gate_x;
        f32x4 gv[2][2];
#pragma unroll
        for (int bj = 0; bj < 2; ++bj)
#pragma unroll
            for (int n = 0; n < 2; ++n) gv[bj][n] = *(const f32x4*)(gate + col0 + bj * 128 + n * 16);
#pragma unroll
        for (int ai = 0; ai < 2; ++ai)
#pragma unroll
            for (int m = 0; m < 4; ++m) { float* rowp = XR + (size_t)(row0 + ai * 128 + m * 16) * D + col0;
#pragma unroll
                for (int bj = 0; bj < 2; ++bj)
#pragma unroll
                    for (int n = 0; n < 2; ++n) { f32x4* p = (f32x4*)(rowp + bj * 128 + n * 16); *p = *(const f32x4*)(RS + (size_t)(row0 + ai * 128 + m * 16) * D + col0 + bj * 128 + n * 16) + gv[bj][n] * acc[ai][bj][m][n]; } }
    }
};
struct EpiSwiglu {
    static constexpr bool PERM = true;
    bf16* HFF;
    __device__ __forceinline__ void operator()(const f32x4 (&acc)[2][2][4][2], const pg8::Unit& u, int wr, int wc, int fr, int fq) const {
        const int row0 = u.pm * 256 + wr * 64 + fr, hc = u.pn * 128 + wc * 32 + 8 * fq;
#pragma unroll
        for (int ai = 0; ai < 2; ++ai)
#pragma unroll
            for (int m = 0; m < 4; ++m) { int r = row0 + ai * 128 + m * 16; asm volatile("" : "+v"(r) :: "memory"); float o[8];
#pragma unroll
                for (int j = 0; j < 4; ++j) { o[j] = siluf_(acc[ai][0][m][0][j]) * acc[ai][1][m][0][j]; o[4 + j] = siluf_(acc[ai][0][m][1][j]) * acc[ai][1][m][1][j]; }
                v4u w; w.x = pk2(o[0], o[1]); w.y = pk2(o[2], o[3]); w.z = pk2(o[4], o[5]); w.w = pk2(o[6], o[7]);
                *(v4u*)(HFF + (size_t)r * DFF + hc) = w; }
    }
};
struct EpiGlu {
    static constexpr bool PERM = true;
    const bf16* S5Gb; const float* bias; bf16* MIX;
    __device__ __forceinline__ void operator()(const f32x4 (&acc)[2][2][4][2], const pg8::Unit& u, int wr, int wc, int fr, int fq) const {
        const int row0 = u.pm * 256 + wr * 64 + fr;
#pragma unroll
        for (int bj = 0; bj < 2; ++bj) { const int col = u.pn * 256 + bj * 128 + wc * 32 + 8 * fq; const f32x4 b0 = *(const f32x4*)(bias + col), b1 = *(const f32x4*)(bias + col + 4);
#pragma unroll
            for (int ai = 0; ai < 2; ++ai)
#pragma unroll
                for (int m = 0; m < 4; ++m) { const int r = row0 + ai * 128 + m * 16; const v4u gw = *(const v4u*)(S5Gb + (size_t)r * S5W + col);
                    const f32x4 v0 = acc[ai][bj][m][0] + b0, v1 = acc[ai][bj][m][1] + b1; float o[8];
                    o[0] = bflo(gw.x) * sigmoidf_(v0[0]); o[1] = bfhi(gw.x) * sigmoidf_(v0[1]); o[2] = bflo(gw.y) * sigmoidf_(v0[2]); o[3] = bfhi(gw.y) * sigmoidf_(v0[3]);
                    o[4] = bflo(gw.z) * sigmoidf_(v1[0]); o[5] = bfhi(gw.z) * sigmoidf_(v1[1]); o[6] = bflo(gw.w) * sigmoidf_(v1[2]); o[7] = bfhi(gw.w) * sigmoidf_(v1[3]);
                    v4u w; w.x = pk2(o[0], o[1]); w.y = pk2(o[2], o[3]); w.z = pk2(o[4], o[5]); w.w = pk2(o[6], o[7]);
                    *(v4u*)(MIX + (size_t)r * D + col) = w; } }
    }
};

struct BatchOrder {
    int n, G, c, mode;
    __device__ __forceinline__ bool next(int i, pg8::Unit& u) const {
        const long L = (long)i * G + c; if (L >= n) return false; const int idx = (int)L; u.ka = 0;
        if (mode == 4) { u.pm = 0; u.pn = idx & 7; u.ka = (idx >> 3) * 256; }
        else if (mode == 1) { const int d = idx >> 7, h = (idx >> 5) & 3, cc = idx & 31, ch = d == 0 ? cc : (cc == 0 ? 0 : cc + 1); u.pm = u.pn = (d * 4 + h) * NCH + ch; }
        else if (mode == 3) { u.pm = idx; u.pn = idx / 3; }
        else { u.pm = u.pn = idx; }
        return true;
    }
};
struct EpiG1 {
    static constexpr bool PERM = true;
    bf16* SQ; const float* CS; float* RSP;
    __device__ __forceinline__ void operator()(const f32x4 (&acc)[2][2][4][2], const pg8::Unit& u, int wr, int wc, int fr, int fq) const {
        const int h = u.pm / NCH, c = u.pm % NCH;
#pragma unroll
        for (int d = 0; d < 2; ++d) {
            const float* cs = CS + (size_t)(d * 4 + h) * R + c * 256 + wc * 32 + 8 * fq; f32x4 csv[2][2];
#pragma unroll
            for (int bj = 0; bj < 2; ++bj)
#pragma unroll
                for (int n = 0; n < 2; ++n) csv[bj][n] = *(const f32x4*)(cs + bj * 128 + 4 * n);
            bf16* dst = SQ + (size_t)((d * 4 + h) * NCH + c) * 256 * 512; float* rsp = RSP + ((size_t)(d * 4 + h) * R + c * 256) * 4 + wc;
#pragma unroll
            for (int ai = 0; ai < 2; ++ai)
#pragma unroll
                for (int m = 0; m < 4; ++m) { int t = ai * 128 + wr * 64 + m * 16 + fr; asm volatile("" : "+v"(t) :: "memory"); float rs = 0.f;
#pragma unroll
                    for (int bj = 0; bj < 2; ++bj) { const int s0 = bj * 128 + wc * 32 + 8 * fq; float o[8];
#pragma unroll
                        for (int n = 0; n < 2; ++n)
#pragma unroll
                            for (int j = 0; j < 4; ++j) { const int si = s0 + 4 * n + j; const bool ok = d == 0 ? si <= t : si >= t; const float v = acc[ai][bj][m][n][j] * csv[bj][n][j]; o[4 * n + j] = ok ? v : 0.f; rs += o[4 * n + j]; }
                        v4u w; w.x = pk2(o[0], o[1]); w.y = pk2(o[2], o[3]); w.z = pk2(o[4], o[5]); w.w = pk2(o[6], o[7]);
                        *(v4u*)(dst + (size_t)t * 512 + s0) = w; }
                    rs += __shfl_xor(rs, 16); rs += __shfl_xor(rs, 32); if (fq == 0) rsp[(size_t)t * 4] = rs; }
        }
    }
};
struct EpiS5Y {
    static constexpr bool PERM = true;
    bf16* S5Gb;
    __device__ __forceinline__ void operator()(const f32x4 (&acc)[2][2][4][2], const pg8::Unit& u, int wr, int wc, int fr, int fq) const {
        const int g = u.pn, mt = u.pm - 3 * u.pn;
#pragma unroll
        for (int ai = 0; ai < 2; ++ai)
#pragma unroll
            for (int m = 0; m < 4; ++m) { int ck = mt * 256 + ai * 128 + wr * 64 + m * 16 + fr; asm volatile("" : "+v"(ck) :: "memory");
                if (ck < NCK) {
#pragma unroll
                    for (int bj = 0; bj < 2; ++bj) { const int nc = bj * 128 + wc * 32 + 8 * fq, t = nc >> 4, c0 = nc & 15; float o[8];
#pragma unroll
                        for (int j = 0; j < 4; ++j) { o[j] = gelu_tanh_(acc[ai][bj][m][0][j]); o[4 + j] = gelu_tanh_(acc[ai][bj][m][1][j]); }
                        v4u w; w.x = pk2(o[0], o[1]); w.y = pk2(o[2], o[3]); w.z = pk2(o[4], o[5]); w.w = pk2(o[6], o[7]);
                        *(v4u*)(S5Gb + (size_t)(ck * 16 + t) * S5W + g * 16 + c0) = w; } } }
    }
};
struct EpiPart {
    static constexpr bool PERM = false;
    float* PART;
    __device__ __forceinline__ void operator()(const f32x4 (&acc)[2][2][4][2], const pg8::Unit& u, int wr, int wc, int fr, int fq) const {
        float* o = PART + ((size_t)(u.ka >> 8) * 256 + wr * 64 + fr) * D + u.pn * 256 + wc * 32 + 4 * fq;
#pragma unroll
        for (int ai = 0; ai < 2; ++ai)
#pragma unroll
            for (int m = 0; m < 4; ++m) { float* rowp = o + (size_t)(ai * 128 + m * 16) * D;
#pragma unroll
                for (int bj = 0; bj < 2; ++bj)
#pragma unroll
                    for (int n = 0; n < 2; ++n) *(f32x4*)(rowp + bj * 128 + n * 16) = acc[ai][bj][m][n]; }
    }
};
struct EpiF32T {
    static constexpr bool PERM = false;
    float* base; size_t tile_stride; int ldc;
    __device__ __forceinline__ void operator()(const f32x4 (&acc)[2][2][4][2], const pg8::Unit& u, int wr, int wc, int fr, int fq) const {
        float* o = base + (size_t)u.pm * tile_stride + (size_t)(wr * 64 + fr) * ldc + wc * 32 + 4 * fq;
#pragma unroll
        for (int ai = 0; ai < 2; ++ai)
#pragma unroll
            for (int m = 0; m < 4; ++m) { float* rowp = o + (size_t)(ai * 128 + m * 16) * ldc;
#pragma unroll
                for (int bj = 0; bj < 2; ++bj)
#pragma unroll
                    for (int n = 0; n < 2; ++n) *(f32x4*)(rowp + bj * 128 + n * 16) = acc[ai][bj][m][n]; }
    }
};
struct EpiG3 {
    static constexpr bool PERM = true;
    bf16* HMB;
    __device__ __forceinline__ void operator()(const f32x4 (&acc)[2][2][4][2], const pg8::Unit& u, int wr, int wc, int fr, int fq) const {
        const int dh = u.pm / NCH, c = u.pm % NCH, d = dh >> 2, h = dh & 3;
        bf16* o = HMB + ((size_t)d * R + c * 256 + wr * 64 + fr) * MLW + h * 256 + wc * 32 + 8 * fq;
#pragma unroll
        for (int ai = 0; ai < 2; ++ai)
#pragma unroll
            for (int m = 0; m < 4; ++m) { bf16* rowp = o + (size_t)(ai * 128 + m * 16) * MLW;
#pragma unroll
                for (int bj = 0; bj < 2; ++bj) { const f32x4 v0 = acc[ai][bj][m][0], v1 = acc[ai][bj][m][1];
                    v4u w; w.x = pk2(v0[0], v0[1]); w.y = pk2(v0[2], v0[3]); w.z = pk2(v1[0], v1[1]); w.w = pk2(v1[2], v1[3]); *(v4u*)(rowp + bj * 128) = w; } }
    }
};
struct EpiBf16T {
    static constexpr bool PERM = true;
    bf16* base; size_t tile_stride; int ldc;
    __device__ __forceinline__ void operator()(const f32x4 (&acc)[2][2][4][2], const pg8::Unit& u, int wr, int wc, int fr, int fq) const {
        bf16* o = base + (size_t)u.pm * tile_stride + (size_t)(wr * 64 + fr) * ldc + wc * 32 + 8 * fq;
#pragma unroll
        for (int ai = 0; ai < 2; ++ai)
#pragma unroll
            for (int m = 0; m < 4; ++m) { bf16* rowp = o + (size_t)(ai * 128 + m * 16) * ldc;
#pragma unroll
                for (int bj = 0; bj < 2; ++bj) { const f32x4 v0 = acc[ai][bj][m][0], v1 = acc[ai][bj][m][1];
                    v4u w; w.x = pk2(v0[0], v0[1]); w.y = pk2(v0[2], v0[3]); w.z = pk2(v1[0], v1[1]); w.w = pk2(v1[2], v1[3]); *(v4u*)(rowp + bj * 128) = w; } }
    }
};

constexpr int CV_B0 = 0, CV_B1 = 10200, CV_A0 = CV_B1, CV_A1 = CV_B1 + 10900, CV_C0 = CV_A1, CV_C1 = I_L;
constexpr int NPH = 12;
__global__ void __launch_bounds__(NTHR, 2) fwd(Args a) {
    extern __shared__ __attribute__((aligned(16))) unsigned char lds_raw[];
    LAS unsigned char* lds = (LAS unsigned char*)lds_raw;
    volatile LAS unsigned* MISC = (volatile LAS unsigned*)(lds + MISC_OFF);
    const int G = gridDim.x, bid = blockIdx.x, NGW = G * NWAVES;
    const int wave0 = __builtin_amdgcn_readfirstlane((int)threadIdx.x >> 6);
    for (int u = threadIdx.x; u < (LDS_BYTES - LDSCTL_OFF) / 4; u += NTHR) ((LAS unsigned*)(lds + LDSCTL_OFF))[u] = 0u;
    __syncthreads();
    gu32* ctl = (gu32*)(a.ws + WS_CTL);
#define PH_WS CArgs* ap = (CArgs*)__builtin_amdgcn_kernarg_segment_ptr(); asm volatile("" : "+s"(ap)); unsigned char* ws = ap->ws;
#define MOD ((float*)(ws + WS_MOD))
#define XR ((float*)(ws + WS_XR))
#define HN ((bf16*)(ws + WS_HN))
#define U ((bf16*)(ws + WS_U))
#define CG ((bf16*)(ws + WS_CG))
#define Kb ((bf16*)(ws + WS_K))
#define Ob ((bf16*)(ws + WS_O))
#define GATES ((float*)(ws + WS_GATES))
#define MIX ((bf16*)(ws + WS_MIX))
#define HFF ((bf16*)(ws + WS_HFF))
#define YS ((float*)(ws + WS_YS))
#define S5Gb ((bf16*)(ws + WS_S5G))
#define HML ((float*)(ws + WS_HML))
    XcdBarrier bar; bar.bar = (unsigned*)(ctl + CW_BAR); bar.x = 0; bar.st = nullptr;
    if (a.use_bar) bar = xcd_barrier_post((unsigned*)(ctl + CW_BAR), MISC + 8);
#define GRID_BAR() do { if (a.use_bar) xcd_barrier(bar); } while (0)
    unsigned long long tp_acc = 0ull;
#define TP0(k) const unsigned long long tp0_ = (((TPROBE >> (k)) | (TPROBE >> ((k) + 16))) & 1) ? __builtin_amdgcn_s_memrealtime() : 0ull;
#define TPW(k) do { if ((TPROBE >> ((k) + 16)) & 1) tp_acc += __builtin_amdgcn_s_memrealtime() - tp0_; } while (0)
#define TP1(k) do { if ((TPROBE >> (k)) & 1) tp_acc += __builtin_amdgcn_s_memrealtime() - tp0_; } while (0)
#define PH_IDS PH_WS int lane; asm volatile("v_mbcnt_lo_u32_b32 %0, -1, 0\n\tv_mbcnt_hi_u32_b32 %0, -1, %0" : "=v"(lane)); const int wave = wave0, tid = wave * 64 + lane, gw = bid * NWAVES + wave; (void)tid; (void)gw;

    if (PROMASK && a.do_pro) { TP0(12) PH_IDS
        __syncthreads();
        {
            LAS float* red = (LAS float*)lds;
            LAS float* scv = (LAS float*)(lds + 16384);
            for (int k = tid; k < D; k += NTHR) { scv[k] = siluf_(ap->c_ctx[k]); scv[D + k] = siluf_(ap->c[k]); }
            __syncthreads();
            for (int it = bid; it < DEPTH * 64; it += G) {
                const int l = it / 64, cg = it % 64, col = cg * 192 + (lane < 48 ? lane : 0) * 4;
                const float* W = ap->w_mod + (size_t)l * D * 6 * D + col; f32x4 s0 = {0.f, 0.f, 0.f, 0.f}, s1 = {0.f, 0.f, 0.f, 0.f};
#pragma unroll 16
                for (int k = wave * 256; k < wave * 256 + 256; ++k) { const f32x4 w = *(const f32x4*)(W + (size_t)k * 6 * D); s0 += w * scv[k]; s1 += w * scv[D + k]; }
                if (lane < 48) { *(LAS f32x4*)(red + (wave * 2 + 0) * 192 + lane * 4) = s0; *(LAS f32x4*)(red + (wave * 2 + 1) * 192 + lane * 4) = s1; }
                __syncthreads();
                if (tid < 384) { const int ty = tid / 192, cc = tid % 192; float s = ap->b_mod[(size_t)l * 6 * D + cg * 192 + cc];
#pragma unroll
                  for (int w = 0; w < 8; ++w) s += red[(w * 2 + ty) * 192 + cc];
                  MOD[((size_t)l * 2 + ty) * 6 * D + cg * 192 + cc] = s; }
                __syncthreads();
            }
        }
        __syncthreads();
        {
            LAS float* L = (LAS float*)lds; LAS float* pwr = L; LAS float* pwi = L + 2176; LAS float* bbr = L + 4352; LAS float* bbi = L + 6400; LAS float* ccr = L + 8448; LAS float* cci = L + 10496; LAS float* ktab = L + 12544;
            for (int task = bid; task < DEPTH * S5G; task += G) {
                const int l = task / S5G, g = task % S5G;
                if (tid < 128) { const int d = tid >> 6, p = tid & 63; const size_t pb = (((size_t)l * 2 + d) * S5G + g) * S5P + p;
                    const float lre = ap->s5_lam_re[pb], lim = ap->s5_lam_im[pb], st = __expf(ap->s5_log_step[pb]);
                    const float ea = __expf(lre * st), th = lim * st, cs = cosf(th), sn = sinf(th), lr = ea * cs, li = ea * sn;
                    const float sh = sinf(0.5f * th), m1r = expm1f(lre * st) * cs - 2.f * sh * sh, m1i = li;
                    const float dn = 1.f / (lre * lre + lim * lim), cr = (m1r * lre + m1i * lim) * dn, ci = (m1i * lre - m1r * lim) * dn;
                    float pr = 1.f, pi = 0.f;
                    for (int j = 0; j <= 16; ++j) { pwr[(d * 17 + j) * 64 + p] = pr; pwi[(d * 17 + j) * 64 + p] = pi; const float nr = pr * lr - pi * li, ni = pr * li + pi * lr; if (j < 16) { pr = nr; pi = ni; } }
                    float ar = pr, ai = pi;
                    for (int q = 0; q < 4; ++q) { const float nr = ar * ar - ai * ai, ni = 2.f * ar * ai; ar = nr; ai = ni; }
                    ((f32x4*)(ws + WS_LAMP))[(((size_t)l * S5G + g) * 2 + d) * 64 + p] = (f32x4){pr, pi, ar, ai};
                    for (int c = 0; c < 16; ++c) { const float br = ap->s5_b_re[pb * 16 + c], bi = ap->s5_b_im[pb * 16 + c]; bbr[(d * 64 + p) * 16 + c] = cr * br - ci * bi; bbi[(d * 64 + p) * 16 + c] = cr * bi + ci * br;
                        const size_t cb = ((((size_t)l * 2 + d) * S5G + g) * S5CH + c) * S5P + p; ccr[(d * 16 + c) * 64 + p] = ap->s5_c_re[cb]; cci[(d * 16 + c) * 64 + p] = ap->s5_c_im[cb]; } }
                __syncthreads();
                { const int d = tid >> 8, j = (tid >> 4) & 15, c = tid & 15; float sacc[16];
#pragma unroll
                  for (int cp = 0; cp < 16; ++cp) sacc[cp] = 0.f;
                  for (int p = 0; p < 64; ++p) { const float xr = ccr[(d * 16 + c) * 64 + p], xi = cci[(d * 16 + c) * 64 + p], yr = pwr[(d * 17 + j) * 64 + p], yi = pwi[(d * 17 + j) * 64 + p];
                      const float zr = xr * yr - xi * yi, zi = xr * yi + xi * yr; const LAS float* br = bbr + (d * 64 + p) * 16; const LAS float* bi = bbi + (d * 64 + p) * 16;
#pragma unroll
                      for (int cp = 0; cp < 16; ++cp) sacc[cp] += zr * br[cp] - zi * bi[cp]; }
#pragma unroll
                  for (int cp = 0; cp < 16; ++cp) ktab[((d * 16 + j) * 16 + c) * 16 + cp] = sacc[cp]; }
                __syncthreads();
                bf16* FC = (bf16*)(ws + WS_FC) + ((size_t)l * S5G + g) * 65536; bf16* WC = (bf16*)(ws + WS_WC) + ((size_t)l * S5G + g) * 131072; const float* dsk = ap->s5_d + (size_t)l * S5W + g * 16;
                for (int idx = tid; idx < 8192; idx += NTHR) { const int n = idx >> 5, k0 = (idx & 31) * 8, d = n >> 7, p = (n >> 1) & 63, ri = n & 1, sI = k0 >> 4, c0 = k0 & 15, e = d == 0 ? 15 - sI : sI;
                    const float yr = pwr[(d * 17 + e) * 64 + p], yi = pwi[(d * 17 + e) * 64 + p]; float o[8];
#pragma unroll
                    for (int i = 0; i < 8; ++i) { const float br = bbr[(d * 64 + p) * 16 + c0 + i], bi = bbi[(d * 64 + p) * 16 + c0 + i]; o[i] = ri == 0 ? yr * br - yi * bi : yr * bi + yi * br; }
                    v4u w; w.x = pk2(o[0], o[1]); w.y = pk2(o[2], o[3]); w.z = pk2(o[4], o[5]); w.w = pk2(o[6], o[7]); *(v4u*)(FC + (size_t)n * 256 + k0) = w; }
                for (int idx = tid; idx < 16384; idx += NTHR) { const int n = idx >> 6, k0 = (idx & 63) * 8, t = n >> 4, c = n & 15; float o[8];
                    if (k0 < 256) { const int sI = k0 >> 4, c0 = k0 & 15;
#pragma unroll
                        for (int i = 0; i < 8; ++i) { float v = 0.f; if (sI <= t) v += ktab[((0 * 16 + (t - sI)) * 16 + c) * 16 + c0 + i]; if (sI >= t) v += ktab[((1 * 16 + (sI - t)) * 16 + c) * 16 + c0 + i]; if (sI == t && c0 + i == c) v += dsk[c]; o[i] = v; }
                    } else { const int kk = k0 - 256, d = kk >> 7, p0 = (kk & 127) >> 1, mm = d == 0 ? t + 1 : 16 - t;
#pragma unroll
                        for (int i = 0; i < 4; ++i) { const int p = p0 + i; const float xr = ccr[(d * 16 + c) * 64 + p], xi = cci[(d * 16 + c) * 64 + p], yr = pwr[(d * 17 + mm) * 64 + p], yi = pwi[(d * 17 + mm) * 64 + p];
                            o[2 * i] = xr * yr - xi * yi; o[2 * i + 1] = -(xr * yi + xi * yr); } }
                    v4u w; w.x = pk2(o[0], o[1]); w.y = pk2(o[2], o[3]); w.z = pk2(o[4], o[5]); w.w = pk2(o[6], o[7]); *(v4u*)(WC + (size_t)n * 512 + k0) = w; }
                __syncthreads();
            }
        }
        __syncthreads();
        if (bid < 128) convert_range(ap, ws, lds, wave, lane, 0, 0, 7000, bid * NWAVES + wave, 128 * NWAVES);
        else convert_range(ap, ws, lds, wave, lane, 0, 7000, I_L, (bid - 128) * NWAVES + wave, (G - 128) * NWAVES);
        TPW(12); GRID_BAR(); TP1(12);
    }

    const int plo = a.ph_lo, phi = a.ph_hi;
#define IN(k) (((PHMASK >> (k)) & 1) && plo <= (k) && (k) < phi)
    for (int l = a.l_lo; l < a.l_hi; ++l) {
#define wl (ws + WS_W + (size_t)l * WL_STRIDE)
#define modc (MOD + ((size_t)l * 2 + 0) * 6 * D)
#define modx (MOD + ((size_t)l * 2 + 1) * 6 * D)
#define NORM_PHASE(gvec, SH, SC, NPART, PCOND, PARTP, GATEP, SRCC, WB, SRCX) do { \
            for (int r = bid; r < CTXL; r += G) {     \
                const int c0 = wave * 256 + lane * 4; f32x4* xp = (f32x4*)(XR + (size_t)r * D + c0); f32x4 v = *(const f32x4*)((SRCC) + (size_t)r * D + c0); \
                if (PCOND) { f32x4 pl[(NPART)]; _Pragma("unroll") for (int ks = 0; ks < (NPART); ++ks) pl[ks] = *(const f32x4*)((PARTP) + ((size_t)ks * 256 + r) * D + c0);     \
                    __builtin_amdgcn_sched_barrier(0); \
                    f32x4 s0 = {0.f, 0.f, 0.f, 0.f}; _Pragma("unroll") for (int ks = 0; ks < (NPART); ++ks) s0 += pl[ks]; \
                    v += s0 * *(const f32x4*)((GATEP) + c0); } \
                if ((PCOND) || (WB)) *xp = v; \
                const float ps = wave_sum((v.x * v.x + v.y * v.y) + (v.z * v.z + v.w * v.w)); LAS float* red = (LAS float*)lds; if (lane == 0) red[wave] = ps; __syncthreads(); \
                float tot = 0.f; _Pragma("unroll") for (int w = 0; w < 8; ++w) tot += red[w]; const float rstd = 1.f / sqrtf(tot * (1.f / D) + EPS); \
                const f32x4 gg = *(const f32x4*)((gvec) + c0), sc = *(const f32x4*)(modc + (SC) * D + c0), sh = *(const f32x4*)(modc + (SH) * D + c0); \
                const f32x4 o = v * rstd * gg * (sc + 1.f) + sh; v2u w; w.x = pk2(o.x, o.y); w.y = pk2(o.z, o.w); *(v2u*)(HN + (size_t)r * D + c0) = w; __syncthreads(); } \
            { int r = CTXL + gw; f32x4 vn[8], ma[8], mb[8];     \
              _Pragma("unroll") for (int j = 0; j < 8; ++j) { const int c0 = lane * 4 + 256 * j; ma[j] = *(const f32x4*)((gvec) + c0) * (*(const f32x4*)(modx + (SC) * D + c0) + 1.f); mb[j] = *(const f32x4*)(modx + (SH) * D + c0); } \
              { const f32x4* xr = (const f32x4*)((SRCX) + (size_t)(r < R ? r : R - 1) * D) + lane; _Pragma("unroll") for (int j = 0; j < 8; ++j) vn[j] = xr[64 * j]; } \
              for (; r < R; r += NGW) { f32x4 v[8]; float ss = 0.f; _Pragma("unroll") for (int j = 0; j < 8; ++j) v[j] = vn[j];     \
                { const f32x4* xr = (const f32x4*)((SRCX) + (size_t)(r + NGW < R ? r + NGW : R - 1) * D) + lane; _Pragma("unroll") for (int j = 0; j < 8; ++j) vn[j] = xr[64 * j]; } \
                _Pragma("unroll") for (int j = 0; j < 8; ++j) ss += (v[j].x * v[j].x + v[j].y * v[j].y) + (v[j].z * v[j].z + v[j].w * v[j].w); \
                const float rstd = 1.f / sqrtf(wave_sum(ss) * (1.f / D) + EPS); \
                _Pragma("unroll") for (int j = 0; j < 8; ++j) { const int c0 = lane * 4 + 256 * j; \
                    const f32x4 o = v[j] * rstd * ma[j] + mb[j]; v2u w; w.x = pk2(o.x, o.y); w.y = pk2(o.z, o.w); *(v2u*)(HN + (size_t)r * D + c0) = w; } } } } while (0)
        if (IN(0)) { TP0(0) PH_IDS const float* g1n = ap->norm1_g + (size_t)l * D; const float* pg0 = MOD + ((size_t)(l > 0 ? l - 1 : 0) * 2 + 0) * 6 * D + 5 * D; const float* srcc = l == 0 ? ap->ctx : (const float*)XR; const float* srcx = l == 0 ? ap->x - (size_t)CTXL * D : (const float*)XR;     NORM_PHASE(g1n, 0, 1, DFF / 256, l > 0, HML + (size_t)8 * 256 * D, pg0, srcc, l == 0, srcx); TPW(0); GRID_BAR(); TP1(0); }

        if (IN(1)) { TP0(1) PH_WS
            pg8::Gemm g{HN, (const bf16*)(wl + WL_IN), D, D, D}; pg8::StaticOrder S; S.init(NPAN, NIN / 256, G, bid);
            EpiWin E{ap->b_in + (size_t)l * INW, U, CG, (bf16*)(ws + WS_SQ), Kb, (bf16*)(ws + WS_KT), (bf16*)(ws + WS_VC), Ob, GATES};
            pg8::gemm_phase<EpiWin, pg8::StaticOrder, false, true>(lds, g, S, E, wave0);
            TPW(1); GRID_BAR(); TP1(1);
        }

        if (IN(2)) { TP0(2) PH_IDS
            { pg8::Gemm g{U, (const bf16*)(ws + WS_FC) + (size_t)l * S5G * 65536, UPITCH, 256, 256}; BatchOrder S{S5G * 3, G, (bid + 96) % G, 3};
              EpiBf16T E{(bf16*)(ws + WS_EB), 65536, 256};
              pg8::gemm_phase<EpiBf16T, BatchOrder, true, true>(lds, g, S, E, wave0); }
            {
                LAS float* wsl = (LAS float*)(lds + 65536);
                float* BC = (float*)(ws + WS_BC); float* CS = (float*)(ws + WS_CS); float* DN = (float*)(ws + WS_DN); float* AT = (float*)(ws + WS_AT);
                for (int task = (bid + 128) % G; task < 2 * MLH * NCH; task += G) {
                    const int d = task / (MLH * NCH), h = (task / NCH) % MLH, c = task % NCH, dh = d * 4 + h;
                    if (wave == 0) { float lf[4], li[4], b[4]; float run = 0.f;
#pragma unroll
                        for (int j = 0; j < 4; ++j) { const int tp = lane * 4 + j, rr = c * 256 + (d ? 255 - tp : tp); const float gf = GATES[(size_t)rr * 16 + d * 8 + 4 + h]; li[j] = GATES[(size_t)rr * 16 + d * 8 + h];
                            lf[j] = fminf(gf, 0.f) - log1pf(__expf(-fabsf(gf))); run += lf[j]; b[j] = run; }
                        float inc = run;
#pragma unroll
                        for (int o = 1; o < 64; o <<= 1) { const float v = __shfl_up(inc, o); if (lane >= o) inc += v; }
                        const float excl = inc - run, btot = __shfl(inc, 63);
#pragma unroll
                        for (int j = 0; j < 4; ++j) { const int tp = lane * 4 + j, ir = d ? 255 - tp : tp; const float bb = b[j] + excl;
                            BC[(size_t)dh * R + c * 256 + ir] = bb; CS[(size_t)dh * R + c * 256 + ir] = __expf(li[j] - bb); wsl[ir] = __expf(btot - bb + li[j]); }
                        if (lane == 0) AT[dh * NCH + c] = __expf(btot); }
                    __syncthreads();
                    const bf16* kt = (const bf16*)(ws + WS_KT) + (size_t)(h * NCH + c) * 65536; bf16* ktw = (bf16*)(ws + WS_KTW) + (size_t)(dh * NCH + c) * 65536;
                    v4u kvs[16];
#pragma unroll
                    for (int i = 0; i < 16; ++i) { const int idx = tid + NTHR * i; kvs[i] = *(const v4u*)(kt + (size_t)(idx >> 5) * 256 + (idx & 31) * 8); }
                    __builtin_amdgcn_sched_barrier(0);
#pragma unroll
                    for (int i = 0; i < 16; ++i) { const int idx = tid + NTHR * i, dk = idx >> 5, s0 = (idx & 31) * 8; const v4u kv = kvs[i];
                        const f32x4 w0 = *(const LAS f32x4*)(wsl + s0), w1 = *(const LAS f32x4*)(wsl + s0 + 4);
                        const float o0 = bflo(kv.x) * w0.x, o1 = bfhi(kv.x) * w0.y, o2 = bflo(kv.y) * w0.z, o3 = bfhi(kv.y) * w0.w, o4 = bflo(kv.z) * w1.x, o5 = bfhi(kv.z) * w1.y, o6 = bflo(kv.w) * w1.z, o7 = bfhi(kv.w) * w1.w;
                        v4u w; w.x = pk2(o0, o1); w.y = pk2(o2, o3); w.z = pk2(o4, o5); w.w = pk2(o6, o7); *(v4u*)(ktw + (size_t)dk * 256 + s0) = w;
                        float rs = ((o0 + o1) + (o2 + o3)) + ((o4 + o5) + (o6 + o7));
#pragma unroll
                        for (int o = 1; o < 32; o <<= 1) rs += __shfl_xor(rs, o);
                        if ((lane & 31) == 0) DN[(size_t)(dh * NCH + c) * 256 + dk] = rs; }
                    __syncthreads();
                }
            }
#if MLDBG
            {
                LAS float* red = (LAS float*)(lds + 65536 + 4096);
                float* HREF = (float*)(ws + WS_END); float* DREF = HREF + (size_t)2 * R * MLW;
                const bf16* SQd = (const bf16*)(ws + WS_SQ); const bf16* VCd = (const bf16*)(ws + WS_VC);
                for (int un = bid; un < 256; un += G) {
                    const int h = un >> 6, d = (un >> 5) & 1, sl = un & 31, dk = tid & 255, hf = tid >> 8, dv0 = sl * 8 + hf * 4;
                    float C0 = 0.f, C1 = 0.f, C2 = 0.f, C3 = 0.f, nn = 0.f;
                    for (int tau = 0; tau < R; ++tau) {
                        const int r = tau_row(d, tau), c = r >> 8, t = r & 255;
                        const float q = bf2f(SQd[((size_t)(h * NCH + c) * 256 + t) * 512 + 256 + dk]), k = bf2f(Kb[((size_t)h * R + r) * 256 + dk]);
                        const bf16* vp = VCd + ((size_t)(h * NCH + c) * 256 + dv0) * 512 + t; const float v0 = bf2f(vp[0]), v1 = bf2f(vp[512]), v2 = bf2f(vp[1024]), v3 = bf2f(vp[1536]);
                        const float gi = GATES[(size_t)r * 16 + d * 8 + h], gf = GATES[(size_t)r * 16 + d * 8 + 4 + h];
                        const float f = sigmoidf_(gf), ik = __expf(gi) * k;
                        C0 = f * C0 + ik * v0; C1 = f * C1 + ik * v1; C2 = f * C2 + ik * v2; C3 = f * C3 + ik * v3; nn = f * nn + ik;
                        const float s0 = wave_sum(q * C0), s1 = wave_sum(q * C1), s2 = wave_sum(q * C2), s3 = wave_sum(q * C3), s4 = wave_sum(q * nn);
                        LAS float* rb = red + (tau & 1) * 40 + wave * 5;
                        if (lane == 0) { rb[0] = s0; rb[1] = s1; rb[2] = s2; rb[3] = s3; rb[4] = s4; }
                        __syncthreads();
                        if (tid < 8) { const int h2 = tid >> 2, j = tid & 3; const LAS float* rr = red + (tau & 1) * 40 + h2 * 20; const float num = rr[j] + rr[5 + j] + rr[10 + j] + rr[15 + j], den = rr[4] + rr[9] + rr[14] + rr[19];
                            HREF[((size_t)d * R + r) * MLW + h * 256 + sl * 8 + h2 * 4 + j] = num / fmaxf(fabsf(den), 1.f); if (sl == 0 && tid == 0) DREF[((size_t)d * R + r) * 4 + h] = den; }
                    }
                    __syncthreads();
                }
            }
#endif
            {
                LAS float* part = (LAS float*)(lds + 98304);
                LAS float* stat = part + 512;
                const int ch = tid; float wv[CONVK];
#pragma unroll
                for (int j = 0; j < CONVK; ++j) wv[j] = ap->conv_dw_w[((size_t)l * CONVK + j) * CONVW + ch];
                const float dwb = ap->conv_dw_b[(size_t)l * CONVW + ch], lg = ap->conv_ln_g[(size_t)l * CONVW + ch], lb = ap->conv_ln_b[(size_t)l * CONVW + ch];
                for (int tk = bid; tk < 264; tk += G) { const int un = tk >> 1;
                    const int row0 = un < 4 ? 0 : CTXL + (un - 4) * 64, u0 = un < 4 ? un * 64 : 0, len = un < 4 ? CTXL : 64;
                    { const int hf = tk & 1; const int p0 = u0 + hf * 32 - CONVK / 2;
                        {
                            LAS v4u* tile = (LAS v4u*)lds;
                            v4u tv[8];
#pragma unroll
                            for (int i = 0; i < 8; ++i) { const int id = tid + NTHR * i, rw = id >> 6, p = p0 + rw, pc = p < 0 ? 0 : (p >= len ? len - 1 : p);
                                tv[i] = *(const v4u*)(CG + (size_t)(row0 + pc) * CONVW + (id & 63) * 8); if (p < 0 || p >= len) tv[i] = (v4u){0u, 0u, 0u, 0u}; }
#pragma unroll
                            for (int i = 0; i < 8; ++i) { const int id = tid + NTHR * i; if (id < 62 * 64) tile[id] = tv[i]; }
                            __syncthreads();
                        }
                        float xw[62];
#pragma unroll
                        for (int k = 0; k < 62; ++k) xw[k] = bf2f(((const LAS unsigned short*)lds)[k * CONVW + ch]);
                        float y[32], q[32];
#pragma unroll
                        for (int i = 0; i < 32; ++i) { float acc = dwb;
#pragma unroll
                            for (int j = 0; j < CONVK; ++j) acc += wv[j] * xw[i + j];
                            y[i] = acc; q[i] = acc; }
                        float sq[32];
#pragma unroll
                        for (int i = 0; i < 32; ++i) sq[i] = y[i] * y[i];
#define CONV_FOLD(n, msk) { const bool hb = (lane & (msk)) != 0; _Pragma("unroll") for (int i = 0; i < (n) / 2; ++i) { \
                            const float s1 = hb ? q[i] : q[i + (n) / 2], k1 = hb ? q[i + (n) / 2] : q[i]; q[i] = k1 + __shfl_xor(s1, (msk)); \
                            const float s2 = hb ? sq[i] : sq[i + (n) / 2], k2 = hb ? sq[i + (n) / 2] : sq[i]; sq[i] = k2 + __shfl_xor(s2, (msk)); } }
                        CONV_FOLD(32, 32) CONV_FOLD(16, 16) CONV_FOLD(8, 8) CONV_FOLD(4, 4) CONV_FOLD(2, 2)
#undef CONV_FOLD
                        const float ts = q[0] + __shfl_xor(q[0], 1), tq = sq[0] + __shfl_xor(sq[0], 1);
                        if ((lane & 1) == 0) { part[(wave * 32 + (lane >> 1)) * 2] = ts; part[(wave * 32 + (lane >> 1)) * 2 + 1] = tq; }
                        __syncthreads();
                        if (tid < 32) { float a1 = 0.f, a2 = 0.f;
#pragma unroll
                            for (int w = 0; w < 8; ++w) { a1 += part[(w * 32 + tid) * 2]; a2 += part[(w * 32 + tid) * 2 + 1]; }
                            const float mean = a1 * (1.f / CONVW), var = fmaxf(a2 * (1.f / CONVW) - mean * mean, 0.f); stat[tid * 2] = mean; stat[tid * 2 + 1] = 1.f / sqrtf(var + LN_EPS); }
                        __syncthreads();
#pragma unroll
                        for (int i = 0; i < 32; ++i) { const float o = (y[i] - stat[2 * i]) * stat[2 * i + 1] * lg + lb;
                            ((unsigned short*)MIX)[(size_t)(row0 + u0 + hf * 32 + i) * D + S5W + ch] = (unsigned short)f2bf(siluf_(o)); }
                        __syncthreads();
                    }
                }
            }
            TPW(2); GRID_BAR(); TP1(2);
        }

        if (IN(3)) { TP0(3) PH_IDS
            {
                const bf16* EB = (const bf16*)(ws + WS_EB); pg8::f32x2* ESC = (pg8::f32x2*)(ws + WS_ESC);
                for (int task = gw; task < S5G * 2 * NSC; task += NGW) { const int g = task / (2 * NSC), d = (task / NSC) & 1, sc = task % NSC;
                    const f32x4 lp = ((const f32x4*)(ws + WS_LAMP))[(((size_t)l * S5G + g) * 2 + d) * 64 + lane]; pg8::f32x2 e[16];
#pragma unroll
                    for (int j = 0; j < 16; ++j) { const int tc = sc * 16 + j, rc = d == 0 ? tc : (tc < CTXCK ? CTXCK - 1 - tc : NCK - 1 + CTXCK - tc); { const unsigned ew = *(const unsigned*)(EB + ((size_t)g * UROWS + rc) * 256 + d * 128 + 2 * lane); e[j] = (pg8::f32x2){bflo(ew), bfhi(ew)}; } }
                    __builtin_amdgcn_sched_barrier(0);
                    float hr = 0.f, hi = 0.f;
#pragma unroll
                    for (int j = 0; j < 16; ++j) { const float nr = lp.x * hr - lp.y * hi + e[j].x, ni = lp.x * hi + lp.y * hr + e[j].y; hr = nr; hi = ni; }
                    ESC[((size_t)(g * 2 + d) * NSC + sc) * 64 + lane] = (pg8::f32x2){hr, hi}; }
            }
            { pg8::Gemm g{(const bf16*)(ws + WS_SQ) + 256, Kb, 512, 256, 256}; BatchOrder S{MLH * NCH, G, bid, 0};
              EpiG1 E{(bf16*)(ws + WS_SQ), (const float*)(ws + WS_CS), (float*)(ws + WS_RSP)};
              pg8::gemm_phase<EpiG1, BatchOrder, true, true>(lds, g, S, E, wave0); }
            { pg8::Gemm g{(const bf16*)(ws + WS_VC), (const bf16*)(ws + WS_KTW), 512, 256, 256}; BatchOrder S{256, G, bid, 1};
              EpiBf16T E{(bf16*)(ws + WS_DC), 65536, 256};
              pg8::gemm_phase<EpiBf16T, BatchOrder, true, true>(lds, g, S, E, wave0); }
            TPW(3); GRID_BAR(); TP1(3);
        }

        if (IN(4)) { TP0(4) PH_IDS
            const bf16* DC = (const bf16*)(ws + WS_DC); const float* AT = (const float*)(ws + WS_AT); bf16* VC = (bf16*)(ws + WS_VC);
            for (int b = bid; b < 256; b += G) {
                const int dh = b >> 5, d = dh >> 2, part = b & 31, dv = part * 8 + (tid >> 6), dk0 = (tid & 63) * 4; const bool nt_ = part == 0 && tid < 256;
                f32x4 C = {0.f, 0.f, 0.f, 0.f}; float nn = 0.f;
                *(v2u*)(VC + ((size_t)(dh * NCH) * 256 + dv) * 512 + 256 + dk0) = (v2u){0u, 0u};
                if (nt_) ((float*)(ws + WS_NIN))[(size_t)(dh * NCH) * 256 + tid] = 0.f;
#define SCAN_CH(st) (d == 0 ? (st) : ((st) == 0 ? 0 : NCH - (st)))
                for (int st0 = 0; st0 < NCH - 1; st0 += 4) { v2u dcw[4]; float A4[4], dn4[4];
#pragma unroll
                    for (int i = 0; i < 4; ++i) { const int c = SCAN_CH(st0 + i); dcw[i] = *(const v2u*)(DC + ((size_t)(dh * NCH + c) * 256 + dv) * 256 + dk0); A4[i] = AT[dh * NCH + c];
                        dn4[i] = ((const float*)(ws + WS_DN))[(size_t)(dh * NCH + c) * 256 + (tid & 255)]; }
                    __builtin_amdgcn_sched_barrier(0);
#pragma unroll
                    for (int i = 0; i < 4; ++i) { const int cn = SCAN_CH(st0 + i + 1); const f32x4 dc = {bflo(dcw[i].x), bfhi(dcw[i].x), bflo(dcw[i].y), bfhi(dcw[i].y)};
                        C = C * A4[i] + dc; v2u w; w.x = pk2(C.x, C.y); w.y = pk2(C.z, C.w);
                        *(v2u*)(VC + ((size_t)(dh * NCH + cn) * 256 + dv) * 512 + 256 + dk0) = w;
                        if (nt_) { nn = nn * A4[i] + dn4[i]; ((float*)(ws + WS_NIN))[(size_t)(dh * NCH + cn) * 256 + tid] = nn; } } }
#undef SCAN_CH
            }
            {
                const bf16* EB = (const bf16*)(ws + WS_EB); const pg8::f32x2* ESC = (const pg8::f32x2*)(ws + WS_ESC);
                for (int task = gw; task < S5G * 2 * NSC; task += NGW) { const int g = task / (2 * NSC), d = (task / NSC) & 1, sc = task % NSC;
                    const f32x4 lp = ((const f32x4*)(ws + WS_LAMP))[(((size_t)l * S5G + g) * 2 + d) * 64 + lane]; pg8::f32x2 e[16];
#pragma unroll
                    for (int j = 0; j < 16; ++j) { const int tc = sc * 16 + j, rc = d == 0 ? tc : (tc < CTXCK ? CTXCK - 1 - tc : NCK - 1 + CTXCK - tc); { const unsigned ew = *(const unsigned*)(EB + ((size_t)g * UROWS + rc) * 256 + d * 128 + 2 * lane); e[j] = (pg8::f32x2){bflo(ew), bfhi(ew)}; } }
                    __builtin_amdgcn_sched_barrier(0);
                    float hr = 0.f, hi = 0.f;
                    for (int s2 = 0; s2 < sc; ++s2) { const pg8::f32x2 es = ESC[((size_t)(g * 2 + d) * NSC + s2) * 64 + lane]; const float nr = lp.z * hr - lp.w * hi + es.x, ni = lp.z * hi + lp.w * hr + es.y; hr = nr; hi = ni; }
#pragma unroll
                    for (int j = 0; j < 16; ++j) { const int tc = sc * 16 + j, rc = d == 0 ? tc : (tc < CTXCK ? CTXCK - 1 - tc : NCK - 1 + CTXCK - tc);
                        *(unsigned*)(U + ((size_t)g * UROWS + rc) * UPITCH + 256 + d * 128 + 2 * lane) = pk2(hr, hi);
                        const float nr = lp.x * hr - lp.y * hi + e[j].x, ni = lp.x * hi + lp.y * hr + e[j].y; hr = nr; hi = ni; } }
            }
            TPW(4); GRID_BAR(); TP1(4);
        }

        if (IN(5)) { TP0(5) PH_WS
            pg8::Gemm g{(const bf16*)(ws + WS_SQ), (const bf16*)(ws + WS_VC), 512, 512, 512}; BatchOrder S{2 * MLH * NCH, G, bid, 2};
            EpiG3 E{(bf16*)(ws + WS_HML)};
            pg8::gemm_phase<EpiG3, BatchOrder, true, true>(lds, g, S, E, wave0);
            { pg8::Gemm g2{U, (const bf16*)(ws + WS_WC) + (size_t)l * S5G * 131072, UPITCH, 512, 512}; BatchOrder S2{S5G * 3, G, (bid + 96) % G, 3};
              EpiS5Y E2{S5Gb};
              pg8::gemm_phase<EpiS5Y, BatchOrder, true, true>(lds, g2, S2, E2, wave0); }
            TPW(5); GRID_BAR(); TP1(5);
        }

        if (IN(6)) { TP0(6) PH_IDS
            if (bid < 66) {
                pg8::Gemm g{S5Gb, (const bf16*)(wl + WL_GLU), S5W, S5W, S5W}; pg8::StaticOrder S; S.init(NPAN, S5W / 256, 66, bid);
                EpiGlu E{S5Gb, ap->s5_b_glu + (size_t)l * S5W, MIX};
                pg8::gemm_phase<EpiGlu, pg8::StaticOrder, true, true>(lds, g, S, E, wave0);
            } else {
                const float* ng = ap->ml_norm_g + (size_t)l * MLW;
                const float* BC = (const float*)(ws + WS_BC); const float* RSP = (const float*)(ws + WS_RSP); const float* NIN = (const float*)(ws + WS_NIN); const bf16* SQ = (const bf16*)(ws + WS_SQ); const bf16* HMB = (const bf16*)(ws + WS_HML);
                for (int r = (bid - 66) * NWAVES + wave; r < R; r += (G - 66) * NWAVES) { const int c = r >> 8, t = r & 255;
                    v2u qw[4], ow[4], hw[2][4]; f32x4 n4[2][4], rp[2][4], gg[4]; float bc[2][4];
#pragma unroll
                    for (int h = 0; h < 4; ++h) { qw[h] = *(const v2u*)(SQ + ((size_t)(h * NCH + c) * 256 + t) * 512 + 256 + lane * 4); ow[h] = *(const v2u*)(Ob + (size_t)r * MLW + h * 256 + lane * 4); gg[h] = *(const f32x4*)(ng + h * 256 + lane * 4);
#pragma unroll
                        for (int d = 0; d < 2; ++d) { const int dh = d * 4 + h; n4[d][h] = *(const f32x4*)(NIN + (size_t)(dh * NCH + c) * 256 + lane * 4); rp[d][h] = *(const f32x4*)(RSP + ((size_t)dh * R + r) * 4); bc[d][h] = BC[(size_t)dh * R + r];
                            hw[d][h] = *(const v2u*)(HMB + ((size_t)d * R + r) * MLW + h * 256 + lane * 4); } }
                    __builtin_amdgcn_sched_barrier(0);
                    float qn[2][4];
#pragma unroll
                    for (int h = 0; h < 4; ++h) { const f32x4 q = {bflo(qw[h].x), bfhi(qw[h].x), bflo(qw[h].y), bfhi(qw[h].y)};
#pragma unroll
                        for (int d = 0; d < 2; ++d) qn[d][h] = (q.x * n4[d][h].x + q.y * n4[d][h].y) + (q.z * n4[d][h].z + q.w * n4[d][h].w); }
#pragma unroll
                    for (int d = 0; d < 2; ++d)
#pragma unroll
                        for (int h = 0; h < 4; ++h) qn[d][h] = wave_sum(qn[d][h]);
                    f32x4 v[4]; float mean[4], var[4];
#pragma unroll
                    for (int h = 0; h < 4; ++h) { v[h] = (f32x4){0.f, 0.f, 0.f, 0.f};
#pragma unroll
                        for (int d = 0; d < 2; ++d) { const float aa = __expf(bc[d][h]), den = aa * ((rp[d][h].x + rp[d][h].y) + (rp[d][h].z + rp[d][h].w) + qn[d][h]), scl = aa / fmaxf(fabsf(den), 1.f);
                            v[h] += (f32x4){bflo(hw[d][h].x), bfhi(hw[d][h].x), bflo(hw[d][h].y), bfhi(hw[d][h].y)} * scl; }
                        mean[h] = (v[h].x + v[h].y) + (v[h].z + v[h].w); }
#pragma unroll
                    for (int h = 0; h < 4; ++h) mean[h] = wave_sum(mean[h]) * (1.f / 256.f);
#pragma unroll
                    for (int h = 0; h < 4; ++h) { v[h] = v[h] - mean[h]; var[h] = (v[h].x * v[h].x + v[h].y * v[h].y) + (v[h].z * v[h].z + v[h].w * v[h].w); }
#pragma unroll
                    for (int h = 0; h < 4; ++h) var[h] = wave_sum(var[h]) * (1.f / 256.f);
#pragma unroll
                    for (int h = 0; h < 4; ++h) { const float rstd = 1.f / sqrtf(var[h] + LN_EPS);
                        const f32x4 o = {sigmoidf_(bflo(ow[h].x)) * v[h].x * rstd * gg[h].x, sigmoidf_(bfhi(ow[h].x)) * v[h].y * rstd * gg[h].y, sigmoidf_(bflo(ow[h].y)) * v[h].z * rstd * gg[h].z, sigmoidf_(bfhi(ow[h].y)) * v[h].w * rstd * gg[h].w};
                        v2u w; w.x = pk2(o.x, o.y); w.y = pk2(o.z, o.w); *(v2u*)(MIX + (size_t)r * D + 1024 + h * 256 + lane * 4) = w; } }
            }
            TPW(6); GRID_BAR(); TP1(6);
        }

        if (IN(8)) { TP0(8) PH_WS
            { pg8::Gemm g{MIX, (const bf16*)(wl + WL_OUT), D, D, D}; pg8::StaticOrder S; S.init(NPAN - 1, D / 256, G, bid, 1);
              EpiRes E{XR, modc + 2 * D, modx + 2 * D, l == 0 ? ap->x - (size_t)CTXL * D : (const float*)XR};
              pg8::gemm_phase<EpiRes, pg8::StaticOrder, true, true>(lds, g, S, E, wave0); }
            if (l < DEPTH - 1) { pg8::Gemm g{MIX, (const bf16*)(wl + WL_OUT), D, D, 256}; BatchOrder S{8 * (D / 256), G, bid, 4};
              EpiPart E{HML};
              pg8::gemm_phase<EpiPart, BatchOrder, true, true>(lds, g, S, E, wave0); }
            if (l < DEPTH - 1 && bid >= 64) { int lane; asm volatile("v_mbcnt_lo_u32_b32 %0, -1, 0\n\tv_mbcnt_hi_u32_b32 %0, -1, %0" : "=v"(lane)); convert_range(ap, ws, lds, wave0, lane, l + 1, CV_B0, CV_B1, (bid - 64) * NWAVES + wave0, (G - 64) * NWAVES); }
            TPW(8); GRID_BAR(); TP1(8);
        }

        if (IN(9)) { TP0(9) PH_IDS const float* g2n = ap->norm2_g + (size_t)l * D; NORM_PHASE(g2n, 3, 4, D / 256, l < DEPTH - 1, HML, modc + 2 * D, XR, false, XR); TPW(9); GRID_BAR(); TP1(9); }

        if (IN(10)) { TP0(10) PH_WS
            pg8::Gemm g{HN, (const bf16*)(wl + WL_FI), D, D, D}; pg8::StaticOrder S; S.init(NPAN, 2 * DFF / 256, G, bid);
            EpiSwiglu E{HFF};
            pg8::gemm_phase<EpiSwiglu, pg8::StaticOrder, false, true>(lds, g, S, E, wave0);
            if (l < DEPTH - 1 && bid >= 172) { int lane; asm volatile("v_mbcnt_lo_u32_b32 %0, -1, 0\n\tv_mbcnt_hi_u32_b32 %0, -1, %0" : "=v"(lane)); convert_range(ap, ws, lds, wave0, lane, l + 1, CV_A0, CV_A1, (bid - 172) * NWAVES + wave0, (G - 172) * NWAVES); }
            TPW(10); GRID_BAR(); TP1(10);
        }

        if (IN(11)) { TP0(11) PH_WS
            { pg8::Gemm g{HFF, (const bf16*)(wl + WL_FO), DFF, DFF, DFF}; pg8::StaticOrder S; S.init(NPAN - 1, D / 256, G, bid, 1);
              EpiRes E{XR, modc + 5 * D, modx + 5 * D, XR};
              pg8::gemm_phase<EpiRes, pg8::StaticOrder, true, true>(lds, g, S, E, wave0); }
            if (l < DEPTH - 1) { pg8::Gemm g{HFF, (const bf16*)(wl + WL_FO), DFF, DFF, 256}; BatchOrder S{8 * (DFF / 256), G, bid, 4};
              EpiPart E{HML + (size_t)8 * 256 * D};
              pg8::gemm_phase<EpiPart, BatchOrder, true, true>(lds, g, S, E, wave0); }
            if (l < DEPTH - 1 && bid >= 176) { int lane; asm volatile("v_mbcnt_lo_u32_b32 %0, -1, 0\n\tv_mbcnt_hi_u32_b32 %0, -1, %0" : "=v"(lane)); convert_range(ap, ws, lds, wave0, lane, l + 1, CV_C0, CV_C1, (bid - 176) * NWAVES + wave0, (G - 176) * NWAVES); }
            TPW(11); GRID_BAR(); TP1(11);
        }
    }

    if (a.do_fin) { PH_IDS
#if MLDBG
        float Pdbg = 0.f;
        if (bid == 0 && tid == 0) { const float* cnt = (const float*)(ws + WS_CTL) + 8192;
            for (int k = 0; k < 6; ++k) { const float e = __hip_atomic_load(cnt + 2 * k, __ATOMIC_RELAXED, __HIP_MEMORY_SCOPE_AGENT), rr = __hip_atomic_load(cnt + 2 * k + 1, __ATOMIC_RELAXED, __HIP_MEMORY_SCOPE_AGENT); if (e > MLDBG_THR * MLDBG_THR * rr) Pdbg += (float)(1 << k); } }
#endif
        { int r = CTXL + gw; f32x4 vn[8]; f32x4 gf[8];
#pragma unroll
          for (int j = 0; j < 8; ++j) gf[j] = *(const f32x4*)(ap->norm_f_g + lane * 4 + 256 * j);
          { const f32x4* xr = (const f32x4*)(XR + (size_t)(r < R ? r : R - 1) * D) + lane;
#pragma unroll
              for (int j = 0; j < 8; ++j) vn[j] = xr[64 * j]; }
          for (; r < R; r += NGW) { f32x4 v[8]; float ss = 0.f;
#pragma unroll
            for (int j = 0; j < 8; ++j) v[j] = vn[j];
            { const f32x4* xr = (const f32x4*)(XR + (size_t)(r + NGW < R ? r + NGW : R - 1) * D) + lane;
#pragma unroll
                for (int j = 0; j < 8; ++j) vn[j] = xr[64 * j]; }
#pragma unroll
            for (int j = 0; j < 8; ++j) ss += (v[j].x * v[j].x + v[j].y * v[j].y) + (v[j].z * v[j].z + v[j].w * v[j].w);
            const float rstd = 1.f / sqrtf(wave_sum(ss) * (1.f / D) + EPS);
#pragma unroll
            for (int j = 0; j < 8; ++j) { const int c0 = lane * 4 + 256 * j; *(f32x4*)(ap->out + (size_t)(r - CTXL) * D + c0) = v[j] * rstd * gf[j]; } } }
#if MLDBG
        if (bid == 0 && tid == 0) { asm volatile("s_waitcnt vmcnt(0)" ::: "memory"); ap->out[0] += Pdbg; }
#endif
    }
    if (TPROBE != 0) { const unsigned long long te = __builtin_amdgcn_s_memrealtime(); while (__builtin_amdgcn_s_memrealtime() - te < (unsigned long long)TPMUL * tp_acc) __builtin_amdgcn_s_sleep(8); }
#undef IN
#undef NORM_PHASE
#undef GRID_BAR
}

extern "C" void kernel_launch(void* const* d_in, const int* in_sizes, int n_in, void* d_out, int out_size, void* d_ws, size_t ws_size, hipStream_t stream) {
    static int grid = 0;
    if (grid == 0) {
        if (n_in != 29 || in_sizes[0] != SEQ * D || out_size != SEQ * D || ws_size < WS_END) { fprintf(stderr, "kernel_launch: unexpected problem (n_in %d, in0 %d, out %d, ws %zu < %zu)\n", n_in, n_in > 0 ? in_sizes[0] : -1, out_size, ws_size, (size_t)WS_END); grid = -1; return; }
        int dev = 0, cus = 0, per_cu = 0;
        if (hipGetDevice(&dev) != hipSuccess || hipDeviceGetAttribute(&cus, hipDeviceAttributeMultiprocessorCount, dev) != hipSuccess) { grid = -1; return; }
        if (hipFuncSetAttribute((const void*)fwd, hipFuncAttributeMaxDynamicSharedMemorySize, LDS_BYTES) != hipSuccess) { fprintf(stderr, "kernel_launch: hipFuncSetAttribute failed\n"); grid = -1; return; }
        if (hipOccupancyMaxActiveBlocksPerMultiprocessor(&per_cu, (const void*)fwd, NTHR, LDS_BYTES) != hipSuccess || per_cu < 1) fprintf(stderr, "kernel_launch: occupancy query says %d\n", per_cu);
        (void)hipGetLastError();
        grid = cus;
    }
    if (grid < 0) return;
    (void)hipMemsetAsync((char*)d_ws + WS_CTL, 0, CTL_ZERO_BYTES, stream);
    Args a{};
    const float** pp = (const float**)&a;
    for (int i = 0; i < 29; ++i) pp[i] = (const float*)d_in[i];
    a.out = (float*)d_out; a.ws = (unsigned char*)d_ws;
#if MK_SINGLE
    a.l_lo = 0; a.l_hi = DEPTH; a.ph_lo = 0; a.ph_hi = NPH; a.do_pro = 1; a.do_fin = 1; a.use_bar = 1;
    hipLaunchKernelGGL(fwd, dim3(grid), dim3(NTHR), LDS_BYTES, stream, a);
#else
    a.use_bar = 0;
    a.l_lo = 0; a.l_hi = 0; a.ph_lo = 0; a.ph_hi = 0; a.do_pro = 1; a.do_fin = 0;
    hipLaunchKernelGGL(fwd, dim3(grid), dim3(NTHR), LDS_BYTES, stream, a);
    a.do_pro = 0;
    for (int l = 0; l < DEPTH; ++l) for (int p = 0; p < NPH; ++p) { a.l_lo = l; a.l_hi = l + 1; a.ph_lo = p; a.ph_hi = p + 1; hipLaunchKernelGGL(fwd, dim3(grid), dim3(NTHR), LDS_BYTES, stream, a); }
    a.l_lo = 0; a.l_hi = 0; a.ph_lo = 0; a.ph_hi = 0; a.do_fin = 1;
    hipLaunchKernelGGL(fwd, dim3(grid), dim3(NTHR), LDS_BYTES, stream, a);
#endif
}
```

```cpp
#include <hip/hip_runtime.h>
#include <cstdio>
#include <cstdint>

#ifndef PHMASK
#define PHMASK 0xfff
#endif
#ifndef PROMASK
#define PROMASK 1
#endif
#ifndef MLDBG
#define MLDBG 0
#endif
#ifndef MLDBG_THR
#define MLDBG_THR 0.03f
#endif
#ifndef TPROBE
#define TPROBE 0
#endif
#define TPMUL 9
#ifndef MK_SINGLE
#define MK_SINGLE 1
#endif

namespace pg8 {
#define PG8_LAS __attribute__((address_space(3)))
typedef unsigned short bf16_t;
typedef short bf16x8 __attribute__((ext_vector_type(8)));
typedef float f32x4 __attribute__((ext_vector_type(4)));
typedef float f32x2 __attribute__((ext_vector_type(2)));
typedef unsigned u32x4 __attribute__((ext_vector_type(4)));
constexpr int BM = 256, BK = 64, HALF = 128, HTB = HALF * BK * 2, STAGE_BYTES = 8 * HTB, NXCD = 8, WGM = 8;

__host__ __device__ __forceinline__ int lds_byte(int r, int c) { const int st = (r >> 4) * 2 + (c >> 5), rr = r & 15, cc = c & 31, ob = rr * 64 + cc * 2; return st * 1024 + (ob ^ (((ob >> 9) & 1) << 5)); }
__host__ __device__ __forceinline__ void stage_rc(int b, int& R, int& C) { const int st = b / 1024, sb = b % 1024, swz = sb ^ (((sb >> 9) & 1) << 5); R = (st >> 1) * 16 + swz / 64; C = (st & 1) * 32 + (swz % 64) / 2; }
__host__ __device__ __forceinline__ int perm32(int rho) { const int n = rho >> 4, i = rho & 15; return 8 * (i >> 2) + 4 * n + (i & 3); }

struct Unit { int pm, pn, ka, pm2, pn2; };
struct Gemm { const bf16_t* A; const bf16_t* Bt; int lda, ldb, K; const bf16_t* A2; const bf16_t* B2; };

struct StaticOrder {
    int nM, nN, nwg, G, c, pm0;
    __host__ __device__ void init(int nM_, int nN_, int G_, int c_, int pm0_ = 0) { nM = nM_; nN = nN_; nwg = nM * nN; G = G_; c = c_; pm0 = pm0_; }
    __host__ __device__ bool next(int i, Unit& u) const {
        const long L = (long)i * G + c; if (L >= nwg) return false;
        int wgid = (int)L; { const int q = nwg / NXCD, r = nwg % NXCD, xcd = wgid % NXCD, off = wgid / NXCD; wgid = (xcd < r ? xcd * (q + 1) : r * (q + 1) + (xcd - r) * q) + off; }
        const int nig = WGM * nN, gid = wgid / nig, fm = gid * WGM, gsz = (nM - fm) < WGM ? (nM - fm) : WGM;
        u.pm = pm0 + fm + ((wgid % nig) % gsz); u.pn = (wgid % nig) / gsz; u.ka = 0; u.pm2 = 0; u.pn2 = 0; return true;
    }
};

__device__ __forceinline__ unsigned cvt_pk_bf16(float lo, float hi) { unsigned r; asm volatile("v_cvt_pk_bf16_f32 %0, %1, %2" : "=v"(r) : "v"(lo), "v"(hi)); return r; }

template <class Epi, class Sched, bool ALIGN_EPI = false, bool SP2 = false, bool SEG2 = false>
__device__ __forceinline__ void gemm_phase(PG8_LAS unsigned char* lds, const Gemm g, const Sched& S, const Epi& E, const int wave_s) {
    int lane_o; asm volatile("v_mbcnt_lo_u32_b32 %0, -1, 0\n\tv_mbcnt_hi_u32_b32 %0, -1, %0" : "=v"(lane_o)); int tid_o = wave_s * 64 + lane_o;
    const int tid = tid_o, wid = __builtin_amdgcn_readfirstlane(tid >> 6), lane = tid & 63, wr = wid >> 2, wc = wid & 3, fr = lane & 15, fq = lane >> 4;
    const int K = g.K, nt = K / BK;
    unsigned voffA[2], voffB[2];
#pragma unroll
    for (int i = 0; i < 2; ++i) { int R, C; stage_rc(tid * 16 + i * 8192, R, C); const int Rb = Epi::PERM ? ((R & ~31) + perm32(R & 31)) : R;
        voffA[i] = (unsigned)(R * g.lda + C) * 2u; voffB[i] = (unsigned)(Rb * g.ldb + C) * 2u; }
    const size_t kstep = (size_t)(BK * 2);
    const size_t hstepA = (size_t)HALF * g.lda * 2, hstepB = (size_t)HALF * g.ldb * 2;
    const size_t tstepA = 2 * hstepA, tstepB = 2 * hstepB;
    const unsigned ldsw = (unsigned)wid * 1024u;
    const int aoff = lds_byte(wr * 64 + fr, fq * 8), boff = lds_byte(wc * 32 + fr, fq * 8);
#define PG8_SA(b, h) (((b) * 2 + (h)) * HTB)
#define PG8_SB(b, h) ((4 + (b) * 2 + (h)) * HTB)
#define PG8_STAGE(bufoff, gbase, voff) do { _Pragma("unroll") for (int _i = 0; _i < 2; ++_i) \
        __builtin_amdgcn_global_load_lds((const unsigned*)((const char*)(gbase) + (voff)[_i]), (PG8_LAS unsigned*)(lds + (bufoff) + ldsw + _i * 8192), 16, 0, 0); } while (0)
#define PG8_LDA(dst, b, h) do { _Pragma("unroll") for (int m = 0; m < 4; ++m) _Pragma("unroll") for (int k = 0; k < 2; ++k) dst[m][k] = *(const PG8_LAS bf16x8*)(lds + PG8_SA(b, h) + aoff + m * 2048 + k * 1024); } while (0)
#define PG8_LDB(dst, b, h) do { _Pragma("unroll") for (int n = 0; n < 2; ++n) _Pragma("unroll") for (int k = 0; k < 2; ++k) dst[n][k] = *(const PG8_LAS bf16x8*)(lds + PG8_SB(b, h) + boff + n * 2048 + k * 1024); } while (0)
#define PG8_MMA(ai, bj, At, Bt) do { __builtin_amdgcn_s_setprio(1); _Pragma("unroll") for (int m = 0; m < 4; ++m) _Pragma("unroll") for (int n = 0; n < 2; ++n) _Pragma("unroll") for (int k = 0; k < 2; ++k) \
        acc[ai][bj][m][n] = __builtin_amdgcn_mfma_f32_16x16x32_bf16(Bt[n][k], At[m][k], acc[ai][bj][m][n], 0, 0, 0); __builtin_amdgcn_s_setprio(0); } while (0)
#define PG8_WAIT_V(n) asm volatile("s_waitcnt vmcnt(" #n ")" ::: "memory")
#define PG8_WAIT_L(n) asm volatile("s_waitcnt lgkmcnt(" #n ")" ::: "memory")
#define PG8_BAR __builtin_amdgcn_s_barrier()
#define PG8_SCHED __builtin_amdgcn_sched_barrier(0)
    Unit cur, nxt; int ui = 0;
    if (!S.next(0, cur)) return;
    f32x4 acc[2][2][4][2];
#pragma unroll
    for (int a = 0; a < 2; ++a)
#pragma unroll
        for (int b = 0; b < 2; ++b)
#pragma unroll
            for (int m = 0; m < 4; ++m)
#pragma unroll
                for (int n = 0; n < 2; ++n) acc[a][b][m][n] = (f32x4){0.f, 0.f, 0.f, 0.f};
    bf16x8 At[4][2], B0[2][2], B1[2][2];
    const char* cA = (const char*)g.A + (size_t)cur.pm * tstepA + (size_t)cur.ka * 2; const char* cB = (const char*)g.Bt + (size_t)cur.pn * tstepB + (size_t)cur.ka * 2;
    const char* cA2 = SEG2 ? (const char*)g.A2 + (size_t)cur.pm2 * tstepA : cA; const char* cB2 = SEG2 ? (const char*)g.B2 + (size_t)cur.pn2 * tstepB : cB; const int nh = nt / 2;
#define PG8_KP(p1, p2, tt) (SEG2 ? ((tt) < nh ? (p1) + (size_t)(tt) * kstep : (p2) + (size_t)((tt) - nh) * kstep) : (p1) + (size_t)(tt) * kstep)
    if constexpr (SP2) {
        PG8_STAGE(PG8_SB(0, 0), cB, voffB); PG8_STAGE(PG8_SB(0, 1), cB + hstepB, voffB); PG8_STAGE(PG8_SA(0, 0), cA, voffA); PG8_STAGE(PG8_SA(0, 1), cA + hstepA, voffA);
        if (wr == 1) PG8_BAR;
        PG8_WAIT_V(2); PG8_BAR;
        PG8_STAGE(PG8_SB(1, 0), cB + kstep, voffB); PG8_STAGE(PG8_SA(1, 0), cA + kstep, voffA); PG8_STAGE(PG8_SB(1, 1), cB + hstepB + kstep, voffB);
        PG8_WAIT_V(6); PG8_BAR;
    } else {
        PG8_STAGE(PG8_SB(0, 0), cB, voffB); PG8_STAGE(PG8_SA(0, 0), cA, voffA); PG8_STAGE(PG8_SB(0, 1), cB + hstepB, voffB); PG8_STAGE(PG8_SA(0, 1), cA + hstepA, voffA);
        if (wr == 1) PG8_BAR;
        PG8_WAIT_V(4); PG8_BAR;
        PG8_STAGE(PG8_SB(1, 0), cB + kstep, voffB); PG8_STAGE(PG8_SA(1, 0), cA + kstep, voffA); PG8_STAGE(PG8_SB(1, 1), cB + hstepB + kstep, voffB);
        PG8_WAIT_V(6); PG8_BAR;
    }
    for (;;) {
        const bool has_next = S.next(ui + 1, nxt);
        const char* nA = has_next ? (const char*)g.A + (size_t)nxt.pm * tstepA + (size_t)nxt.ka * 2 : cA; const char* nB = has_next ? (const char*)g.Bt + (size_t)nxt.pn * tstepB + (size_t)nxt.ka * 2 : cB;
#pragma nounroll
        for (int t = 0; t < nt; t += 2) {
            const bool last = (t == nt - 2);
            const char* a1 = PG8_KP(cA, cA2, t + 1);
            const char* a2 = last ? nA : PG8_KP(cA, cA2, t + 2); const char* b2 = last ? nB : PG8_KP(cB, cB2, t + 2);
            const char* a3 = a2 + kstep; const char* b3 = b2 + kstep;
            if constexpr (SP2) {
            PG8_LDB(B0, 0, 0); PG8_LDB(B1, 0, 1); PG8_SCHED; PG8_LDA(At, 0, 0); PG8_STAGE(PG8_SA(1, 1), a1 + hstepA, voffA);
            PG8_WAIT_V(8); PG8_WAIT_L(0); PG8_BAR; PG8_MMA(0, 0, At, B0); PG8_MMA(0, 1, At, B1); PG8_BAR; PG8_SCHED;
            PG8_LDA(At, 0, 1); PG8_STAGE(PG8_SB(0, 0), b2, voffB); PG8_STAGE(PG8_SB(0, 1), b2 + hstepB, voffB); PG8_STAGE(PG8_SA(0, 0), a2, voffA);
            PG8_WAIT_V(8); PG8_WAIT_L(0); PG8_BAR; PG8_MMA(1, 0, At, B0); PG8_MMA(1, 1, At, B1); PG8_BAR; PG8_SCHED;
            PG8_LDB(B0, 1, 0); PG8_LDB(B1, 1, 1); PG8_SCHED; PG8_LDA(At, 1, 0); PG8_STAGE(PG8_SA(0, 1), a2 + hstepA, voffA);
            PG8_WAIT_V(8); PG8_WAIT_L(0); PG8_BAR; PG8_MMA(0, 0, At, B0); PG8_MMA(0, 1, At, B1); PG8_BAR; PG8_SCHED;
            PG8_LDA(At, 1, 1); PG8_STAGE(PG8_SB(1, 0), b3, voffB); PG8_STAGE(PG8_SB(1, 1), b3 + hstepB, voffB); PG8_STAGE(PG8_SA(1, 0), a3, voffA);
            PG8_WAIT_V(8); PG8_WAIT_L(0); PG8_BAR; PG8_MMA(1, 0, At, B0); PG8_MMA(1, 1, At, B1); PG8_BAR; PG8_SCHED;
            } else {
            PG8_LDB(B0, 0, 0); PG8_SCHED; PG8_LDA(At, 0, 0); PG8_STAGE(PG8_SA(1, 1), a1 + hstepA, voffA);
            PG8_WAIT_L(8); PG8_BAR; PG8_WAIT_L(0); PG8_MMA(0, 0, At, B0); PG8_BAR; PG8_SCHED;
            PG8_LDB(B1, 0, 1); PG8_STAGE(PG8_SB(0, 0), b2, voffB);
            PG8_BAR; PG8_WAIT_L(0); PG8_MMA(0, 1, At, B1); PG8_BAR;
            PG8_LDA(At, 0, 1); PG8_STAGE(PG8_SA(0, 0), a2, voffA);
            PG8_BAR; PG8_WAIT_L(0); PG8_MMA(1, 0, At, B0); PG8_BAR; PG8_SCHED;
            PG8_STAGE(PG8_SB(0, 1), b2 + hstepB, voffB);
            PG8_WAIT_V(6); PG8_BAR; PG8_MMA(1, 1, At, B1); PG8_BAR;
            PG8_LDB(B0, 1, 0); PG8_SCHED; PG8_LDA(At, 1, 0); PG8_STAGE(PG8_SA(0, 1), a2 + hstepA, voffA);
            PG8_WAIT_L(8); PG8_BAR; PG8_WAIT_L(0); PG8_MMA(0, 0, At, B0); PG8_BAR; PG8_SCHED;
            PG8_LDB(B1, 1, 1); PG8_STAGE(PG8_SB(1, 0), b3, voffB);
            PG8_BAR; PG8_WAIT_L(0); PG8_MMA(0, 1, At, B1); PG8_BAR;
            PG8_LDA(At, 1, 1); PG8_STAGE(PG8_SA(1, 0), a3, voffA);
            PG8_BAR; PG8_WAIT_L(0); PG8_MMA(1, 0, At, B0); PG8_BAR; PG8_SCHED;
            PG8_STAGE(PG8_SB(1, 1), b3 + hstepB, voffB);
            PG8_WAIT_V(6); PG8_BAR; PG8_MMA(1, 1, At, B1); PG8_BAR;
            }
        }
        if constexpr (ALIGN_EPI) { if (wr == 0) PG8_BAR; }
        { int fr_o = fr, fq_o = fq; asm volatile("" : "+v"(fr_o), "+v"(fq_o)); E(acc, cur, wr, wc, fr_o, fq_o); }
        if (!has_next) break;
#pragma unroll
        for (int a = 0; a < 2; ++a)
#pragma unroll
            for (int b = 0; b < 2; ++b)
#pragma unroll
                for (int m = 0; m < 4; ++m)
#pragma unroll
                    for (int n = 0; n < 2; ++n) acc[a][b][m][n] = (f32x4){0.f, 0.f, 0.f, 0.f};
        cur = nxt; cA = nA; cB = nB; ++ui; if (SEG2) { cA2 = (const char*)g.A2 + (size_t)cur.pm2 * tstepA; cB2 = (const char*)g.B2 + (size_t)cur.pn2 * tstepB; }
        if constexpr (ALIGN_EPI) { if (wr == 1) PG8_BAR; }
    }
    PG8_WAIT_V(0);
    if constexpr (!ALIGN_EPI) { if (wr == 0) PG8_BAR; }
    PG8_BAR;
#undef PG8_KP
#undef PG8_SA
#undef PG8_SB
#undef PG8_STAGE
#undef PG8_LDA
#undef PG8_LDB
#undef PG8_MMA
#undef PG8_WAIT_V
#undef PG8_WAIT_L
#undef PG8_BAR
#undef PG8_SCHED
}
}

constexpr int D = 2048, SEQ = 8192, CTXL = 256, R = SEQ + CTXL, DEPTH = 4, NPAN = R / 256;
constexpr int S5W = 512, S5G = 32, S5CH = 16, S5P = 64, CONVW = 512, CONVK = 31, MLW = 1024, MLH = 4, DH = 256, DFF = 5632;
constexpr int INW = 5648, NIN = 5888;
constexpr int OFF_CONV = 512, OFF_Q = 1536, OFF_K = 2560, OFF_V = 3584, OFF_O = 4608, OFF_G = 5632;
constexpr float EPS = 1e-6f, LN_EPS = 1e-5f;
constexpr int UROWS = 768, UPITCH = 512;

constexpr size_t MiB = 1u << 20;
constexpr size_t WS_CTL = 0, CTL_ZERO_BYTES = 1 * MiB;
constexpr size_t WS_MOD = 1 * MiB;
constexpr size_t WS_XR = 2 * MiB;
constexpr size_t WS_HN = 68 * MiB;
constexpr size_t WS_U = 101 * MiB;
constexpr size_t WS_CG = 125 * MiB;
constexpr size_t WS_Q = 134 * MiB, WS_K = 151 * MiB, WS_V = 168 * MiB;
constexpr size_t WS_O = 185 * MiB;
constexpr size_t WS_GATES = 202 * MiB;
constexpr size_t WS_MIX = 203 * MiB;
constexpr size_t WS_HFF = 236 * MiB;
constexpr size_t WS_YS = 327 * MiB;
constexpr size_t WS_S5G = 360 * MiB;
constexpr size_t WS_HML = 369 * MiB;
constexpr size_t WS_W = 436 * MiB;
constexpr size_t WL_IN = 0, WL_OUT = 23 * MiB, WL_FI = 31 * MiB, WL_FO = 75 * MiB, WL_GLU = 97 * MiB, WL_STRIDE = 98 * MiB;
constexpr size_t WS_SQ = 828 * MiB;
constexpr size_t WS_VC = 894 * MiB;
constexpr size_t WS_QN = WS_SQ + 33 * MiB, WS_VT = WS_VC + 33 * MiB;
constexpr size_t WS_KT = 960 * MiB;
constexpr size_t WS_KTW = 977 * MiB;
constexpr size_t WS_DC = 1010 * MiB;
constexpr size_t WS_BC = 1076 * MiB;
constexpr size_t WS_CS = WS_BC + 512 * 1024;
constexpr size_t WS_DN = WS_CS + 512 * 1024;
constexpr size_t WS_NIN = WS_DN + 512 * 1024;
constexpr size_t WS_AT = 1078 * MiB + 1536 * 1024;
constexpr size_t WS_RSP = 1078 * MiB;
constexpr size_t WS_FC = 1080 * MiB;
constexpr size_t WS_WC = 1096 * MiB;
constexpr size_t WS_LAMP = 1128 * MiB;
constexpr size_t WS_EB = 1129 * MiB;
constexpr size_t WS_ESC = 1153 * MiB;
constexpr size_t WS_END = 1155 * MiB;
constexpr int NCK = R / 16, CTXCK = CTXL / 16, NSC = NCK / 16;
constexpr int NCH = 33;
constexpr int CW_BAR = 4096;

constexpr int RING_BYTES = 131072, LDSCTL_OFF = RING_BYTES, MISC_OFF = LDSCTL_OFF + 320, LDS_BYTES = 147456;
constexpr int NWAVES = 8, NTHR = 512;

#define GAS __attribute__((address_space(1)))
#define LAS __attribute__((address_space(3)))
typedef unsigned short bf16;
typedef unsigned v4u __attribute__((ext_vector_type(4)));
typedef unsigned v2u __attribute__((ext_vector_type(2)));
typedef float f32x4 __attribute__((ext_vector_type(4)));
typedef GAS unsigned gu32;
#define RLX_AGENT __ATOMIC_RELAXED, __HIP_MEMORY_SCOPE_AGENT
#define LDS_WAIT() asm volatile("s_waitcnt lgkmcnt(0)" ::: "memory")
__device__ __forceinline__ unsigned f2bf(float f) { unsigned u = __builtin_bit_cast(unsigned, f); return (u + 0x7fffu + ((u >> 16) & 1u)) >> 16; }
__device__ __forceinline__ unsigned pk2(float lo, float hi) { unsigned r; asm("v_cvt_pk_bf16_f32 %0, %1, %2" : "=v"(r) : "v"(lo), "v"(hi)); return r; }
__device__ __forceinline__ float bf2f(unsigned short b) { return __builtin_bit_cast(float, ((unsigned)b) << 16); }
__device__ __forceinline__ float bflo(unsigned w) { return __builtin_bit_cast(float, w << 16); }
__device__ __forceinline__ float bfhi(unsigned w) { return __builtin_bit_cast(float, w & 0xffff0000u); }
__device__ __forceinline__ float sigmoidf_(float x) { return __builtin_amdgcn_rcpf(1.f + __builtin_amdgcn_exp2f(-1.4426950408889634f * x)); }
__device__ __forceinline__ float siluf_(float x) { return x * __builtin_amdgcn_rcpf(1.f + __builtin_amdgcn_exp2f(-1.4426950408889634f * x)); }
__device__ __forceinline__ float gelu_tanh_(float x) { const float u = 0.7978845608028654f * (x + 0.044715f * x * x * x); return x * __builtin_amdgcn_rcpf(1.f + __builtin_amdgcn_exp2f(-2.8853900817779268f * u)); }
template <int CTRL, int RM> __device__ __forceinline__ float dppf(float v) { return __builtin_bit_cast(float, __builtin_amdgcn_update_dpp(0, __builtin_bit_cast(int, v), CTRL, RM, 0xF, false)); }
__device__ __forceinline__ float wave_sum(float v) {
    v += dppf<0xB1, 0xF>(v); v += dppf<0x4E, 0xF>(v); v += dppf<0x124, 0xF>(v); v += dppf<0x128, 0xF>(v);
    v += dppf<0x142, 0xA>(v); v += dppf<0x143, 0xC>(v);
    return __builtin_bit_cast(float, __builtin_amdgcn_readlane(__builtin_bit_cast(int, v), 63));
}
__device__ __forceinline__ int tau_row(int d, int tau) { return d == 0 ? tau : (tau < CTXL ? CTXL - 1 - tau : (R - 1 + CTXL) - tau); }

#define XB_TMO      128
#define XB_XCNT(j)  (256  + 64 * (j))
#define XB_XSUB(j)  (1280 + 64 * (j))
#define XB_XGEN(j)  (2304 + 64 * (j))
#define XB_TOP      3328
#define XB_TOPGEN   3392
#define XCD_BAR_WORDS 3456
#define XB_SPIN_CAP (1u << 22)
__device__ __forceinline__ unsigned xb_ld(unsigned* p)              { return __hip_atomic_load(p, __ATOMIC_RELAXED, __HIP_MEMORY_SCOPE_AGENT); }
__device__ __forceinline__ unsigned xb_add(unsigned* p, unsigned v) { return __hip_atomic_fetch_add(p, v, __ATOMIC_RELAXED, __HIP_MEMORY_SCOPE_AGENT); }
__device__ __forceinline__ unsigned xb_xcc_id() { return (unsigned)__builtin_amdgcn_s_getreg((3 << 11) | 20) & 0xFu; }
#define XB_SPIN(cond, bar) do { unsigned _sp = 0; while (cond) { __builtin_amdgcn_s_sleep(1); \
    if ((++_sp & 255u) == 0u) { if (xb_ld(&(bar)[XB_TMO])) break; if (_sp > XB_SPIN_CAP) { atomicAdd(&(bar)[XB_TMO], 1u); break; } } } } while (0)
struct XcdBarrier { unsigned* bar; unsigned x; volatile LAS unsigned* st; };
__device__ __forceinline__ XcdBarrier xcd_barrier_post(unsigned* bar, volatile LAS unsigned* st) {
    XcdBarrier b; b.bar = bar; b.x = xb_xcc_id(); b.st = st;
    if (threadIdx.x == 0) (void)xb_add(&bar[XB_XCNT(b.x)], 1u);
    return b;
}
__device__ __forceinline__ void xcd_barrier_complete(unsigned* bar, unsigned x, unsigned& nloc, unsigned& nx) {
    const unsigned G = gridDim.x * gridDim.y * gridDim.z;
    unsigned sum, cnt, mine, sp = 0u;
    for (;;) {
        sum = 0u; cnt = 0u; mine = 0u;
#pragma unroll
        for (unsigned j = 0; j < 16; ++j) { const unsigned c = xb_ld(&bar[XB_XCNT(j)]); sum += c; cnt += (c > 0u) ? 1u : 0u; mine = (j == x) ? c : mine; }
        if (sum == G) break;
        __builtin_amdgcn_s_sleep(1);
        if ((++sp & 255u) == 0u) { if (xb_ld(&bar[XB_TMO])) break; if (sp > XB_SPIN_CAP) { atomicAdd(&bar[XB_TMO], 1u); break; } }
    }
    nloc = mine > 0u ? mine : 1u; nx = cnt > 0u ? cnt : 1u;
}
__device__ __forceinline__ void xcd_barrier(const XcdBarrier& b) {
    asm volatile("s_waitcnt vmcnt(0)" ::: "memory");
    __syncthreads();
    if (threadIdx.x == 0) {
        unsigned* bar = b.bar;
        __builtin_amdgcn_s_waitcnt(0);
        unsigned nloc = b.st[0], nx = b.st[1];
        if (nloc == 0u) { xcd_barrier_complete(bar, b.x, nloc, nx); b.st[0] = nloc; b.st[1] = nx; }
        const unsigned old = xb_add(&bar[XB_XSUB(b.x)], 1u);
        const unsigned gen = old / nloc;
        if (old + 1u == (gen + 1u) * nloc) {
            __builtin_amdgcn_fence(__ATOMIC_RELEASE, "agent");
            asm volatile("s_waitcnt vmcnt(0)" ::: "memory");
            const unsigned og = xb_add(&bar[XB_TOP], 1u);
            const unsigned tg = og / nx;
            if (og + 1u == (tg + 1u) * nx) xb_add(&bar[XB_TOPGEN], 1u);
            else XB_SPIN(xb_ld(&bar[XB_TOPGEN]) == tg, bar);
            __builtin_amdgcn_fence(__ATOMIC_ACQUIRE, "agent");
            xb_add(&bar[XB_XGEN(b.x)], 1u);
            asm volatile("s_waitcnt vmcnt(0)" ::: "memory");
        } else {
            XB_SPIN(xb_ld(&bar[XB_XGEN(b.x)]) == gen, bar);
            __builtin_amdgcn_fence(__ATOMIC_ACQUIRE, "agent");
            asm volatile("s_waitcnt vmcnt(0)" ::: "memory");
        }
    }
    __syncthreads();
}

struct Args {
    const float *x, *c, *ctx, *c_ctx, *w_mod, *b_mod, *norm1_g, *w_in, *b_in, *s5_lam_re, *s5_lam_im, *s5_log_step, *s5_b_re, *s5_b_im, *s5_c_re, *s5_c_im,
                *s5_d, *s5_w_glu, *s5_b_glu, *conv_dw_w, *conv_dw_b, *conv_ln_g, *conv_ln_b, *ml_norm_g, *w_out, *norm2_g, *w_ffn_in, *w_ffn_out, *norm_f_g;
    float* out; unsigned char* ws;
    int l_lo, l_hi, ph_lo, ph_hi, do_pro, do_fin, use_bar, pad;
};

typedef const Args __attribute__((address_space(4))) CArgs;

struct TItem { const float* W; bf16* WT; int Nsrc, ldt, k0, n0d, n0s, nvalid; };
__device__ __forceinline__ void titem_load(const TItem& t, f32x4 (&v)[8], int lane) {
    const int r8 = lane >> 3, q4 = (lane & 7) * 4;
#pragma unroll
    for (int i = 0; i < 8; ++i) { const f32x4 x = *(const f32x4*)(t.W + (size_t)(t.k0 + 8 * i + r8) * t.Nsrc + t.n0s + (q4 < t.nvalid ? q4 : 0)); v[i] = q4 < t.nvalid ? x : (f32x4){0.f, 0.f, 0.f, 0.f}; }
}
__device__ __forceinline__ void titem_store(const TItem& t, const f32x4 (&v)[8], LAS float* scr, int lane) {
    const int r8 = lane >> 3, q4 = (lane & 7) * 4;
#pragma unroll
    for (int i = 0; i < 8; ++i) { LAS float* d = scr + (8 * i + r8) * 33 + q4; d[0] = v[i].x; d[1] = v[i].y; d[2] = v[i].z; d[3] = v[i].w; }
    LDS_WAIT(); asm volatile("" ::: "memory");
    const int c = lane & 7;
#pragma unroll
    for (int j = 0; j < 4; ++j) { const int n = (lane >> 3) + 8 * j; const LAS float* s = scr + (8 * c) * 33 + n;
        v4u o; o.x = pk2(s[0 * 33], s[1 * 33]); o.y = pk2(s[2 * 33], s[3 * 33]); o.z = pk2(s[4 * 33], s[5 * 33]); o.w = pk2(s[6 * 33], s[7 * 33]);
        *(GAS v4u*)(t.WT + (size_t)(t.n0d + n) * t.ldt + t.k0 + 8 * c) = o; }
    LDS_WAIT(); asm volatile("" ::: "memory");
}
__device__ __forceinline__ int win_src(int nd) {
    if (nd >= OFF_CONV && nd < OFF_Q) { const int t = (nd - OFF_CONV) >> 8, w = (nd - OFF_CONV) & 255; return w < 128 ? OFF_CONV + t * 128 + w : OFF_CONV + CONVW + t * 128 + (w - 128); }
    return nd;
}
__device__ __forceinline__ int wfi_src(int nd) { const int t = nd >> 8, w = nd & 255; return w < 128 ? t * 128 + w : DFF + t * 128 + (w - 128); }

constexpr int I_IN = (D / 64) * (NIN / 32), I_OUT = (D / 64) * (D / 32), I_FI = (D / 64) * (2 * DFF / 32), I_FO = (DFF / 64) * (D / 32), I_GLU = (S5W / 64) * (S5W / 32);
constexpr int I_L = I_IN + I_OUT + I_FI + I_FO + I_GLU;
__device__ __forceinline__ void titem_decode(CArgs* ap, unsigned char* ws, int l_, int r_, TItem& T) {
    unsigned char* wl_ = ws + WS_W + (size_t)l_ * WL_STRIDE;
    if (r_ < I_IN) { const int nb = r_ % (NIN / 32), kb = r_ / (NIN / 32), nd = nb * 32; const int nv = nd + 32 <= INW ? 32 : (nd < INW ? INW - nd : 0);
        T = TItem{ap->w_in + (size_t)l_ * D * INW, (bf16*)(wl_ + WL_IN), INW, D, kb * 64, nd, nv ? win_src(nd) : 0, nv}; }
    else if ((r_ -= I_IN) < I_OUT) { const int nb = r_ % (D / 32), kb = r_ / (D / 32); T = TItem{ap->w_out + (size_t)l_ * D * D, (bf16*)(wl_ + WL_OUT), D, D, kb * 64, nb * 32, nb * 32, 32}; }
    else if ((r_ -= I_OUT) < I_FI) { const int nb = r_ % (2 * DFF / 32), kb = r_ / (2 * DFF / 32); T = TItem{ap->w_ffn_in + (size_t)l_ * D * 2 * DFF, (bf16*)(wl_ + WL_FI), 2 * DFF, D, kb * 64, nb * 32, wfi_src(nb * 32), 32}; }
    else if ((r_ -= I_FI) < I_FO) { const int nb = r_ % (D / 32), kb = r_ / (D / 32); T = TItem{ap->w_ffn_out + (size_t)l_ * DFF * D, (bf16*)(wl_ + WL_FO), D, DFF, kb * 64, nb * 32, nb * 32, 32}; }
    else { r_ -= I_FO; const int nb = r_ % (S5W / 32), kb = r_ / (S5W / 32); T = TItem{ap->s5_w_glu + (size_t)l_ * S5W * S5W, (bf16*)(wl_ + WL_GLU), S5W, S5W, kb * 64, nb * 32, nb * 32, 32}; }
}
__device__ __forceinline__ void convert_range(CArgs* ap, unsigned char* ws, LAS unsigned char* lds, int wave, int lane, int l, int lo, int hi, int first, int step) {
    LAS float* scr = (LAS float*)(lds + wave * 16384);
    int it = lo + first; if (it >= hi) return;
    TItem tc, tn; f32x4 vc[8], vn[8];
    titem_decode(ap, ws, l, it, tn); titem_load(tn, vn, lane);
    for (; it < hi; it += step) { tc = tn;
#pragma unroll
        for (int i = 0; i < 8; ++i) vc[i] = vn[i];
        { const int i1 = it + step < hi ? it + step : hi - 1; titem_decode(ap, ws, l, i1, tn); titem_load(tn, vn, lane); }
        titem_store(tc, vc, scr, lane); }
}

using pg8::f32x2;
struct EpiWin {
    static constexpr bool PERM = true;
    const float* bias; bf16 *U, *CG, *SQ, *Kb, *KT, *VC, *O; float* GATES;
    __device__ __forceinline__ void operator()(const f32x4 (&acc)[2][2][4][2], const pg8::Unit& u, int wr, int wc, int fr, int fq) const {
        const int row0 = u.pm * 256 + wr * 64 + fr, pn = u.pn, cw0 = wc * 32 + 8 * fq;
        if (pn < 2) {
#pragma unroll
            for (int bj = 0; bj < 2; ++bj) { const int col = pn * 256 + bj * 128 + cw0, g = col >> 4, ch0 = col & 15;
                const f32x4 b0 = *(const f32x4*)(bias + col), b1 = *(const f32x4*)(bias + col + 4);
#pragma unroll
                for (int ai = 0; ai < 2; ++ai)
#pragma unroll
                    for (int m = 0; m < 4; ++m) { const int r = row0 + ai * 128 + m * 16; const f32x4 v0 = acc[ai][bj][m][0] + b0, v1 = acc[ai][bj][m][1] + b1;
                        v4u w; w.x = pk2(v0[0], v0[1]); w.y = pk2(v0[2], v0[3]); w.z = pk2(v1[0], v1[1]); w.w = pk2(v1[2], v1[3]);
                        *(v4u*)(U + ((size_t)g * UROWS + (r >> 4)) * UPITCH + (r & 15) * 16 + ch0) = w; } }
        } else if (pn < 6) {
            const int ch = (pn - 2) * 128 + cw0;
            const f32x4 a0 = *(const f32x4*)(bias + OFF_CONV + ch), a1 = *(const f32x4*)(bias + OFF_CONV + ch + 4), b0 = *(const f32x4*)(bias + OFF_CONV + CONVW + ch), b1 = *(const f32x4*)(bias + OFF_CONV + CONVW + ch + 4);
#pragma unroll
            for (int ai = 0; ai < 2; ++ai)
#pragma unroll
                for (int m = 0; m < 4; ++m) { const int r = row0 + ai * 128 + m * 16;
                    const f32x4 x0 = acc[ai][0][m][0] + a0, x1 = acc[ai][0][m][1] + a1, y0 = acc[ai][1][m][0] + b0, y1 = acc[ai][1][m][1] + b1; float o[8];
#pragma unroll
                    for (int j = 0; j < 4; ++j) { o[j] = x0[j] * sigmoidf_(y0[j]); o[4 + j] = x1[j] * sigmoidf_(y1[j]); }
                    v4u w; w.x = pk2(o[0], o[1]); w.y = pk2(o[2], o[3]); w.z = pk2(o[4], o[5]); w.w = pk2(o[6], o[7]);
                    *(v4u*)(CG + (size_t)r * CONVW + ch) = w; }
        } else if (pn < 22) {
            const int which = (pn - 6) >> 2, h = (pn - 6) & 3, c = u.pm; const float sc = which == 1 ? 0.0625f : 1.f;
#pragma unroll
            for (int bj = 0; bj < 2; ++bj) { const int cw = bj * 128 + cw0; const f32x4 b0 = *(const f32x4*)(bias + pn * 256 + cw), b1 = *(const f32x4*)(bias + pn * 256 + cw + 4);
#pragma unroll
                for (int ai = 0; ai < 2; ++ai)
#pragma unroll
                    for (int m = 0; m < 4; ++m) { int t = wr * 64 + fr + ai * 128 + m * 16; asm volatile("" : "+v"(t) :: "memory"); const int r = c * 256 + t; const f32x4 v0 = (acc[ai][bj][m][0] + b0) * sc, v1 = (acc[ai][bj][m][1] + b1) * sc;
                        v4u w; w.x = pk2(v0[0], v0[1]); w.y = pk2(v0[2], v0[3]); w.z = pk2(v1[0], v1[1]); w.w = pk2(v1[2], v1[3]);
                        if (which == 0) { *(v4u*)(SQ + ((size_t)(h * NCH + c) * 256 + t) * 256 + cw) = w; }
                        else if (which == 1) { *(v4u*)(Kb + ((size_t)h * R + r) * 256 + cw) = w; unsigned short* kt = (unsigned short*)KT + ((size_t)(h * NCH + c) * 256 + cw) * 256 + t;
                            kt[0] = (unsigned short)w.x; kt[256] = (unsigned short)(w.x >> 16); kt[512] = (unsigned short)w.y; kt[768] = (unsigned short)(w.y >> 16);
                            kt[1024] = (unsigned short)w.z; kt[1280] = (unsigned short)(w.z >> 16); kt[1536] = (unsigned short)w.w; kt[1792] = (unsigned short)(w.w >> 16); }
                        else if (which == 2) { unsigned short* vt = (unsigned short*)VC + ((size_t)(h * NCH + c) * 256 + cw) * 256 + t;
                            vt[0] = (unsigned short)w.x; vt[256] = (unsigned short)(w.x >> 16); vt[512] = (unsigned short)w.y; vt[768] = (unsigned short)(w.y >> 16);
                            vt[1024] = (unsigned short)w.z; vt[1280] = (unsigned short)(w.z >> 16); vt[1536] = (unsigned short)w.w; vt[1792] = (unsigned short)(w.w >> 16); }
                        else *(v4u*)(O + (size_t)r * 1024 + h * 256 + cw) = w; } }
        } else {
            if (wc == 0 && fq < 2) { const f32x4 b0 = *(const f32x4*)(bias + OFF_G + 8 * fq), b1 = *(const f32x4*)(bias + OFF_G + 8 * fq + 4);
#pragma unroll
                for (int ai = 0; ai < 2; ++ai)
#pragma unroll
                    for (int m = 0; m < 4; ++m) { const int r = row0 + ai * 128 + m * 16;
                        *(f32x4*)(GATES + (size_t)r * 16 + 8 * fq) = acc[ai][0][m][0] + b0; *(f32x4*)(GATES + (size_t)r * 16 + 8 * fq + 4) = acc[ai][0][m][1] + b1; } }
        }
    }
};
struct EpiRes {
    static constexpr bool PERM = false;
    float* XR; const float* gate_c; const float* gate_x; const float* RS;
    __device__ __forceinline__ void operator()(const f32x4 (&acc)[2][2][4][2], const pg8::Unit& u, int wr, int wc, int fr, int fq) const {
        const int row0 = u.pm * 256 + wr * 64 + fr, col0 = u.pn * 256 + wc * 32 + 4 * fq; const float* gate = u.pm == 0 ? gate_c : gate_x;
        f32x4 gv[2][2];
#pragma unroll
        for (int bj = 0; bj < 2; ++bj)
#pragma unroll
            for (int n = 0; n < 2; ++n) gv[bj][n] = *(const f32x4*)(gate + col0 + bj * 128 + n * 16);
#pragma unroll
        for (int ai = 0; ai < 2; ++ai)
#pragma unroll
            for (int m = 0; m < 4; ++m) { float* rowp = XR + (size_t)(row0 + ai * 128 + m * 16) * D + col0;
#pragma unroll
                for (int bj = 0; bj < 2; ++bj)
#pragma unroll
                    for (int n = 0; n < 2; ++n) { f32x4* p = (f32x4*)(rowp + bj * 128 + n * 16); *p = *(const f32x4*)(RS + (size_t)(row0 + ai * 128 + m * 16) * D + col0 + bj * 128 + n * 16) + gv[bj][n] * acc[ai][bj][m][n]; } }
    }
};
struct EpiSwiglu {
    static constexpr bool PERM = true;
    bf16* HFF;
    __device__ __forceinline__ void operator()(const f32x4 (&acc)[2][2][4][2], const pg8::Unit& u, int wr, int wc, int fr, int fq) const {
        const int row0 = u.pm * 256 + wr * 64 + fr, hc = u.pn * 128 + wc * 32 + 8 * fq;
#pragma unroll
        for (int ai = 0; ai < 2; ++ai)
#pragma unroll
            for (int m = 0; m < 4; ++m) { int r = row0 + ai * 128 + m * 16; asm volatile("" : "+v"(r) :: "memory"); float o[8];
#pragma unroll
                for (int j = 0; j < 4; ++j) { o[j] = siluf_(acc[ai][0][m][0][j]) * acc[ai][1][m][0][j]; o[4 + j] = siluf_(acc[ai][0][m][1][j]) * acc[ai][1][m][1][j]; }
                v4u w; w.x = pk2(o[0], o[1]); w.y = pk2(o[2], o[3]); w.z = pk2(o[4], o[5]); w.w = pk2(o[6], o[7]);
                *(v4u*)(HFF + (size_t)r * DFF + hc) = w; }
    }
};
struct EpiGlu {
    static constexpr bool PERM = true;
    const bf16* S5Gb; const float* bias; bf16* MIX;
    __device__ __forceinline__ void operator()(const f32x4 (&acc)[2][2][4][2], const pg8::Unit& u, int wr, int wc, int fr, int fq) const {
        const int row0 = u.pm * 256 + wr * 64 + fr;
#pragma unroll
        for (int bj = 0; bj < 2; ++bj) { const int col = u.pn * 256 + bj * 128 + wc * 32 + 8 * fq; const f32x4 b0 = *(const f32x4*)(bias + col), b1 = *(const f32x4*)(bias + col + 4);
#pragma unroll
            for (int ai = 0; ai < 2; ++ai)
#pragma unroll
                for (int m = 0; m < 4; ++m) { const int r = row0 + ai * 128 + m * 16; const v4u gw = *(const v4u*)(S5Gb + (size_t)r * S5W + col);
                    const f32x4 v0 = acc[ai][bj][m][0] + b0, v1 = acc[ai][bj][m][1] + b1; float o[8];
                    o[0] = bflo(gw.x) * sigmoidf_(v0[0]); o[1] = bfhi(gw.x) * sigmoidf_(v0[1]); o[2] = bflo(gw.y) * sigmoidf_(v0[2]); o[3] = bfhi(gw.y) * sigmoidf_(v0[3]);
                    o[4] = bflo(gw.z) * sigmoidf_(v1[0]); o[5] = bfhi(gw.z) * sigmoidf_(v1[1]); o[6] = bflo(gw.w) * sigmoidf_(v1[2]); o[7] = bfhi(gw.w) * sigmoidf_(v1[3]);
                    v4u w; w.x = pk2(o[0], o[1]); w.y = pk2(o[2], o[3]); w.z = pk2(o[4], o[5]); w.w = pk2(o[6], o[7]);
                    *(v4u*)(MIX + (size_t)r * D + col) = w; } }
    }
};

struct BatchOrder {
    int n, G, c, mode;
    __device__ __forceinline__ bool next(int i, pg8::Unit& u) const {
        const long L = (long)i * G + c; if (L >= n) return false; const int idx = (int)L; u.ka = 0; u.pm2 = 0; u.pn2 = 0;
        if (mode == 4) { u.pm = 0; u.pn = idx & 7; u.ka = (idx >> 3) * 256; }
        else if (mode == 1) { const int d = idx >> 7, h = (idx >> 5) & 3, cc = idx & 31, ch = d == 0 ? cc : (cc == 0 ? 0 : cc + 1); u.pm = h * NCH + ch; u.pn = (d * 4 + h) * NCH + ch; }
        else if (mode == 3) { u.pm = idx; u.pn = idx / 3; }
        else if (mode == 2) { const int dh = idx / NCH, ch = idx % NCH, hc = (dh & 3) * NCH + ch; u.pm = idx; u.pn = hc; u.pm2 = hc; u.pn2 = idx; }
        else { u.pm = u.pn = idx; }
        return true;
    }
};
struct EpiG1 {
    static constexpr bool PERM = true;
    bf16* SQ; const float* CS; float* RSP;
    __device__ __forceinline__ void operator()(const f32x4 (&acc)[2][2][4][2], const pg8::Unit& u, int wr, int wc, int fr, int fq) const {
        const int h = u.pm / NCH, c = u.pm % NCH;
#pragma unroll
        for (int d = 0; d < 2; ++d) {
            const float* cs = CS + (size_t)(d * 4 + h) * R + c * 256 + wc * 32 + 8 * fq; f32x4 csv[2][2];
#pragma unroll
            for (int bj = 0; bj < 2; ++bj)
#pragma unroll
                for (int n = 0; n < 2; ++n) csv[bj][n] = *(const f32x4*)(cs + bj * 128 + 4 * n);
            bf16* dst = SQ + (size_t)((d * 4 + h) * NCH + c) * 65536; float* rsp = RSP + ((size_t)(d * 4 + h) * R + c * 256) * 4 + wc;
#pragma unroll
            for (int ai = 0; ai < 2; ++ai)
#pragma unroll
                for (int m = 0; m < 4; ++m) { int t = ai * 128 + wr * 64 + m * 16 + fr; asm volatile("" : "+v"(t) :: "memory"); float rs = 0.f;
#pragma unroll
                    for (int bj = 0; bj < 2; ++bj) { const int s0 = bj * 128 + wc * 32 + 8 * fq; float o[8];
#pragma unroll
                        for (int n = 0; n < 2; ++n)
#pragma unroll
                            for (int j = 0; j < 4; ++j) { const int si = s0 + 4 * n + j; const bool ok = d == 0 ? si <= t : si >= t; const float v = acc[ai][bj][m][n][j] * csv[bj][n][j]; o[4 * n + j] = ok ? v : 0.f; rs += o[4 * n + j]; }
                        v4u w; w.x = pk2(o[0], o[1]); w.y = pk2(o[2], o[3]); w.z = pk2(o[4], o[5]); w.w = pk2(o[6], o[7]);
                        *(v4u*)(dst + (size_t)t * 256 + s0) = w; }
                    rs += __shfl_xor(rs, 16); rs += __shfl_xor(rs, 32); if (fq == 0) rsp[(size_t)t * 4] = rs; }
        }
    }
};
struct EpiS5Y {
    static constexpr bool PERM = true;
    bf16* S5Gb;
    __device__ __forceinline__ void operator()(const f32x4 (&acc)[2][2][4][2], const pg8::Unit& u, int wr, int wc, int fr, int fq) const {
        const int g = u.pn, mt = u.pm - 3 * u.pn;
#pragma unroll
        for (int ai = 0; ai < 2; ++ai)
#pragma unroll
            for (int m = 0; m < 4; ++m) { int ck = mt * 256 + ai * 128 + wr * 64 + m * 16 + fr; asm volatile("" : "+v"(ck) :: "memory");
                if (ck < NCK) {
#pragma unroll
                    for (int bj = 0; bj < 2; ++bj) { const int nc = bj * 128 + wc * 32 + 8 * fq, t = nc >> 4, c0 = nc & 15; float o[8];
#pragma unroll
                        for (int j = 0; j < 4; ++j) { o[j] = gelu_tanh_(acc[ai][bj][m][0][j]); o[4 + j] = gelu_tanh_(acc[ai][bj][m][1][j]); }
                        v4u w; w.x = pk2(o[0], o[1]); w.y = pk2(o[2], o[3]); w.z = pk2(o[4], o[5]); w.w = pk2(o[6], o[7]);
                        *(v4u*)(S5Gb + (size_t)(ck * 16 + t) * S5W + g * 16 + c0) = w; } } }
    }
};
struct EpiPart {
    static constexpr bool PERM = false;
    float* PART;
    __device__ __forceinline__ void operator()(const f32x4 (&acc)[2][2][4][2], const pg8::Unit& u, int wr, int wc, int fr, int fq) const {
        float* o = PART + ((size_t)(u.ka >> 8) * 256 + wr * 64 + fr) * D + u.pn * 256 + wc * 32 + 4 * fq;
#pragma unroll
        for (int ai = 0; ai < 2; ++ai)
#pragma unroll
            for (int m = 0; m < 4; ++m) { float* rowp = o + (size_t)(ai * 128 + m * 16) * D;
#pragma unroll
                for (int bj = 0; bj < 2; ++bj)
#pragma unroll
                    for (int n = 0; n < 2; ++n) *(f32x4*)(rowp + bj * 128 + n * 16) = acc[ai][bj][m][n]; }
    }
};
struct EpiF32T {
    static constexpr bool PERM = false;
    float* base; size_t tile_stride; int ldc;
    __device__ __forceinline__ void operator()(const f32x4 (&acc)[2][2][4][2], const pg8::Unit& u, int wr, int wc, int fr, int fq) const {
        float* o = base + (size_t)u.pm * tile_stride + (size_t)(wr * 64 + fr) * ldc + wc * 32 + 4 * fq;
#pragma unroll
        for (int ai = 0; ai < 2; ++ai)
#pragma unroll
            for (int m = 0; m < 4; ++m) { float* rowp = o + (size_t)(ai * 128 + m * 16) * ldc;
#pragma unroll
                for (int bj = 0; bj < 2; ++bj)
#pragma unroll
                    for (int n = 0; n < 2; ++n) *(f32x4*)(rowp + bj * 128 + n * 16) = acc[ai][bj][m][n]; }
    }
};
struct EpiG3 {
    static constexpr bool PERM = true;
    bf16* HMB;
    __device__ __forceinline__ void operator()(const f32x4 (&acc)[2][2][4][2], const pg8::Unit& u, int wr, int wc, int fr, int fq) const {
        const int dh = u.pm / NCH, c = u.pm % NCH, d = dh >> 2, h = dh & 3;
        bf16* o = HMB + ((size_t)d * R + c * 256 + wr * 64 + fr) * MLW + h * 256 + wc * 32 + 8 * fq;
#pragma unroll
        for (int ai = 0; ai < 2; ++ai)
#pragma unroll
            for (int m = 0; m < 4; ++m) { bf16* rowp = o + (size_t)(ai * 128 + m * 16) * MLW;
#pragma unroll
                for (int bj = 0; bj < 2; ++bj) { const f32x4 v0 = acc[ai][bj][m][0], v1 = acc[ai][bj][m][1];
                    v4u w; w.x = pk2(v0[0], v0[1]); w.y = pk2(v0[2], v0[3]); w.z = pk2(v1[0], v1[1]); w.w = pk2(v1[2], v1[3]); *(v4u*)(rowp + bj * 128) = w; } }
    }
};
struct EpiBf16T {
    static constexpr bool PERM = true;
    bf16* base; size_t tile_stride; int ldc; int use_pn;
    __device__ __forceinline__ void operator()(const f32x4 (&acc)[2][2][4][2], const pg8::Unit& u, int wr, int wc, int fr, int fq) const {
        bf16* o = base + (size_t)(use_pn ? u.pn : u.pm) * tile_stride + (size_t)(wr * 64 + fr) * ldc + wc * 32 + 8 * fq;
#pragma unroll
        for (int ai = 0; ai < 2; ++ai)
#pragma unroll
            for (int m = 0; m < 4; ++m) { bf16* rowp = o + (size_t)(ai * 128 + m * 16) * ldc;
#pragma unroll
                for (int bj = 0; bj < 2; ++bj) { const f32x4 v0 = acc[ai][bj][m][0], v1 = acc[ai][bj][m][1];
                    v4u w; w.x = pk2(v0[0], v0[1]); w.y = pk2(v0[2], v0[3]); w.z = pk2(v1[0], v1[1]); w.w = pk2(v1[2], v1[3]); *(v4u*)(rowp + bj * 128) = w; } }
    }
};

constexpr int CV_B0 = 0, CV_B1 = 10200, CV_A0 = CV_B1, CV_A1 = CV_B1 + 10900, CV_C0 = CV_A1, CV_C1 = I_L;
constexpr int NPH = 12;
__global__ void __launch_bounds__(NTHR, 2) fwd(Args a) {
    extern __shared__ __attribute__((aligned(16))) unsigned char lds_raw[];
    LAS unsigned char* lds = (LAS unsigned char*)lds_raw;
    volatile LAS unsigned* MISC = (volatile LAS unsigned*)(lds + MISC_OFF);
    const int G = gridDim.x, bid = blockIdx.x, NGW = G * NWAVES;
    const int wave0 = __builtin_amdgcn_readfirstlane((int)threadIdx.x >> 6);
    for (int u = threadIdx.x; u < (LDS_BYTES - LDSCTL_OFF) / 4; u += NTHR) ((LAS unsigned*)(lds + LDSCTL_OFF))[u] = 0u;
    __syncthreads();
    gu32* ctl = (gu32*)(a.ws + WS_CTL);
#define PH_WS CArgs* ap = (CArgs*)__builtin_amdgcn_kernarg_segment_ptr(); asm volatile("" : "+s"(ap)); unsigned char* ws = ap->ws;
#define MOD ((float*)(ws + WS_MOD))
#define XR ((float*)(ws + WS_XR))
#define HN ((bf16*)(ws + WS_HN))
#define U ((bf16*)(ws + WS_U))
#define CG ((bf16*)(ws + WS_CG))
#define Kb ((bf16*)(ws + WS_K))
#define Ob ((bf16*)(ws + WS_O))
#define GATES ((float*)(ws + WS_GATES))
#define MIX ((bf16*)(ws + WS_MIX))
#define HFF ((bf16*)(ws + WS_HFF))
#define YS ((float*)(ws + WS_YS))
#define S5Gb ((bf16*)(ws + WS_S5G))
#define HML ((float*)(ws + WS_HML))
    XcdBarrier bar; bar.bar = (unsigned*)(ctl + CW_BAR); bar.x = 0; bar.st = nullptr;
    if (a.use_bar) bar = xcd_barrier_post((unsigned*)(ctl + CW_BAR), MISC + 8);
#define GRID_BAR() do { if (a.use_bar) xcd_barrier(bar); } while (0)
    unsigned long long tp_acc = 0ull;
#define TP0(k) const unsigned long long tp0_ = (((TPROBE >> (k)) | (TPROBE >> ((k) + 16))) & 1) ? __builtin_amdgcn_s_memrealtime() : 0ull;
#define TPW(k) do { if ((TPROBE >> ((k) + 16)) & 1) tp_acc += __builtin_amdgcn_s_memrealtime() - tp0_; } while (0)
#define TP1(k) do { if ((TPROBE >> (k)) & 1) tp_acc += __builtin_amdgcn_s_memrealtime() - tp0_; } while (0)
#define PH_IDS PH_WS int lane; asm volatile("v_mbcnt_lo_u32_b32 %0, -1, 0\n\tv_mbcnt_hi_u32_b32 %0, -1, %0" : "=v"(lane)); const int wave = wave0, tid = wave * 64 + lane, gw = bid * NWAVES + wave; (void)tid; (void)gw;

    if (PROMASK && a.do_pro) { TP0(12) PH_IDS
        __syncthreads();
        {
            LAS float* red = (LAS float*)lds;
            for (int it = bid; it < DEPTH * 64; it += G) {
                const int l = it / 64, cg = it % 64, col = cg * 192 + (lane < 48 ? lane : 0) * 4;
                const float* W = ap->w_mod + (size_t)l * D * 6 * D + col; f32x4 s0 = {0.f, 0.f, 0.f, 0.f}, s1 = {0.f, 0.f, 0.f, 0.f};
#pragma unroll 16
                for (int k = wave * 256; k < wave * 256 + 256; ++k) { const f32x4 w = *(const f32x4*)(W + (size_t)k * 6 * D); const float cc = ap->c_ctx[k], cx = ap->c[k]; s0 += w * siluf_(cc); s1 += w * siluf_(cx); }
                if (lane < 48) { *(LAS f32x4*)(red + (wave * 2 + 0) * 192 + lane * 4) = s0; *(LAS f32x4*)(red + (wave * 2 + 1) * 192 + lane * 4) = s1; }
                __syncthreads();
                if (tid < 384) { const int ty = tid / 192, cc = tid % 192; float s = ap->b_mod[(size_t)l * 6 * D + cg * 192 + cc];
#pragma unroll
                  for (int w = 0; w < 8; ++w) s += red[(w * 2 + ty) * 192 + cc];
                  MOD[((size_t)l * 2 + ty) * 6 * D + cg * 192 + cc] = s; }
                __syncthreads();
            }
        }
        __syncthreads();
        {
            LAS float* L = (LAS float*)lds; LAS float* pwr = L; LAS float* pwi = L + 2176; LAS float* bbr = L + 4352; LAS float* bbi = L + 6400; LAS float* ccr = L + 8448; LAS float* cci = L + 10496; LAS float* ktab = L + 12544;
            for (int task = bid; task < DEPTH * S5G; task += G) {
                const int l = task / S5G, g = task % S5G;
                if (tid < 128) { const int d = tid >> 6, p = tid & 63; const size_t pb = (((size_t)l * 2 + d) * S5G + g) * S5P + p;
                    const float lre = ap->s5_lam_re[pb], lim = ap->s5_lam_im[pb], st = __expf(ap->s5_log_step[pb]);
                    const float ea = __expf(lre * st), th = lim * st, cs = cosf(th), sn = sinf(th), lr = ea * cs, li = ea * sn;
                    const float sh = sinf(0.5f * th), m1r = expm1f(lre * st) * cs - 2.f * sh * sh, m1i = li;
                    const float dn = 1.f / (lre * lre + lim * lim), cr = (m1r * lre + m1i * lim) * dn, ci = (m1i * lre - m1r * lim) * dn;
                    float pr = 1.f, pi = 0.f;
                    for (int j = 0; j <= 16; ++j) { pwr[(d * 17 + j) * 64 + p] = pr; pwi[(d * 17 + j) * 64 + p] = pi; const float nr = pr * lr - pi * li, ni = pr * li + pi * lr; if (j < 16) { pr = nr; pi = ni; } }
                    float ar = pr, ai = pi;
                    for (int q = 0; q < 4; ++q) { const float nr = ar * ar - ai * ai, ni = 2.f * ar * ai; ar = nr; ai = ni; }
                    ((f32x4*)(ws + WS_LAMP))[(((size_t)l * S5G + g) * 2 + d) * 64 + p] = (f32x4){pr, pi, ar, ai};
                    for (int c = 0; c < 16; ++c) { const float br = ap->s5_b_re[pb * 16 + c], bi = ap->s5_b_im[pb * 16 + c]; bbr[(d * 64 + p) * 16 + c] = cr * br - ci * bi; bbi[(d * 64 + p) * 16 + c] = cr * bi + ci * br;
                        const size_t cb = ((((size_t)l * 2 + d) * S5G + g) * S5CH + c) * S5P + p; ccr[(d * 16 + c) * 64 + p] = ap->s5_c_re[cb]; cci[(d * 16 + c) * 64 + p] = ap->s5_c_im[cb]; } }
                __syncthreads();
                { const int d = tid >> 8, j = (tid >> 4) & 15, c = tid & 15; float sacc[16];
#pragma unroll
                  for (int cp = 0; cp < 16; ++cp) sacc[cp] = 0.f;
                  for (int p = 0; p < 64; ++p) { const float xr = ccr[(d * 16 + c) * 64 + p], xi = cci[(d * 16 + c) * 64 + p], yr = pwr[(d * 17 + j) * 64 + p], yi = pwi[(d * 17 + j) * 64 + p];
                      const float zr = xr * yr - xi * yi, zi = xr * yi + xi * yr; const LAS float* br = bbr + (d * 64 + p) * 16; const LAS float* bi = bbi + (d * 64 + p) * 16;
#pragma unroll
                      for (int cp = 0; cp < 16; ++cp) sacc[cp] += zr * br[cp] - zi * bi[cp]; }
#pragma unroll
                  for (int cp = 0; cp < 16; ++cp) ktab[((d * 16 + j) * 16 + c) * 16 + cp] = sacc[cp]; }
                __syncthreads();
                bf16* FC = (bf16*)(ws + WS_FC) + ((size_t)l * S5G + g) * 65536; bf16* WC = (bf16*)(ws + WS_WC) + ((size_t)l * S5G + g) * 131072; const float* dsk = ap->s5_d + (size_t)l * S5W + g * 16;
                for (int idx = tid; idx < 8192; idx += NTHR) { const int n = idx >> 5, k0 = (idx & 31) * 8, d = n >> 7, p = (n >> 1) & 63, ri = n & 1, sI = k0 >> 4, c0 = k0 & 15, e = d == 0 ? 15 - sI : sI;
                    const float yr = pwr[(d * 17 + e) * 64 + p], yi = pwi[(d * 17 + e) * 64 + p]; float o[8];
#pragma unroll
                    for (int i = 0; i < 8; ++i) { const float br = bbr[(d * 64 + p) * 16 + c0 + i], bi = bbi[(d * 64 + p) * 16 + c0 + i]; o[i] = ri == 0 ? yr * br - yi * bi : yr * bi + yi * br; }
                    v4u w; w.x = pk2(o[0], o[1]); w.y = pk2(o[2], o[3]); w.z = pk2(o[4], o[5]); w.w = pk2(o[6], o[7]); *(v4u*)(FC + (size_t)n * 256 + k0) = w; }
                for (int idx = tid; idx < 16384; idx += NTHR) { const int n = idx >> 6, k0 = (idx & 63) * 8, t = n >> 4, c = n & 15; float o[8];
                    if (k0 < 256) { const int sI = k0 >> 4, c0 = k0 & 15;
#pragma unroll
                        for (int i = 0; i < 8; ++i) { float v = 0.f; if (sI <= t) v += ktab[((0 * 16 + (t - sI)) * 16 + c) * 16 + c0 + i]; if (sI >= t) v += ktab[((1 * 16 + (sI - t)) * 16 + c) * 16 + c0 + i]; if (sI == t && c0 + i == c) v += dsk[c]; o[i] = v; }
                    } else { const int kk = k0 - 256, d = kk >> 7, p0 = (kk & 127) >> 1, mm = d == 0 ? t + 1 : 16 - t;
#pragma unroll
                        for (int i = 0; i < 4; ++i) { const int p = p0 + i; const float xr = ccr[(d * 16 + c) * 64 + p], xi = cci[(d * 16 + c) * 64 + p], yr = pwr[(d * 17 + mm) * 64 + p], yi = pwi[(d * 17 + mm) * 64 + p];
                            o[2 * i] = xr * yr - xi * yi; o[2 * i + 1] = -(xr * yi + xi * yr); } }
                    v4u w; w.x = pk2(o[0], o[1]); w.y = pk2(o[2], o[3]); w.z = pk2(o[4], o[5]); w.w = pk2(o[6], o[7]); *(v4u*)(WC + (size_t)n * 512 + k0) = w; }
                __syncthreads();
            }
        }
        __syncthreads();
        if (bid < 128) convert_range(ap, ws, lds, wave, lane, 0, 0, 7000, bid * NWAVES + wave, 128 * NWAVES);
        else convert_range(ap, ws, lds, wave, lane, 0, 7000, I_L, (bid - 128) * NWAVES + wave, (G - 128) * NWAVES);
        TPW(12); GRID_BAR(); TP1(12);
    }

    const int plo = a.ph_lo, phi = a.ph_hi;
#define IN(k) (((PHMASK >> (k)) & 1) && plo <= (k) && (k) < phi)
    for (int l = a.l_lo; l < a.l_hi; ++l) {
#define wl (ws + WS_W + (size_t)l * WL_STRIDE)
#define modc (MOD + ((size_t)l * 2 + 0) * 6 * D)
#define modx (MOD + ((size_t)l * 2 + 1) * 6 * D)
#define NORM_PHASE(gvec, SH, SC, NPART, PCOND, PARTP, GATEP, SRCC, WB, SRCX) do { \
            for (int r = bid; r < CTXL; r += G) {     \
                const int c0 = wave * 256 + lane * 4; f32x4* xp = (f32x4*)(XR + (size_t)r * D + c0); f32x4 v = *(const f32x4*)((SRCC) + (size_t)r * D + c0); \
                if (PCOND) { f32x4 pl[(NPART)]; _Pragma("unroll") for (int ks = 0; ks < (NPART); ++ks) pl[ks] = *(const f32x4*)((PARTP) + ((size_t)ks * 256 + r) * D + c0);     \
                    __builtin_amdgcn_sched_barrier(0); \
                    f32x4 s0 = {0.f, 0.f, 0.f, 0.f}; _Pragma("unroll") for (int ks = 0; ks < (NPART); ++ks) s0 += pl[ks]; \
                    v += s0 * *(const f32x4*)((GATEP) + c0); } \
                if ((PCOND) || (WB)) *xp = v; \
                const float ps = wave_sum((v.x * v.x + v.y * v.y) + (v.z * v.z + v.w * v.w)); LAS float* red = (LAS float*)lds; if (lane == 0) red[wave] = ps; __syncthreads(); \
                float tot = 0.f; _Pragma("unroll") for (int w = 0; w < 8; ++w) tot += red[w]; const float rstd = 1.f / sqrtf(tot * (1.f / D) + EPS); \
                const f32x4 gg = *(const f32x4*)((gvec) + c0), sc = *(const f32x4*)(modc + (SC) * D + c0), sh = *(const f32x4*)(modc + (SH) * D + c0); \
                const f32x4 o = v * rstd * gg * (sc + 1.f) + sh; v2u w; w.x = pk2(o.x, o.y); w.y = pk2(o.z, o.w); *(v2u*)(HN + (size_t)r * D + c0) = w; __syncthreads(); } \
            { int r = CTXL + gw; f32x4 vn[8], ma[8], mb[8];     \
              _Pragma("unroll") for (int j = 0; j < 8; ++j) { const int c0 = lane * 4 + 256 * j; ma[j] = *(const f32x4*)((gvec) + c0) * (*(const f32x4*)(modx + (SC) * D + c0) + 1.f); mb[j] = *(const f32x4*)(modx + (SH) * D + c0); } \
              { const f32x4* xr = (const f32x4*)((SRCX) + (size_t)(r < R ? r : R - 1) * D) + lane; _Pragma("unroll") for (int j = 0; j < 8; ++j) vn[j] = xr[64 * j]; } \
              for (; r < R; r += NGW) { f32x4 v[8]; float ss = 0.f; _Pragma("unroll") for (int j = 0; j < 8; ++j) v[j] = vn[j];     \
                { const f32x4* xr = (const f32x4*)((SRCX) + (size_t)(r + NGW < R ? r + NGW : R - 1) * D) + lane; _Pragma("unroll") for (int j = 0; j < 8; ++j) vn[j] = xr[64 * j]; } \
                _Pragma("unroll") for (int j = 0; j < 8; ++j) ss += (v[j].x * v[j].x + v[j].y * v[j].y) + (v[j].z * v[j].z + v[j].w * v[j].w); \
                const float rstd = 1.f / sqrtf(wave_sum(ss) * (1.f / D) + EPS); \
                _Pragma("unroll") for (int j = 0; j < 8; ++j) { const int c0 = lane * 4 + 256 * j; \
                    const f32x4 o = v[j] * rstd * ma[j] + mb[j]; v2u w; w.x = pk2(o.x, o.y); w.y = pk2(o.z, o.w); *(v2u*)(HN + (size_t)r * D + c0) = w; } } } } while (0)
        if (IN(0)) { TP0(0) PH_IDS const float* g1n = ap->norm1_g + (size_t)l * D; const float* pg0 = MOD + ((size_t)(l > 0 ? l - 1 : 0) * 2 + 0) * 6 * D + 5 * D; const float* srcc = l == 0 ? ap->ctx : (const float*)XR; const float* srcx = l == 0 ? ap->x - (size_t)CTXL * D : (const float*)XR;     NORM_PHASE(g1n, 0, 1, DFF / 256, l > 0, HML + (size_t)8 * 256 * D, pg0, srcc, l == 0, srcx); TPW(0); GRID_BAR(); TP1(0); }

        if (IN(1)) { TP0(1) PH_WS
            pg8::Gemm g{HN, (const bf16*)(wl + WL_IN), D, D, D}; pg8::StaticOrder S; S.init(NPAN, NIN / 256, G, bid);
            EpiWin E{ap->b_in + (size_t)l * INW, U, CG, (bf16*)(ws + WS_QN), Kb, (bf16*)(ws + WS_KT), (bf16*)(ws + WS_VT), Ob, GATES};
            pg8::gemm_phase<EpiWin, pg8::StaticOrder, false, true>(lds, g, S, E, wave0);
            TPW(1); GRID_BAR(); TP1(1);
        }

        if (IN(2)) { TP0(2) PH_IDS
            { pg8::Gemm g{U, (const bf16*)(ws + WS_FC) + (size_t)l * S5G * 65536, UPITCH, 256, 256}; BatchOrder S{S5G * 3, G, (bid + 96) % G, 3};
              EpiBf16T E{(bf16*)(ws + WS_EB), 65536, 256, 0};
              pg8::gemm_phase<EpiBf16T, BatchOrder, true, true>(lds, g, S, E, wave0); }
            {
                LAS float* wsl = (LAS float*)(lds + 65536);
                float* BC = (float*)(ws + WS_BC); float* CS = (float*)(ws + WS_CS); float* DN = (float*)(ws + WS_DN); float* AT = (float*)(ws + WS_AT);
                for (int task = (bid + 128) % G; task < 2 * MLH * NCH; task += G) {
                    const int d = task / (MLH * NCH), h = (task / NCH) % MLH, c = task % NCH, dh = d * 4 + h;
                    if (wave == 0) { float lf[4], li[4], b[4]; float run = 0.f;
#pragma unroll
                        for (int j = 0; j < 4; ++j) { const int tp = lane * 4 + j, rr = c * 256 + (d ? 255 - tp : tp); const float gf = GATES[(size_t)rr * 16 + d * 8 + 4 + h]; li[j] = GATES[(size_t)rr * 16 + d * 8 + h];
                            lf[j] = fminf(gf, 0.f) - log1pf(__expf(-fabsf(gf))); run += lf[j]; b[j] = run; }
                        float inc = run;
#pragma unroll
                        for (int o = 1; o < 64; o <<= 1) { const float v = __shfl_up(inc, o); if (lane >= o) inc += v; }
                        const float excl = inc - run, btot = __shfl(inc, 63);
#pragma unroll
                        for (int j = 0; j < 4; ++j) { const int tp = lane * 4 + j, ir = d ? 255 - tp : tp; const float bb = b[j] + excl;
                            BC[(size_t)dh * R + c * 256 + ir] = bb; CS[(size_t)dh * R + c * 256 + ir] = __expf(li[j] - bb); wsl[ir] = __expf(btot - bb + li[j]); }
                        if (lane == 0) AT[dh * NCH + c] = __expf(btot); }
                    __syncthreads();
                    const bf16* kt = (const bf16*)(ws + WS_KT) + (size_t)(h * NCH + c) * 65536; bf16* ktw = (bf16*)(ws + WS_KTW) + (size_t)(dh * NCH + c) * 65536;
                    v4u kvs[16];
#pragma unroll
                    for (int i = 0; i < 16; ++i) { const int idx = tid + NTHR * i; kvs[i] = *(const v4u*)(kt + (size_t)(idx >> 5) * 256 + (idx & 31) * 8); }
                    __builtin_amdgcn_sched_barrier(0);
#pragma unroll
                    for (int i = 0; i < 16; ++i) { const int idx = tid + NTHR * i, dk = idx >> 5, s0 = (idx & 31) * 8; const v4u kv = kvs[i];
                        const f32x4 w0 = *(const LAS f32x4*)(wsl + s0), w1 = *(const LAS f32x4*)(wsl + s0 + 4);
                        const float o0 = bflo(kv.x) * w0.x, o1 = bfhi(kv.x) * w0.y, o2 = bflo(kv.y) * w0.z, o3 = bfhi(kv.y) * w0.w, o4 = bflo(kv.z) * w1.x, o5 = bfhi(kv.z) * w1.y, o6 = bflo(kv.w) * w1.z, o7 = bfhi(kv.w) * w1.w;
                        v4u w; w.x = pk2(o0, o1); w.y = pk2(o2, o3); w.z = pk2(o4, o5); w.w = pk2(o6, o7); *(v4u*)(ktw + (size_t)dk * 256 + s0) = w;
                        float rs = ((o0 + o1) + (o2 + o3)) + ((o4 + o5) + (o6 + o7));
#pragma unroll
                        for (int o = 1; o < 32; o <<= 1) rs += __shfl_xor(rs, o);
                        if ((lane & 31) == 0) DN[(size_t)(dh * NCH + c) * 256 + dk] = rs; }
                    __syncthreads();
                }
            }
#if MLDBG
            {
                LAS float* red = (LAS float*)(lds + 65536 + 4096);
                float* HREF = (float*)(ws + WS_END); float* DREF = HREF + (size_t)2 * R * MLW;
                const bf16* SQd = (const bf16*)(ws + WS_SQ); const bf16* VCd = (const bf16*)(ws + WS_VC);
                for (int un = bid; un < 256; un += G) {
                    const int h = un >> 6, d = (un >> 5) & 1, sl = un & 31, dk = tid & 255, hf = tid >> 8, dv0 = sl * 8 + hf * 4;
                    float C0 = 0.f, C1 = 0.f, C2 = 0.f, C3 = 0.f, nn = 0.f;
                    for (int tau = 0; tau < R; ++tau) {
                        const int r = tau_row(d, tau), c = r >> 8, t = r & 255;
                        const float q = bf2f(SQd[((size_t)(h * NCH + c) * 256 + t) * 512 + 256 + dk]), k = bf2f(Kb[((size_t)h * R + r) * 256 + dk]);
                        const bf16* vp = VCd + ((size_t)(h * NCH + c) * 256 + dv0) * 512 + t; const float v0 = bf2f(vp[0]), v1 = bf2f(vp[512]), v2 = bf2f(vp[1024]), v3 = bf2f(vp[1536]);
                        const float gi = GATES[(size_t)r * 16 + d * 8 + h], gf = GATES[(size_t)r * 16 + d * 8 + 4 + h];
                        const float f = sigmoidf_(gf), ik = __expf(gi) * k;
                        C0 = f * C0 + ik * v0; C1 = f * C1 + ik * v1; C2 = f * C2 + ik * v2; C3 = f * C3 + ik * v3; nn = f * nn + ik;
                        const float s0 = wave_sum(q * C0), s1 = wave_sum(q * C1), s2 = wave_sum(q * C2), s3 = wave_sum(q * C3), s4 = wave_sum(q * nn);
                        LAS float* rb = red + (tau & 1) * 40 + wave * 5;
                        if (lane == 0) { rb[0] = s0; rb[1] = s1; rb[2] = s2; rb[3] = s3; rb[4] = s4; }
                        __syncthreads();
                        if (tid < 8) { const int h2 = tid >> 2, j = tid & 3; const LAS float* rr = red + (tau & 1) * 40 + h2 * 20; const float num = rr[j] + rr[5 + j] + rr[10 + j] + rr[15 + j], den = rr[4] + rr[9] + rr[14] + rr[19];
                            HREF[((size_t)d * R + r) * MLW + h * 256 + sl * 8 + h2 * 4 + j] = num / fmaxf(fabsf(den), 1.f); if (sl == 0 && tid == 0) DREF[((size_t)d * R + r) * 4 + h] = den; }
                    }
                    __syncthreads();
                }
            }
#endif
            {
                LAS float* part = (LAS float*)(lds + 98304);
                LAS float* stat = part + 512;
                const int ch = tid; float wv[CONVK];
#pragma unroll
                for (int j = 0; j < CONVK; ++j) wv[j] = ap->conv_dw_w[((size_t)l * CONVK + j) * CONVW + ch];
                const float dwb = ap->conv_dw_b[(size_t)l * CONVW + ch], lg = ap->conv_ln_g[(size_t)l * CONVW + ch], lb = ap->conv_ln_b[(size_t)l * CONVW + ch];
                for (int tk = bid; tk < 264; tk += G) { const int un = tk >> 1;
                    const int row0 = un < 4 ? 0 : CTXL + (un - 4) * 64, u0 = un < 4 ? un * 64 : 0, len = un < 4 ? CTXL : 64;
                    { const int hf = tk & 1; const int p0 = u0 + hf * 32 - CONVK / 2;
                        {
                            LAS v4u* tile = (LAS v4u*)lds;
                            v4u tv[8];
#pragma unroll
                            for (int i = 0; i < 8; ++i) { const int id = tid + NTHR * i, rw = id >> 6, p = p0 + rw, pc = p < 0 ? 0 : (p >= len ? len - 1 : p);
                                tv[i] = *(const v4u*)(CG + (size_t)(row0 + pc) * CONVW + (id & 63) * 8); if (p < 0 || p >= len) tv[i] = (v4u){0u, 0u, 0u, 0u}; }
#pragma unroll
                            for (int i = 0; i < 8; ++i) { const int id = tid + NTHR * i; if (id < 62 * 64) tile[id] = tv[i]; }
                            __syncthreads();
                        }
                        float xw[62];
#pragma unroll
                        for (int k = 0; k < 62; ++k) xw[k] = bf2f(((const LAS unsigned short*)lds)[k * CONVW + ch]);
                        float y[32], q[32];
#pragma unroll
                        for (int i = 0; i < 32; ++i) { float acc = dwb;
#pragma unroll
                            for (int j = 0; j < CONVK; ++j) acc += wv[j] * xw[i + j];
                            y[i] = acc; q[i] = acc; }
                        float sq[32];
#pragma unroll
                        for (int i = 0; i < 32; ++i) sq[i] = y[i] * y[i];
#define CONV_FOLD(n, msk) { const bool hb = (lane & (msk)) != 0; _Pragma("unroll") for (int i = 0; i < (n) / 2; ++i) { \
                            const float s1 = hb ? q[i] : q[i + (n) / 2], k1 = hb ? q[i + (n) / 2] : q[i]; q[i] = k1 + __shfl_xor(s1, (msk)); \
                            const float s2 = hb ? sq[i] : sq[i + (n) / 2], k2 = hb ? sq[i + (n) / 2] : sq[i]; sq[i] = k2 + __shfl_xor(s2, (msk)); } }
                        CONV_FOLD(32, 32) CONV_FOLD(16, 16) CONV_FOLD(8, 8) CONV_FOLD(4, 4) CONV_FOLD(2, 2)
#undef CONV_FOLD
                        const float ts = q[0] + __shfl_xor(q[0], 1), tq = sq[0] + __shfl_xor(sq[0], 1);
                        if ((lane & 1) == 0) { part[(wave * 32 + (lane >> 1)) * 2] = ts; part[(wave * 32 + (lane >> 1)) * 2 + 1] = tq; }
                        __syncthreads();
                        if (tid < 32) { float a1 = 0.f, a2 = 0.f;
#pragma unroll
                            for (int w = 0; w < 8; ++w) { a1 += part[(w * 32 + tid) * 2]; a2 += part[(w * 32 + tid) * 2 + 1]; }
                            const float mean = a1 * (1.f / CONVW), var = fmaxf(a2 * (1.f / CONVW) - mean * mean, 0.f); stat[tid * 2] = mean; stat[tid * 2 + 1] = 1.f / sqrtf(var + LN_EPS); }
                        __syncthreads();
#pragma unroll
                        for (int i = 0; i < 32; ++i) { const float o = (y[i] - stat[2 * i]) * stat[2 * i + 1] * lg + lb;
                            ((unsigned short*)MIX)[(size_t)(row0 + u0 + hf * 32 + i) * D + S5W + ch] = (unsigned short)f2bf(siluf_(o)); }
                        __syncthreads();
                    }
                }
            }
            TPW(2); GRID_BAR(); TP1(2);
        }

        if (IN(3)) { TP0(3) PH_IDS
            {
                const bf16* EB = (const bf16*)(ws + WS_EB); pg8::f32x2* ESC = (pg8::f32x2*)(ws + WS_ESC);
                for (int task = gw; task < S5G * 2 * NSC; task += NGW) { const int g = task / (2 * NSC), d = (task / NSC) & 1, sc = task % NSC;
                    const f32x4 lp = ((const f32x4*)(ws + WS_LAMP))[(((size_t)l * S5G + g) * 2 + d) * 64 + lane]; pg8::f32x2 e[16];
#pragma unroll
                    for (int j = 0; j < 16; ++j) { const int tc = sc * 16 + j, rc = d == 0 ? tc : (tc < CTXCK ? CTXCK - 1 - tc : NCK - 1 + CTXCK - tc); { const unsigned ew = *(const unsigned*)(EB + ((size_t)g * UROWS + rc) * 256 + d * 128 + 2 * lane); e[j] = (pg8::f32x2){bflo(ew), bfhi(ew)}; } }
                    __builtin_amdgcn_sched_barrier(0);
                    float hr = 0.f, hi = 0.f;
#pragma unroll
                    for (int j = 0; j < 16; ++j) { const float nr = lp.x * hr - lp.y * hi + e[j].x, ni = lp.x * hi + lp.y * hr + e[j].y; hr = nr; hi = ni; }
                    ESC[((size_t)(g * 2 + d) * NSC + sc) * 64 + lane] = (pg8::f32x2){hr, hi}; }
            }
            { pg8::Gemm g{(const bf16*)(ws + WS_QN), Kb, 256, 256, 256}; BatchOrder S{MLH * NCH, G, bid, 0};
              EpiG1 E{(bf16*)(ws + WS_SQ), (const float*)(ws + WS_CS), (float*)(ws + WS_RSP)};
              pg8::gemm_phase<EpiG1, BatchOrder, true, true>(lds, g, S, E, wave0); }
            { pg8::Gemm g{(const bf16*)(ws + WS_VT), (const bf16*)(ws + WS_KTW), 256, 256, 256}; BatchOrder S{256, G, bid, 1};
              EpiBf16T E{(bf16*)(ws + WS_DC), 65536, 256, 1};
              pg8::gemm_phase<EpiBf16T, BatchOrder, true, true>(lds, g, S, E, wave0); }
            TPW(3); GRID_BAR(); TP1(3);
        }

        if (IN(4)) { TP0(4) PH_IDS
            const bf16* DC = (const bf16*)(ws + WS_DC); const float* AT = (const float*)(ws + WS_AT); bf16* VC = (bf16*)(ws + WS_VC);
            for (int b = bid; b < 256; b += G) {
                const int dh = b >> 5, d = dh >> 2, part = b & 31, dv = part * 8 + (tid >> 6), dk0 = (tid & 63) * 4; const bool nt_ = part == 0 && tid < 256;
                f32x4 C = {0.f, 0.f, 0.f, 0.f}; float nn = 0.f;
                *(v2u*)(VC + ((size_t)(dh * NCH) * 256 + dv) * 256 + dk0) = (v2u){0u, 0u};
                if (nt_) ((float*)(ws + WS_NIN))[(size_t)(dh * NCH) * 256 + tid] = 0.f;
#define SCAN_CH(st) (d == 0 ? (st) : ((st) == 0 ? 0 : NCH - (st)))
                for (int st0 = 0; st0 < NCH - 1; st0 += 4) { v2u dcw[4]; float A4[4], dn4[4];
#pragma unroll
                    for (int i = 0; i < 4; ++i) { const int c = SCAN_CH(st0 + i); dcw[i] = *(const v2u*)(DC + ((size_t)(dh * NCH + c) * 256 + dv) * 256 + dk0); A4[i] = AT[dh * NCH + c];
                        dn4[i] = ((const float*)(ws + WS_DN))[(size_t)(dh * NCH + c) * 256 + (tid & 255)]; }
                    __builtin_amdgcn_sched_barrier(0);
#pragma unroll
                    for (int i = 0; i < 4; ++i) { const int cn = SCAN_CH(st0 + i + 1); const f32x4 dc = {bflo(dcw[i].x), bfhi(dcw[i].x), bflo(dcw[i].y), bfhi(dcw[i].y)};
                        C = C * A4[i] + dc; v2u w; w.x = pk2(C.x, C.y); w.y = pk2(C.z, C.w);
                        *(v2u*)(VC + ((size_t)(dh * NCH + cn) * 256 + dv) * 256 + dk0) = w;
                        if (nt_) { nn = nn * A4[i] + dn4[i]; ((float*)(ws + WS_NIN))[(size_t)(dh * NCH + cn) * 256 + tid] = nn; } } }
#undef SCAN_CH
            }
            {
                const bf16* EB = (const bf16*)(ws + WS_EB); const pg8::f32x2* ESC = (const pg8::f32x2*)(ws + WS_ESC);
                for (int task = gw; task < S5G * 2 * NSC; task += NGW) { const int g = task / (2 * NSC), d = (task / NSC) & 1, sc = task % NSC;
                    const f32x4 lp = ((const f32x4*)(ws + WS_LAMP))[(((size_t)l * S5G + g) * 2 + d) * 64 + lane]; pg8::f32x2 e[16];
#pragma unroll
                    for (int j = 0; j < 16; ++j) { const int tc = sc * 16 + j, rc = d == 0 ? tc : (tc < CTXCK ? CTXCK - 1 - tc : NCK - 1 + CTXCK - tc); { const unsigned ew = *(const unsigned*)(EB + ((size_t)g * UROWS + rc) * 256 + d * 128 + 2 * lane); e[j] = (pg8::f32x2){bflo(ew), bfhi(ew)}; } }
                    __builtin_amdgcn_sched_barrier(0);
                    float hr = 0.f, hi = 0.f;
                    for (int s2 = 0; s2 < sc; ++s2) { const pg8::f32x2 es = ESC[((size_t)(g * 2 + d) * NSC + s2) * 64 + lane]; const float nr = lp.z * hr - lp.w * hi + es.x, ni = lp.z * hi + lp.w * hr + es.y; hr = nr; hi = ni; }
#pragma unroll
                    for (int j = 0; j < 16; ++j) { const int tc = sc * 16 + j, rc = d == 0 ? tc : (tc < CTXCK ? CTXCK - 1 - tc : NCK - 1 + CTXCK - tc);
                        *(unsigned*)(U + ((size_t)g * UROWS + rc) * UPITCH + 256 + d * 128 + 2 * lane) = pk2(hr, hi);
                        const float nr = lp.x * hr - lp.y * hi + e[j].x, ni = lp.x * hi + lp.y * hr + e[j].y; hr = nr; hi = ni; } }
            }
            TPW(4); GRID_BAR(); TP1(4);
        }

        if (IN(5)) { TP0(5) PH_WS
            pg8::Gemm g{(const bf16*)(ws + WS_SQ), (const bf16*)(ws + WS_VT), 256, 256, 512, (const bf16*)(ws + WS_QN), (const bf16*)(ws + WS_VC)}; BatchOrder S{2 * MLH * NCH, G, bid, 2};
            EpiG3 E{(bf16*)(ws + WS_HML)};
            pg8::gemm_phase<EpiG3, BatchOrder, true, true, true>(lds, g, S, E, wave0);
            { pg8::Gemm g2{U, (const bf16*)(ws + WS_WC) + (size_t)l * S5G * 131072, UPITCH, 512, 512}; BatchOrder S2{S5G * 3, G, (bid + 96) % G, 3};
              EpiS5Y E2{S5Gb};
              pg8::gemm_phase<EpiS5Y, BatchOrder, true, true>(lds, g2, S2, E2, wave0); }
            TPW(5); GRID_BAR(); TP1(5);
        }

        if (IN(6)) { TP0(6) PH_IDS
            if (bid < 66) {
                pg8::Gemm g{S5Gb, (const bf16*)(wl + WL_GLU), S5W, S5W, S5W}; pg8::StaticOrder S; S.init(NPAN, S5W / 256, 66, bid);
                EpiGlu E{S5Gb, ap->s5_b_glu + (size_t)l * S5W, MIX};
                pg8::gemm_phase<EpiGlu, pg8::StaticOrder, true, true>(lds, g, S, E, wave0);
            } else {
                const float* ng = ap->ml_norm_g + (size_t)l * MLW;
                const float* BC = (const float*)(ws + WS_BC); const float* RSP = (const float*)(ws + WS_RSP); const float* NIN = (const float*)(ws + WS_NIN); const bf16* SQ = (const bf16*)(ws + WS_QN); const bf16* HMB = (const bf16*)(ws + WS_HML);
                for (int r = (bid - 66) * NWAVES + wave; r < R; r += (G - 66) * NWAVES) { const int c = r >> 8, t = r & 255;
                    v2u qw[4], ow[4], hw[2][4]; f32x4 n4[2][4], rp[2][4], gg[4]; float bc[2][4];
#pragma unroll
                    for (int h = 0; h < 4; ++h) { qw[h] = *(const v2u*)(SQ + ((size_t)(h * NCH + c) * 256 + t) * 256 + lane * 4); ow[h] = *(const v2u*)(Ob + (size_t)r * MLW + h * 256 + lane * 4); gg[h] = *(const f32x4*)(ng + h * 256 + lane * 4);
#pragma unroll
                        for (int d = 0; d < 2; ++d) { const int dh = d * 4 + h; n4[d][h] = *(const f32x4*)(NIN + (size_t)(dh * NCH + c) * 256 + lane * 4); rp[d][h] = *(const f32x4*)(RSP + ((size_t)dh * R + r) * 4); bc[d][h] = BC[(size_t)dh * R + r];
                            hw[d][h] = *(const v2u*)(HMB + ((size_t)d * R + r) * MLW + h * 256 + lane * 4); } }
                    __builtin_amdgcn_sched_barrier(0);
                    float qn[2][4];
#pragma unroll
                    for (int h = 0; h < 4; ++h) { const f32x4 q = {bflo(qw[h].x), bfhi(qw[h].x), bflo(qw[h].y), bfhi(qw[h].y)};
#pragma unroll
                        for (int d = 0; d < 2; ++d) qn[d][h] = (q.x * n4[d][h].x + q.y * n4[d][h].y) + (q.z * n4[d][h].z + q.w * n4[d][h].w); }
#pragma unroll
                    for (int d = 0; d < 2; ++d)
#pragma unroll
                        for (int h = 0; h < 4; ++h) qn[d][h] = wave_sum(qn[d][h]);
                    f32x4 v[4]; float mean[4], var[4];
#pragma unroll
                    for (int h = 0; h < 4; ++h) { v[h] = (f32x4){0.f, 0.f, 0.f, 0.f};
#pragma unroll
                        for (int d = 0; d < 2; ++d) { const float aa = __expf(bc[d][h]), den = aa * ((rp[d][h].x + rp[d][h].y) + (rp[d][h].z + rp[d][h].w) + qn[d][h]), scl = aa / fmaxf(fabsf(den), 1.f);
                            v[h] += (f32x4){bflo(hw[d][h].x), bfhi(hw[d][h].x), bflo(hw[d][h].y), bfhi(hw[d][h].y)} * scl; }
                        mean[h] = (v[h].x + v[h].y) + (v[h].z + v[h].w); }
#pragma unroll
                    for (int h = 0; h < 4; ++h) mean[h] = wave_sum(mean[h]) * (1.f / 256.f);
#pragma unroll
                    for (int h = 0; h < 4; ++h) { v[h] = v[h] - mean[h]; var[h] = (v[h].x * v[h].x + v[h].y * v[h].y) + (v[h].z * v[h].z + v[h].w * v[h].w); }
#pragma unroll
                    for (int h = 0; h < 4; ++h) var[h] = wave_sum(var[h]) * (1.f / 256.f);
#pragma unroll
                    for (int h = 0; h < 4; ++h) { const float rstd = 1.f / sqrtf(var[h] + LN_EPS);
                        const f32x4 o = {sigmoidf_(bflo(ow[h].x)) * v[h].x * rstd * gg[h].x, sigmoidf_(bfhi(ow[h].x)) * v[h].y * rstd * gg[h].y, sigmoidf_(bflo(ow[h].y)) * v[h].z * rstd * gg[h].z, sigmoidf_(bfhi(ow[h].y)) * v[h].w * rstd * gg[h].w};
                        v2u w; w.x = pk2(o.x, o.y); w.y = pk2(o.z, o.w); *(v2u*)(MIX + (size_t)r * D + 1024 + h * 256 + lane * 4) = w; } }
            }
            TPW(6); GRID_BAR(); TP1(6);
        }

        if (IN(8)) { TP0(8) PH_WS
            { pg8::Gemm g{MIX, (const bf16*)(wl + WL_OUT), D, D, D}; pg8::StaticOrder S; S.init(NPAN - 1, D / 256, G, bid, 1);
              EpiRes E{XR, modc + 2 * D, modx + 2 * D, l == 0 ? ap->x - (size_t)CTXL * D : (const float*)XR};
              pg8::gemm_phase<EpiRes, pg8::StaticOrder, true, true>(lds, g, S, E, wave0); }
            if (l < DEPTH - 1) { pg8::Gemm g{MIX, (const bf16*)(wl + WL_OUT), D, D, 256}; BatchOrder S{8 * (D / 256), G, bid, 4};
              EpiPart E{HML};
              pg8::gemm_phase<EpiPart, BatchOrder, true, true>(lds, g, S, E, wave0); }
            if (l < DEPTH - 1 && bid >= 64) { int lane; asm volatile("v_mbcnt_lo_u32_b32 %0, -1, 0\n\tv_mbcnt_hi_u32_b32 %0, -1, %0" : "=v"(lane)); convert_range(ap, ws, lds, wave0, lane, l + 1, CV_B0, CV_B1, (bid - 64) * NWAVES + wave0, (G - 64) * NWAVES); }
            TPW(8); GRID_BAR(); TP1(8);
        }

        if (IN(9)) { TP0(9) PH_IDS const float* g2n = ap->norm2_g + (size_t)l * D; NORM_PHASE(g2n, 3, 4, D / 256, l < DEPTH - 1, HML, modc + 2 * D, XR, false, XR); TPW(9); GRID_BAR(); TP1(9); }

        if (IN(10)) { TP0(10) PH_WS
            pg8::Gemm g{HN, (const bf16*)(wl + WL_FI), D, D, D}; pg8::StaticOrder S; S.init(NPAN, 2 * DFF / 256, G, bid);
            EpiSwiglu E{HFF};
            pg8::gemm_phase<EpiSwiglu, pg8::StaticOrder, false, true>(lds, g, S, E, wave0);
            if (l < DEPTH - 1 && bid >= 172) { int lane; asm volatile("v_mbcnt_lo_u32_b32 %0, -1, 0\n\tv_mbcnt_hi_u32_b32 %0, -1, %0" : "=v"(lane)); convert_range(ap, ws, lds, wave0, lane, l + 1, CV_A0, CV_A1, (bid - 172) * NWAVES + wave0, (G - 172) * NWAVES); }
            TPW(10); GRID_BAR(); TP1(10);
        }

        if (IN(11)) { TP0(11) PH_WS
            { pg8::Gemm g{HFF, (const bf16*)(wl + WL_FO), DFF, DFF, DFF}; pg8::StaticOrder S; S.init(NPAN - 1, D / 256, G, bid, 1);
              EpiRes E{XR, modc + 5 * D, modx + 5 * D, XR};
              pg8::gemm_phase<EpiRes, pg8::StaticOrder, true, true>(lds, g, S, E, wave0); }
            if (l < DEPTH - 1) { pg8::Gemm g{HFF, (const bf16*)(wl + WL_FO), DFF, DFF, 256}; BatchOrder S{8 * (DFF / 256), G, bid, 4};
              EpiPart E{HML + (size_t)8 * 256 * D};
              pg8::gemm_phase<EpiPart, BatchOrder, true, true>(lds, g, S, E, wave0); }
            if (l < DEPTH - 1 && bid >= 176) { int lane; asm volatile("v_mbcnt_lo_u32_b32 %0, -1, 0\n\tv_mbcnt_hi_u32_b32 %0, -1, %0" : "=v"(lane)); convert_range(ap, ws, lds, wave0, lane, l + 1, CV_C0, CV_C1, (bid - 176) * NWAVES + wave0, (G - 176) * NWAVES); }
            TPW(11); GRID_BAR(); TP1(11);
        }
    }

    if (a.do_fin) { PH_IDS
#if MLDBG
        float Pdbg = 0.f;
        if (bid == 0 && tid == 0) { const float* cnt = (const float*)(ws + WS_CTL) + 8192;
            for (int k = 0; k < 6; ++k) { const float e = __hip_atomic_load(cnt + 2 * k, __ATOMIC_RELAXED, __HIP_MEMORY_SCOPE_AGENT), rr = __hip_atomic_load(cnt + 2 * k + 1, __ATOMIC_RELAXED, __HIP_MEMORY_SCOPE_AGENT); if (e > MLDBG_THR * MLDBG_THR * rr) Pdbg += (float)(1 << k); } }
#endif
        { int r = CTXL + gw; f32x4 vn[8]; f32x4 gf[8];
#pragma unroll
          for (int j = 0; j < 8; ++j) gf[j] = *(const f32x4*)(ap->norm_f_g + lane * 4 + 256 * j);
          { const f32x4* xr = (const f32x4*)(XR + (size_t)(r < R ? r : R - 1) * D) + lane;
#pragma unroll
              for (int j = 0; j < 8; ++j) vn[j] = xr[64 * j]; }
          for (; r < R; r += NGW) { f32x4 v[8]; float ss = 0.f;
#pragma unroll
            for (int j = 0; j < 8; ++j) v[j] = vn[j];
            { const f32x4* xr = (const f32x4*)(XR + (size_t)(r + NGW < R ? r + NGW : R - 1) * D) + lane;
#pragma unroll
                for (int j = 0; j < 8; ++j) vn[j] = xr[64 * j]; }
#pragma unroll
            for (int j = 0; j < 8; ++j) ss += (v[j].x * v[j].x + v[j].y * v[j].y) + (v[j].z * v[j].z + v[j].w * v[j].w);
            const float rstd = 1.f / sqrtf(wave_sum(ss) * (1.f / D) + EPS);
#pragma unroll
            for (int j = 0; j < 8; ++j) { const int c0 = lane * 4 + 256 * j; *(f32x4*)(ap->out + (size_t)(r - CTXL) * D + c0) = v[j] * rstd * gf[j]; } } }
#if MLDBG
        if (bid == 0 && tid == 0) { asm volatile("s_waitcnt vmcnt(0)" ::: "memory"); ap->out[0] += Pdbg; }
#endif
    }
    if (TPROBE != 0) { const unsigned long long te = __builtin_amdgcn_s_memrealtime(); while (__builtin_amdgcn_s_memrealtime() - te < (unsigned long long)TPMUL * tp_acc) __builtin_amdgcn_s_sleep(8); }
#undef IN
#undef NORM_PHASE
#undef GRID_BAR
}

extern "C" void kernel_launch(void* const* d_in, const int* in_sizes, int n_in, void* d_out, int out_size, void* d_ws, size_t ws_size, hipStream_t stream) {
    static int grid = 0;
    if (grid == 0) {
        if (n_in != 29 || in_sizes[0] != SEQ * D || out_size != SEQ * D || ws_size < WS_END) { fprintf(stderr, "kernel_launch: unexpected problem (n_in %d, in0 %d, out %d, ws %zu < %zu)\n", n_in, n_in > 0 ? in_sizes[0] : -1, out_size, ws_size, (size_t)WS_END); grid = -1; return; }
        int dev = 0, cus = 0, per_cu = 0;
        if (hipGetDevice(&dev) != hipSuccess || hipDeviceGetAttribute(&cus, hipDeviceAttributeMultiprocessorCount, dev) != hipSuccess) { grid = -1; return; }
        if (hipFuncSetAttribute((const void*)fwd, hipFuncAttributeMaxDynamicSharedMemorySize, LDS_BYTES) != hipSuccess) { fprintf(stderr, "kernel_launch: hipFuncSetAttribute failed\n"); grid = -1; return; }
        if (hipOccupancyMaxActiveBlocksPerMultiprocessor(&per_cu, (const void*)fwd, NTHR, LDS_BYTES) != hipSuccess || per_cu < 1) fprintf(stderr, "kernel_launch: occupancy query says %d\n", per_cu);
        (void)hipGetLastError();
        grid = cus;
    }
    if (grid < 0) return;
    (void)hipMemsetAsync((char*)d_ws + WS_CTL, 0, CTL_ZERO_BYTES, stream);
    Args a{};
    const float** pp = (const float**)&a;
    for (int i = 0; i < 29; ++i) pp[i] = (const float*)d_in[i];
    a.out = (float*)d_out; a.ws = (unsigned char*)d_ws;
#if MK_SINGLE
    a.l_lo = 0; a.l_hi = DEPTH; a.ph_lo = 0; a.ph_hi = NPH; a.do_pro = 1; a.do_fin = 1; a.use_bar = 1;
    hipLaunchKernelGGL(fwd, dim3(grid), dim3(NTHR), LDS_BYTES, stream, a);
#else
    a.use_bar = 0;
    a.l_lo = 0; a.l_hi = 0; a.ph_lo = 0; a.ph_hi = 0; a.do_pro = 1; a.do_fin = 0;
    hipLaunchKernelGGL(fwd, dim3(grid), dim3(NTHR), LDS_BYTES, stream, a);
    a.do_pro = 0;
    for (int l = 0; l < DEPTH; ++l) for (int p = 0; p < NPH; ++p) { a.l_lo = l; a.l_hi = l + 1; a.ph_lo = p; a.ph_hi = p + 1; hipLaunchKernelGGL(fwd, dim3(grid), dim3(NTHR), LDS_BYTES, stream, a); }
    a.l_lo = 0; a.l_hi = 0; a.ph_lo = 0; a.ph_hi = 0; a.do_fin = 1;
    hipLaunchKernelGGL(fwd, dim3(grid), dim3(NTHR), LDS_BYTES, stream, a);
#endif
}
```
